# Optimizing an MI355X kernel written in HIP

```python
import math
import jax, jax.numpy as jnp
from jax import lax
import numpy as np

D_MODEL = 1024
BATCH = 16
SEQ = 2048
DEPTH = 1

CHUNK = 64
Q_BLOCK = 128
ROPE_THETA = 500000.0
ROPE_FRACTION = 4
LN_EPS = 1e-5
A_HEADS = 8
A_HEAD_DIM = 64
A_WIDTH = A_HEADS * A_HEAD_DIM
IDX_HEADS = 8
IDX_DIM = 32
TOPK_MAX = 256
B_HEADS = 4
B_HEAD_DIM = 64
B_WIDTH = B_HEADS * 2 * B_HEAD_DIM
MEM_LEN = 256
C_HEADS = 4
C_HEAD_DIM = 128
C_WIDTH = C_HEADS * C_HEAD_DIM
N_BRANCH = 3
DEEPNORM_ALPHA = (2.0 * DEPTH) ** 0.25
DEEPNORM_BETA = (8.0 * DEPTH) ** -0.25
IN_SPLITS = (
    A_HEADS * A_HEAD_DIM,
    A_HEAD_DIM,
    A_HEAD_DIM,
    A_WIDTH,
    IDX_HEADS * IDX_DIM,
    IDX_DIM,
    IDX_HEADS,
    B_WIDTH,
    B_WIDTH,
    B_WIDTH,
    B_WIDTH,
    C_WIDTH,
    C_WIDTH,
    N_BRANCH * D_MODEL,
)
VALUE_SPLITS = (2, 9)
IN_WIDTH = sum(IN_SPLITS)

kernel_name = 'hybrid_dsa_diffattn_memxattn_deepnorm'


def _split_cols(h, sizes):
    offs = np.cumsum(sizes)[:-1].tolist()
    return jnp.split(h, offs, axis=-1)


def _layer_norm(x, g, b):
    xf = x.astype(jnp.float32)
    mu = jnp.mean(xf, -1, keepdims=True)
    var = jnp.mean(jnp.square(xf - mu), -1, keepdims=True)
    y = (xf - mu) * lax.rsqrt(var + LN_EPS) * g.astype(jnp.float32) + b.astype(jnp.float32)
    return y.astype(x.dtype)


def _partial_rope(x, pos):
    d = x.shape[-1]
    r = d // ROPE_FRACTION
    half = r // 2
    inv = jnp.power(ROPE_THETA, -jnp.arange(half, dtype=jnp.float32) * (2.0 / r))
    ang = pos[:, None] * inv[None, :]
    cos = jnp.cos(ang)[:, None, :]
    sin = jnp.sin(ang)[:, None, :]
    xf = x.astype(jnp.float32)
    x1, x2, xp = xf[..., :half], xf[..., half:r], xf[..., r:]
    out = jnp.concatenate([x1 * cos - x2 * sin, x2 * cos + x1 * sin, xp], axis=-1)
    return out.astype(x.dtype)


def _chunk_limit(t):
    return (t // CHUNK + 1) * CHUNK


def _to_blocks(a, nb):
    a = a.reshape((a.shape[0], nb, Q_BLOCK) + a.shape[2:])
    return jnp.moveaxis(a, 1, 0)


def _from_blocks(a):
    a = jnp.moveaxis(a, 0, 1)
    return a.reshape((a.shape[0], a.shape[1] * a.shape[2]) + a.shape[3:])


def _dsa_attention(q, k, v, iq, ik, iw):
    seq = q.shape[1]
    nb = seq // Q_BLOCK
    n_sel = min(TOPK_MAX, seq // 4)
    key_pos = jnp.arange(seq)
    scale = A_HEAD_DIM ** -0.5

    def block(args):
        j, qb, iqb, iwb = args
        limit = _chunk_limit(j * Q_BLOCK + jnp.arange(Q_BLOCK))
        rel = jax.nn.relu(jnp.einsum('bqhd,bsd->bqhs', iqb, ik).astype(jnp.float32))
        score = jnp.einsum('bqh,bqhs->bqs', iwb.astype(jnp.float32), rel)
        score = jnp.where(key_pos[None, None, :] < limit[None, :, None], score, -jnp.inf)
        _, idx = lax.top_k(score, n_sel)
        ok = idx < limit[None, :, None]
        k_sel = jax.vmap(lambda kk, ii: kk[ii])(k, idx)
        v_sel = jax.vmap(lambda vv, ii: vv[ii])(v, idx)
        logits = jnp.einsum('bqhd,bqkd->bqhk', qb, k_sel).astype(jnp.float32) * scale
        logits = jnp.where(ok[:, :, None, :], logits, -jnp.inf)
        p = jax.nn.softmax(logits, axis=-1).astype(v.dtype)
        return jnp.einsum('bqhk,bqkd->bqhd', p, v_sel)

    out = lax.map(block, (jnp.arange(nb), _to_blocks(q, nb), _to_blocks(iq, nb), _to_blocks(iw, nb)))
    return _from_blocks(out)


def _diff_attention(q, k, v, lam):
    seq = q.shape[1]
    nb = seq // Q_BLOCK
    key_pos = jnp.arange(seq)
    scale = B_HEAD_DIM ** -0.5

    def block(args):
        j, qb = args
        limit = _chunk_limit(j * Q_BLOCK + jnp.arange(Q_BLOCK))
        logits = jnp.einsum('bqhcd,bshcd->bhcqs', qb, k).astype(jnp.float32) * scale
        logits = jnp.where(key_pos[None, :] < limit[:, None], logits, -jnp.inf)
        p = jax.nn.softmax(logits, axis=-1)
        a = (p[:, :, 0] - lam * p[:, :, 1]).astype(v.dtype)
        return jnp.einsum('bhqs,bshe->bqhe', a, v)

    out = lax.map(block, (jnp.arange(nb), _to_blocks(q, nb)))
    return _from_blocks(out)


def _memory_attention(q, mk, mv):
    logits = jnp.einsum('bqhd,bmhd->bhqm', q, mk).astype(jnp.float32) * (C_HEAD_DIM ** -0.5)
    p = jax.nn.softmax(logits, axis=-1).astype(mv.dtype)
    return jnp.einsum('bhqm,bmhd->bqhd', p, mv)


def setup_inputs(seed: int = 0) -> dict:
    key = jax.random.key(seed)
    ks = jax.random.split(key, 16)
    f32 = jnp.float32
    x = jax.random.normal(ks[0], (BATCH, SEQ, D_MODEL), f32)
    mem = jax.random.normal(ks[1], (BATCH, MEM_LEN, D_MODEL), f32)
    ln_in_g = 1.0 + 0.02 * jax.random.normal(ks[2], (D_MODEL,), f32)
    ln_in_b = 0.02 * jax.random.normal(ks[3], (D_MODEL,), f32)
    col_scale = jnp.concatenate([jnp.full((s,), DEEPNORM_BETA if i in VALUE_SPLITS else 1.0, f32)
                                 for i, s in enumerate(IN_SPLITS)])
    w_in = jax.random.normal(ks[4], (DEPTH, D_MODEL, IN_WIDTH), f32) * (D_MODEL ** -0.5) * col_scale
    kv_scale = jnp.concatenate([jnp.ones((C_WIDTH,), f32), jnp.full((C_WIDTH,), DEEPNORM_BETA, f32)])
    w_mem_kv = jax.random.normal(ks[5], (DEPTH, D_MODEL, 2 * C_WIDTH), f32) * (D_MODEL ** -0.5) * kv_scale
    diff_lambda = 0.1 * jax.random.normal(ks[6], (DEPTH, 4, B_HEAD_DIM), f32)
    diff_norm_g = 1.0 + 0.02 * jax.random.normal(ks[7], (DEPTH, 2 * B_HEAD_DIM), f32)
    w_proj_a = jax.random.normal(ks[8], (DEPTH, A_WIDTH, D_MODEL), f32) * (A_WIDTH ** -0.5) * DEEPNORM_BETA
    w_proj_b = jax.random.normal(ks[9], (DEPTH, B_WIDTH, D_MODEL), f32) * (B_WIDTH ** -0.5) * DEEPNORM_BETA
    w_proj_c = jax.random.normal(ks[10], (DEPTH, C_WIDTH, D_MODEL), f32) * (C_WIDTH ** -0.5) * DEEPNORM_BETA
    w_out = jax.random.normal(ks[11], (DEPTH, D_MODEL, D_MODEL), f32) * (D_MODEL ** -0.5) * DEEPNORM_BETA
    ln_g = 1.0 + 0.02 * jax.random.normal(ks[12], (DEPTH, D_MODEL), f32)
    ln_b = 0.02 * jax.random.normal(ks[13], (DEPTH, D_MODEL), f32)
    return {'x': x, 'mem': mem, 'ln_in_g': ln_in_g, 'ln_in_b': ln_in_b, 'w_in': w_in,
            'w_mem_kv': w_mem_kv, 'diff_lambda': diff_lambda, 'diff_norm_g': diff_norm_g,
            'w_proj_a': w_proj_a, 'w_proj_b': w_proj_b, 'w_proj_c': w_proj_c, 'w_out': w_out,
            'ln_g': ln_g, 'ln_b': ln_b}


def reference(x, mem, ln_in_g, ln_in_b, w_in, w_mem_kv, diff_lambda, diff_norm_g,
              w_proj_a, w_proj_b, w_proj_c, w_out, ln_g, ln_b):
    bsz, seq, _ = x.shape
    pos = jnp.arange(seq, dtype=jnp.float32)
    h = _layer_norm(x, ln_in_g, ln_in_b)
    for l in range(DEPTH):
        lam_init = 0.8 - 0.6 * math.exp(-0.3 * l)
        proj = h @ w_in[l]
        (a_q, a_k, a_v, a_gate, i_q, i_k, i_w, b_q, b_k, b_v, b_gate,
         c_q, c_gate, m_gate) = _split_cols(proj, IN_SPLITS)

        a_q = _partial_rope(a_q.reshape(bsz, seq, A_HEADS, A_HEAD_DIM), pos)
        a_k = _partial_rope(a_k[:, :, None, :], pos)[:, :, 0]
        i_q = _partial_rope(i_q.reshape(bsz, seq, IDX_HEADS, IDX_DIM), pos)
        i_k = _partial_rope(i_k[:, :, None, :], pos)[:, :, 0]
        i_w = i_w * ((IDX_HEADS * IDX_DIM) ** -0.5)
        o_a = _dsa_attention(a_q, a_k, a_v, i_q, i_k, i_w).reshape(bsz, seq, A_WIDTH)
        y_a = (o_a * jax.nn.silu(a_gate)) @ w_proj_a[l]

        b_q = _partial_rope(b_q.reshape(bsz, seq, 2 * B_HEADS, B_HEAD_DIM), pos)
        b_k = _partial_rope(b_k.reshape(bsz, seq, 2 * B_HEADS, B_HEAD_DIM), pos)
        b_q = b_q.reshape(bsz, seq, B_HEADS, 2, B_HEAD_DIM)
        b_k = b_k.reshape(bsz, seq, B_HEADS, 2, B_HEAD_DIM)
        b_v = b_v.reshape(bsz, seq, B_HEADS, 2 * B_HEAD_DIM)
        dl = diff_lambda[l].astype(jnp.float32)
        lam = jnp.exp(jnp.sum(dl[0] * dl[1])) - jnp.exp(jnp.sum(dl[2] * dl[3])) + lam_init
        o_b = _diff_attention(b_q, b_k, b_v, lam).astype(jnp.float32)
        o_b = (o_b * lax.rsqrt(jnp.mean(o_b * o_b, -1, keepdims=True) + LN_EPS)
               * diff_norm_g[l].astype(jnp.float32) * (1.0 - lam_init)).astype(h.dtype)
        y_b = (o_b.reshape(bsz, seq, B_WIDTH) * jax.nn.silu(b_gate)) @ w_proj_b[l]

        mk, mv = jnp.split(mem @ w_mem_kv[l], 2, axis=-1)
        mk = mk.reshape(bsz, MEM_LEN, C_HEADS, C_HEAD_DIM)
        mv = mv.reshape(bsz, MEM_LEN, C_HEADS, C_HEAD_DIM)
        o_c = _memory_attention(c_q.reshape(bsz, seq, C_HEADS, C_HEAD_DIM), mk, mv)
        y_c = (o_c.reshape(bsz, seq, C_WIDTH) * jax.nn.silu(c_gate)) @ w_proj_c[l]

        g = jax.nn.sigmoid(m_gate.reshape(bsz, seq, N_BRANCH, D_MODEL))
        merged = g[:, :, 0] * y_a + g[:, :, 1] * y_b + g[:, :, 2] * y_c
        h = _layer_norm(DEEPNORM_ALPHA * h + merged @ w_out[l], ln_g[l], ln_b[l])
    return h
```

```cpp
#include <hip/hip_runtime.h>
#include <hip/hip_bf16.h>
#include <cstdint>
#include <cstdio>
#include <cmath>

typedef unsigned short bf16;
typedef unsigned v4u __attribute__((ext_vector_type(4)));
typedef float f32x4 __attribute__((ext_vector_type(4)));

constexpr int D = 1024, BATCH = 16, SEQ = 2048, M = BATCH * SEQ;
constexpr int MEM_LEN = 256, MM = BATCH * MEM_LEN;
constexpr int IN_WIDTH = 7592;
constexpr int NPOS = 4608;
constexpr int O_AQ = 0, O_AK = 512, O_AV = 576, O_AG = 640, O_IQ = 1152, O_IK = 1408, O_IW = 1440, O_BQ = 1448, O_BK = 1960, O_BV = 2472,
              O_BG = 2984, O_CQ = 3496, O_CG = 4008, O_MG = 4520;
constexpr float LN_EPS = 1e-5f;
constexpr float LOG2E = 1.4426950408889634f;
constexpr float ALPHA = 1.189207115002721f;
constexpr float LAM_INIT = 0.2f;

constexpr size_t MiB = 1u << 20;
constexpr size_t WS_CTL = 0;
constexpr size_t WS_TAB = 1 * MiB;
constexpr size_t WS_TAB32 = WS_TAB + 128 * 1024;
constexpr size_t WS_LAM = WS_TAB + 256 * 1024;
constexpr size_t WS_STATS = WS_TAB + 512 * 1024;
constexpr size_t WS_WIN = 2 * MiB;
constexpr size_t WS_WMG = 11 * MiB;
constexpr size_t WS_WMEM = 17 * MiB;
constexpr size_t WS_WAB = 19 * MiB;
constexpr size_t WS_WC = 21 * MiB;
constexpr size_t WS_WOUT = 23 * MiB;
constexpr size_t WS_MEMB = 25 * MiB;
constexpr size_t WS_MKV = 33 * MiB;
constexpr size_t WS_XN = 41 * MiB;
constexpr size_t WS_QAB = 105 * MiB;
constexpr size_t WS_QC = 169 * MiB;
constexpr size_t WS_AG = 233 * MiB;
constexpr size_t WS_BK = 265 * MiB;
constexpr size_t WS_BV = 297 * MiB;
constexpr size_t WS_BG = 329 * MiB;
constexpr size_t WS_IQ = 361 * MiB;
constexpr size_t WS_AK = 377 * MiB;
constexpr size_t WS_AV = 381 * MiB;
constexpr size_t WS_IK = 385 * MiB;
constexpr size_t WS_IW = 387 * MiB;
constexpr size_t WS_MASK = 388 * MiB;
constexpr size_t WS_MERGED = WS_BK;
constexpr size_t WS_GTMP = WS_BG;
constexpr size_t WS_END = 400 * MiB;

__device__ __forceinline__ unsigned f2bf(float f) { unsigned u = __float_as_uint(f); return (u + 0x7fffu + ((u >> 16) & 1u)) >> 16; }
__device__ __forceinline__ float bf2f(unsigned v) { return __uint_as_float(v << 16); }
__device__ __forceinline__ unsigned pk2(float lo, float hi) { return f2bf(lo) | (f2bf(hi) << 16); }
__device__ __forceinline__ float silu_f(float x) { return x / (1.f + __expf(-x)); }
__device__ __forceinline__ float sigmoid_f(float x) { return 1.f / (1.f + __expf(-x)); }

__host__ __device__ __forceinline__ int rp64(int j) { return j < 16 ? ((j >> 1) + 8 * (j & 1)) : j; }
__host__ __device__ __forceinline__ int rp32(int j) { return j < 8 ? ((j >> 1) + 4 * (j & 1)) : j; }
__host__ __device__ __forceinline__ int orig_of_pos(int p) {
    const int tile = p >> 8;
    if (tile < 2) { return O_AQ + (p & ~63) + rp64(p & 63); }
    if (tile < 4) { return O_AG + (p - 512); }
    if (tile < 6) { const int c = p - 1024; return O_BQ + (c & ~63) + rp64(c & 63); }
    if (tile < 8) { const int c = p - 1536; return O_BK + (c & ~63) + rp64(c & 63); }
    if (tile < 10) { return O_BV + (p - 2048); }
    if (tile < 12) { return O_BG + (p - 2560); }
    if (tile < 14) { return O_CQ + (p - 3072); }
    if (tile < 16) { return O_CG + (p - 3584); }
    if (tile == 16) { const int c = p - 4096; return O_IQ + (c & ~31) + rp32(c & 31); }
    const int j = p - 4352;
    if (j < 64) return O_AK + rp64(j);
    if (j < 128) return O_AV + (j - 64);
    if (j < 160) return O_IK + rp32(j - 128);
    if (j < 168) return O_IW + (j - 160);
    return -1;
}

struct Bufs {
    const float *x, *mem, *ln_in_g, *ln_in_b, *w_in, *w_mem_kv, *diff_lambda, *diff_norm_g, *w_proj_a, *w_proj_b, *w_proj_c, *w_out, *ln_g, *ln_b;
    float* out; unsigned char* ws;
};
#define WSP(T, off) ((T*)(B.ws + (off)))

__device__ __forceinline__ void rope8_64(float* v, const float* tab, int i0) {
    const f32x4 c = *(const f32x4*)(tab + i0), s = *(const f32x4*)(tab + 8 + i0);
#pragma unroll
    for (int j = 0; j < 4; ++j) { const float x1 = v[2 * j], x2 = v[2 * j + 1]; v[2 * j] = x1 * c[j] - x2 * s[j]; v[2 * j + 1] = x2 * c[j] + x1 * s[j]; }
}
__device__ __forceinline__ void store8(bf16* dst, const float* v) {
    v4u o; o.x = pk2(v[0], v[1]); o.y = pk2(v[2], v[3]); o.z = pk2(v[4], v[5]); o.w = pk2(v[6], v[7]); *(v4u*)dst = o;
}
__device__ __forceinline__ void inproj_emit8(const Bufs& B, int t, int p0, float* v) {
    const int tile = p0 >> 8, pos = t & (SEQ - 1);
    const float* tab64 = WSP(const float, WS_TAB) + pos * 16;
    const float* tab32 = WSP(const float, WS_TAB32) + pos * 8;
    const float SQ64 = 0.125f * LOG2E, SQ128 = 0.08838834764831845f * LOG2E;
    if (tile < 2) {
        const int w = p0 & 63; if (w < 16) rope8_64(v, tab64, w >> 1);
#pragma unroll
        for (int j = 0; j < 8; ++j) v[j] *= SQ64;
        store8(WSP(bf16, WS_QAB) + (size_t)t * 1024 + p0, v);
    } else if (tile < 4) {
#pragma unroll
        for (int j = 0; j < 8; ++j) v[j] = silu_f(v[j]);
        store8(WSP(bf16, WS_AG) + (size_t)t * 512 + (p0 - 512), v);
    } else if (tile < 6) {
        const int c = p0 - 1024, w = c & 63; if (w < 16) rope8_64(v, tab64, w >> 1);
#pragma unroll
        for (int j = 0; j < 8; ++j) v[j] *= SQ64;
        store8(WSP(bf16, WS_QAB) + (size_t)t * 1024 + 512 + c, v);
    } else if (tile < 8) {
        const int c = p0 - 1536, w = c & 63; if (w < 16) rope8_64(v, tab64, w >> 1);
        store8(WSP(bf16, WS_BK) + (size_t)t * 512 + c, v);
    } else if (tile < 10) {
        store8(WSP(bf16, WS_BV) + (size_t)t * 512 + (p0 - 2048), v);
    } else if (tile < 12) {
#pragma unroll
        for (int j = 0; j < 8; ++j) v[j] = silu_f(v[j]);
        store8(WSP(bf16, WS_BG) + (size_t)t * 512 + (p0 - 2560), v);
    } else if (tile < 14) {
#pragma unroll
        for (int j = 0; j < 8; ++j) v[j] *= SQ128;
        store8(WSP(bf16, WS_QC) + (size_t)t * 1024 + (p0 - 3072), v);
    } else if (tile < 16) {
#pragma unroll
        for (int j = 0; j < 8; ++j) v[j] = silu_f(v[j]);
        store8(WSP(bf16, WS_QC) + (size_t)t * 1024 + 512 + (p0 - 3584), v);
    } else if (tile == 16) {
        const int c = p0 - 4096, w = c & 31;
        if (w < 8) { const f32x4 cs = *(const f32x4*)(tab32), sn = *(const f32x4*)(tab32 + 4);
#pragma unroll
            for (int j = 0; j < 4; ++j) { const float x1 = v[2 * j], x2 = v[2 * j + 1]; v[2 * j] = x1 * cs[j] - x2 * sn[j]; v[2 * j + 1] = x2 * cs[j] + x1 * sn[j]; } }
        store8(WSP(bf16, WS_IQ) + (size_t)t * 256 + c, v);
    } else {
        const int j0 = p0 - 4352;
        if (j0 < 64) { if (j0 < 16) rope8_64(v, tab64, j0 >> 1); store8(WSP(bf16, WS_AK) + (size_t)t * 64 + j0, v); }
        else if (j0 < 128) { store8(WSP(bf16, WS_AV) + (size_t)t * 64 + (j0 - 64), v); }
        else if (j0 < 160) { const int w = j0 - 128;
            if (w < 8) { const f32x4 cs = *(const f32x4*)(tab32), sn = *(const f32x4*)(tab32 + 4);
#pragma unroll
                for (int j = 0; j < 4; ++j) { const float x1 = v[2 * j], x2 = v[2 * j + 1]; v[2 * j] = x1 * cs[j] - x2 * sn[j]; v[2 * j + 1] = x2 * cs[j] + x1 * sn[j]; } }
            store8(WSP(bf16, WS_IK) + (size_t)t * 32 + w, v); }
        else if (j0 == 160) { float* o = WSP(float, WS_IW) + (size_t)t * 8; *(f32x4*)o = (f32x4){v[0] * 0.0625f, v[1] * 0.0625f, v[2] * 0.0625f, v[3] * 0.0625f}; *(f32x4*)(o + 4) = (f32x4){v[4] * 0.0625f, v[5] * 0.0625f, v[6] * 0.0625f, v[7] * 0.0625f}; }
    }
}

__global__ void k_ln_in(Bufs B) {
    const int lane = threadIdx.x & 63, row = blockIdx.x * 4 + (threadIdx.x >> 6);
    const f32x4* xr = (const f32x4*)(B.x + (size_t)row * D) + lane;
    f32x4 v[4]; float s = 0.f;
#pragma unroll
    for (int j = 0; j < 4; ++j) { v[j] = xr[64 * j]; s += (v[j].x + v[j].y) + (v[j].z + v[j].w); }
#pragma unroll
    for (int o = 1; o < 64; o <<= 1) s += __shfl_xor(s, o);
    const float mean = s * (1.f / D); float s2 = 0.f;
#pragma unroll
    for (int j = 0; j < 4; ++j) { v[j] = v[j] - mean; s2 += (v[j].x * v[j].x + v[j].y * v[j].y) + (v[j].z * v[j].z + v[j].w * v[j].w); }
#pragma unroll
    for (int o = 1; o < 64; o <<= 1) s2 += __shfl_xor(s2, o);
    const float rstd = rsqrtf(s2 * (1.f / D) + LN_EPS);
    if (lane == 0) { float* st = WSP(float, WS_STATS) + (size_t)row * 2; st[0] = mean; st[1] = rstd; }
    unsigned long long* o8 = (unsigned long long*)(WSP(bf16, WS_XN) + (size_t)row * D) + lane;
#pragma unroll
    for (int j = 0; j < 4; ++j) { const f32x4 g = *((const f32x4*)B.ln_in_g + lane + 64 * j), b = *((const f32x4*)B.ln_in_b + lane + 64 * j);
        const f32x4 y = v[j] * rstd * g + b;
        o8[64 * j] = (unsigned long long)pk2(y.x, y.y) | ((unsigned long long)pk2(y.z, y.w) << 32); }
}
__device__ __forceinline__ float wsrc(const Bufs& B, int kind, int k, int n) {
    switch (kind) {
    case 0: { const int o = orig_of_pos(n); return o < 0 ? 0.f : B.w_in[(size_t)k * IN_WIDTH + o]; }
    case 1: return B.w_in[(size_t)k * IN_WIDTH + O_MG + n];
    case 2: return B.w_mem_kv[(size_t)k * 1024 + n];
    case 3: return k < 512 ? B.w_proj_a[(size_t)k * 1024 + n] : B.w_proj_b[(size_t)(k - 512) * 1024 + n];
    case 4: return k < 512 ? B.w_proj_c[(size_t)k * 1024 + n] : 0.f;
    default: return B.w_out[(size_t)k * 1024 + n];
    }
}
__global__ void k_wconv(Bufs B, int kind, int N, size_t dst_off) {
    __shared__ float scr[64][33];
    const int n0 = blockIdx.x * 32, k0 = blockIdx.y * 64, tx = threadIdx.x & 31, ty = threadIdx.x >> 5;
    for (int kk = ty; kk < 64; kk += 8) scr[kk][tx] = wsrc(B, kind, k0 + kk, n0 + tx);
    __syncthreads();
    bf16* dst = WSP(bf16, dst_off);
    const int n = threadIdx.x >> 3, c = threadIdx.x & 7;
    v4u o; o.x = pk2(scr[8 * c + 0][n], scr[8 * c + 1][n]); o.y = pk2(scr[8 * c + 2][n], scr[8 * c + 3][n]); o.z = pk2(scr[8 * c + 4][n], scr[8 * c + 5][n]); o.w = pk2(scr[8 * c + 6][n], scr[8 * c + 7][n]);
    *(v4u*)(dst + (size_t)(n0 + n) * 1024 + k0 + 8 * c) = o;
    (void)N;
}
__global__ void k_misc(Bufs B) {
    const int gid = blockIdx.x * blockDim.x + threadIdx.x, nth = gridDim.x * blockDim.x;
    for (int i = gid; i < MM * D / 4; i += nth) { const f32x4 v = ((const f32x4*)B.mem)[i]; unsigned long long o = (unsigned long long)pk2(v.x, v.y) | ((unsigned long long)pk2(v.z, v.w) << 32); ((unsigned long long*)WSP(bf16, WS_MEMB))[i] = o; }
    for (int i = gid; i < SEQ * 8; i += nth) { const int pos = i >> 3, f = i & 7;
        const float inv = powf(500000.0f, -(float)f * 0.125f); const float ang = (float)pos * inv;
        float* t64 = WSP(float, WS_TAB) + pos * 16; t64[f] = cosf(ang); t64[8 + f] = sinf(ang);
        if ((f & 1) == 0) { float* t32 = WSP(float, WS_TAB32) + pos * 8; t32[f >> 1] = cosf(ang); t32[4 + (f >> 1)] = sinf(ang); } }
    if (gid == 0) { float a = 0.f, b = 0.f; for (int i = 0; i < 64; ++i) { a += B.diff_lambda[i] * B.diff_lambda[64 + i]; b += B.diff_lambda[128 + i] * B.diff_lambda[192 + i]; }
        *WSP(float, WS_LAM) = expf(a) - expf(b) + LAM_INIT; }
}

template <class Epi> __global__ void __launch_bounds__(256) k_ngemm(const bf16* A, const bf16* Bt, int lda, int ldb, int K, int pad_, Epi E) {
    (void)pad_;
    __shared__ float As[32][65], Bs[32][129];
    const int t0 = blockIdx.y * 64, p0 = blockIdx.x * 128, tx = threadIdx.x & 15, ty = threadIdx.x >> 4;
    float acc[4][8];
#pragma unroll
    for (int i = 0; i < 4; ++i)
#pragma unroll
        for (int j = 0; j < 8; ++j) acc[i][j] = 0.f;
    for (int k0 = 0; k0 < K; k0 += 32) {
        for (int e = threadIdx.x; e < 64 * 32; e += 256) { const int r = e >> 5, c = e & 31; As[c][r] = bf2f(A[(size_t)(t0 + r) * lda + k0 + c]); }
        for (int e = threadIdx.x; e < 128 * 32; e += 256) { const int r = e >> 5, c = e & 31; Bs[c][r] = bf2f(Bt[(size_t)(p0 + r) * ldb + k0 + c]); }
        __syncthreads();
#pragma unroll 4
        for (int kk = 0; kk < 32; ++kk) { float a[4], b[8];
#pragma unroll
            for (int i = 0; i < 4; ++i) a[i] = As[kk][ty * 4 + i];
#pragma unroll
            for (int j = 0; j < 8; ++j) b[j] = Bs[kk][tx * 8 + j];
#pragma unroll
            for (int i = 0; i < 4; ++i)
#pragma unroll
                for (int j = 0; j < 8; ++j) acc[i][j] += a[i] * b[j]; }
        __syncthreads();
    }
#pragma unroll
    for (int i = 0; i < 4; ++i) E(t0 + ty * 4 + i, p0 + tx * 8, acc[i]);
}
struct EpiInproj { Bufs B; __device__ void operator()(int t, int p0, float* v) const { inproj_emit8(B, t, p0, v); } };
struct EpiPlainBf16 { bf16* O; int ldo; int pad; __device__ void operator()(int t, int p0, float* v) const { store8(O + (size_t)t * ldo + p0, v); } };
struct EpiGate { bf16* O; __device__ void operator()(int t, int p0, float* v) const { float g[8];
#pragma unroll
    for (int j = 0; j < 8; ++j) g[j] = sigmoid_f(v[j]); store8(O + (size_t)t * 1024 + p0, g); } };
struct EpiYacc { const bf16* G; float* acc; int first; int pad; __device__ void operator()(int t, int p0, float* v) const {
    const v4u gw = *(const v4u*)(G + (size_t)t * 1024 + p0); float* a = acc + (size_t)t * 1024 + p0;
    const unsigned gg[4] = {gw.x, gw.y, gw.z, gw.w};
#pragma unroll
    for (int j = 0; j < 8; ++j) { const float g = bf2f((gg[j >> 1] >> (16 * (j & 1))) & 0xffffu); const float r = g * v[j]; a[j] = first ? r : a[j] + r; } } };
struct EpiOut { Bufs B; __device__ void operator()(int t, int p0, float* v) const {
    const float* st = WSP(const float, WS_STATS) + (size_t)t * 2; const float mean = st[0], rstd = st[1];
    float* o = B.out + (size_t)t * 1024 + p0; const float* xr = B.x + (size_t)t * 1024 + p0;
#pragma unroll
    for (int j = 0; j < 8; ++j) { const float h = (xr[j] - mean) * rstd * B.ln_in_g[p0 + j] + B.ln_in_b[p0 + j]; o[j] = ALPHA * h + v[j]; } } };
__global__ void k_f32_to_bf16(const float* src, bf16* dst, size_t n4) {
    for (size_t i = (size_t)blockIdx.x * blockDim.x + threadIdx.x; i < n4; i += (size_t)gridDim.x * blockDim.x) { const f32x4 v = ((const f32x4*)src)[i];
        ((unsigned long long*)dst)[i] = (unsigned long long)pk2(v.x, v.y) | ((unsigned long long)pk2(v.z, v.w) << 32); }
}
__global__ void k_ln_out(Bufs B) {
    const int lane = threadIdx.x & 63, row = blockIdx.x * 4 + (threadIdx.x >> 6);
    f32x4* xr = (f32x4*)(B.out + (size_t)row * D) + lane;
    f32x4 v[4]; float s = 0.f;
#pragma unroll
    for (int j = 0; j < 4; ++j) { v[j] = xr[64 * j]; s += (v[j].x + v[j].y) + (v[j].z + v[j].w); }
#pragma unroll
    for (int o = 1; o < 64; o <<= 1) s += __shfl_xor(s, o);
    const float mean = s * (1.f / D); float s2 = 0.f;
#pragma unroll
    for (int j = 0; j < 4; ++j) { v[j] = v[j] - mean; s2 += (v[j].x * v[j].x + v[j].y * v[j].y) + (v[j].z * v[j].z + v[j].w * v[j].w); }
#pragma unroll
    for (int o = 1; o < 64; o <<= 1) s2 += __shfl_xor(s2, o);
    const float rstd = rsqrtf(s2 * (1.f / D) + LN_EPS);
#pragma unroll
    for (int j = 0; j < 4; ++j) { const f32x4 g = *((const f32x4*)B.ln_g + lane + 64 * j), b = *((const f32x4*)B.ln_b + lane + 64 * j); xr[64 * j] = v[j] * rstd * g + b; }
}

__device__ __forceinline__ unsigned sortable_key(float score, int idx) {
    const unsigned b = __float_as_uint(score); const unsigned k = b ^ ((unsigned)((int)b >> 31) | 0x80000000u);
    return (k & ~0x7FFu) | (unsigned)(2047 - idx);
}
__device__ __forceinline__ float block_sum(float v, float* red) {
#pragma unroll
    for (int o = 1; o < 64; o <<= 1) v += __shfl_xor(v, o);
    __syncthreads(); if ((threadIdx.x & 63) == 0) red[threadIdx.x >> 6] = v; __syncthreads();
    return red[0] + red[1] + red[2] + red[3];
}
__device__ __forceinline__ float block_max(float v, float* red) {
#pragma unroll
    for (int o = 1; o < 64; o <<= 1) v = fmaxf(v, __shfl_xor(v, o));
    __syncthreads(); if ((threadIdx.x & 63) == 0) red[threadIdx.x >> 6] = v; __syncthreads();
    return fmaxf(fmaxf(red[0], red[1]), fmaxf(red[2], red[3]));
}
__global__ void __launch_bounds__(256) k_nmask(Bufs B) {
    __shared__ unsigned keys[SEQ]; __shared__ float iq[256]; __shared__ float iw[8]; __shared__ unsigned cnts[4]; __shared__ unsigned tau_s;
    const int row = blockIdx.x, b = row >> 11, t = row & (SEQ - 1), limit = ((t >> 6) + 1) << 6, tid = threadIdx.x;
    iq[tid] = bf2f(WSP(const bf16, WS_IQ)[(size_t)row * 256 + tid]); if (tid < 8) iw[tid] = WSP(const float, WS_IW)[(size_t)row * 8 + tid];
    __syncthreads();
    const bf16* IK = WSP(const bf16, WS_IK) + (size_t)b * SEQ * 32;
    for (int s = tid; s < limit; s += 256) { float kk[32];
#pragma unroll
        for (int d = 0; d < 32; ++d) kk[d] = bf2f(IK[(size_t)s * 32 + d]);
        float sc = 0.f;
        for (int h = 0; h < 8; ++h) { float dt = 0.f;
#pragma unroll
            for (int d = 0; d < 32; ++d) dt += iq[h * 32 + d] * kk[d];
            sc += iw[h] * fmaxf(dt, 0.f); }
        keys[s] = sortable_key(sc, s); }
    __syncthreads();
    unsigned tau = 1u;
    if (limit > 256) { unsigned lo = 1u, hi = 0xFFFFFFFFu;
        for (;;) { if (hi - lo <= 1u) { tau = lo; break; }
            const unsigned mid = lo + ((hi - lo) >> 1); unsigned c = 0;
            for (int s = tid; s < limit; s += 256) c += (keys[s] >= mid) ? 1u : 0u;
#pragma unroll
            for (int o = 1; o < 64; o <<= 1) c += __shfl_xor(c, o);
            __syncthreads(); if ((tid & 63) == 0) cnts[tid >> 6] = c; __syncthreads();
            const unsigned tot = cnts[0] + cnts[1] + cnts[2] + cnts[3];
            if (tot == 256u) { tau = mid; break; } else if (tot > 256u) lo = mid; else hi = mid; } }
    if (tid < 64) { unsigned w = 0; for (int j = 0; j < 32; ++j) { const int s = tid * 32 + j; if (s < limit && keys[s] >= tau) w |= 1u << j; }
        WSP(unsigned, WS_MASK)[(size_t)row * 64 + tid] = w; }
}
__global__ void __launch_bounds__(256) k_nattnA(Bufs B) {
    __shared__ float q[64]; __shared__ float p[SEQ]; __shared__ float red[4];
    const int row = blockIdx.x >> 3, h = blockIdx.x & 7, b = row >> 11, t = row & (SEQ - 1), limit = ((t >> 6) + 1) << 6, tid = threadIdx.x;
    bf16* Q = WSP(bf16, WS_QAB) + (size_t)row * 1024 + h * 64;
    if (tid < 64) q[tid] = bf2f(Q[tid]);
    __syncthreads();
    const bf16* K = WSP(const bf16, WS_AK) + (size_t)b * SEQ * 64; const bf16* V = WSP(const bf16, WS_AV) + (size_t)b * SEQ * 64;
    const unsigned* mk = WSP(const unsigned, WS_MASK) + (size_t)row * 64;
    float mx = -INFINITY;
    for (int s = tid; s < limit; s += 256) { float l = -INFINITY;
        if ((mk[s >> 5] >> (s & 31)) & 1u) { l = 0.f; for (int d = 0; d < 64; ++d) l += q[d] * bf2f(K[(size_t)s * 64 + d]); }
        p[s] = l; mx = fmaxf(mx, l); }
    mx = block_max(mx, red);
    float sm = 0.f;
    for (int s = tid; s < limit; s += 256) { const float e = exp2f(p[s] - mx); p[s] = e; sm += e; }
    sm = block_sum(sm, red);
    __syncthreads();
    const int d = tid & 63, g = tid >> 6; float o = 0.f;
    for (int s = g; s < limit; s += 4) o += p[s] * bf2f(V[(size_t)s * 64 + d]);
    __shared__ float og[4][64]; og[g][d] = o; __syncthreads();
    if (tid < 64) { const float ov = (og[0][tid] + og[1][tid] + og[2][tid] + og[3][tid]) / sm; const float gate = bf2f(WSP(const bf16, WS_AG)[(size_t)row * 512 + h * 64 + tid]);
        Q[tid] = (bf16)f2bf(ov * gate); }
}
__global__ void __launch_bounds__(256) k_nattnB(Bufs B) {
    __shared__ float q[128]; __shared__ float p0[SEQ]; __shared__ float p1[SEQ]; __shared__ float red[4]; __shared__ float og[2][128];
    const int row = blockIdx.x >> 2, h = blockIdx.x & 3, b = row >> 11, t = row & (SEQ - 1), limit = ((t >> 6) + 1) << 6, tid = threadIdx.x;
    bf16* Q = WSP(bf16, WS_QAB) + (size_t)row * 1024 + 512 + h * 128;
    if (tid < 128) q[tid] = bf2f(Q[tid]);
    __syncthreads();
    const bf16* K = WSP(const bf16, WS_BK) + (size_t)b * SEQ * 512 + h * 128; const bf16* V = WSP(const bf16, WS_BV) + (size_t)b * SEQ * 512 + h * 128;
    const float lam = *WSP(const float, WS_LAM);
    float m0 = -INFINITY, m1 = -INFINITY;
    for (int s = tid; s < limit; s += 256) { float l0 = 0.f, l1 = 0.f;
        for (int d = 0; d < 64; ++d) { l0 += q[d] * bf2f(K[(size_t)s * 512 + d]); l1 += q[64 + d] * bf2f(K[(size_t)s * 512 + 64 + d]); }
        p0[s] = l0; p1[s] = l1; m0 = fmaxf(m0, l0); m1 = fmaxf(m1, l1); }
    m0 = block_max(m0, red); m1 = block_max(m1, red);
    float s0 = 0.f, s1 = 0.f;
    for (int s = tid; s < limit; s += 256) { const float e0 = exp2f(p0[s] - m0), e1 = exp2f(p1[s] - m1); p0[s] = e0; p1[s] = e1; s0 += e0; s1 += e1; }
    s0 = block_sum(s0, red); s1 = block_sum(s1, red);
    __syncthreads();
    for (int s = tid; s < limit; s += 256) p0[s] = p0[s] / s0 - lam * (p1[s] / s1);
    __syncthreads();
    const int e = tid & 127, g = tid >> 7; float o = 0.f;
    for (int s = g; s < limit; s += 2) o += p0[s] * bf2f(V[(size_t)s * 512 + e]);
    og[g][e] = o; __syncthreads();
    float ov = 0.f, sq = 0.f; if (tid < 128) { ov = og[0][tid] + og[1][tid]; sq = ov * ov; }
    sq = block_sum(sq, red);
    if (tid < 128) { const float r = rsqrtf(sq * (1.f / 128.f) + LN_EPS); const float gate = bf2f(WSP(const bf16, WS_BG)[(size_t)row * 512 + h * 128 + tid]);
        Q[tid] = (bf16)f2bf(ov * r * B.diff_norm_g[tid] * (1.f - LAM_INIT) * gate); }
}
__global__ void __launch_bounds__(128) k_nattnC(Bufs B) {
    __shared__ float q[128]; __shared__ float p[MEM_LEN]; __shared__ float red2[2];
    const int row = blockIdx.x >> 2, h = blockIdx.x & 3, b = row >> 11, tid = threadIdx.x;
    bf16* Q = WSP(bf16, WS_QC) + (size_t)row * 1024 + h * 128;
    q[tid] = bf2f(Q[tid]);
    __syncthreads();
    const bf16* KV = WSP(const bf16, WS_MKV) + (size_t)b * MEM_LEN * 1024;
    float mx = -INFINITY;
    for (int m = tid; m < MEM_LEN; m += 128) { float l = 0.f; for (int d = 0; d < 128; ++d) l += q[d] * bf2f(KV[(size_t)m * 1024 + h * 128 + d]); p[m] = l; mx = fmaxf(mx, l); }
#pragma unroll
    for (int o = 1; o < 64; o <<= 1) mx = fmaxf(mx, __shfl_xor(mx, o));
    __syncthreads(); if ((tid & 63) == 0) red2[tid >> 6] = mx; __syncthreads(); mx = fmaxf(red2[0], red2[1]);
    float sm = 0.f;
    for (int m = tid; m < MEM_LEN; m += 128) { const float e = exp2f(p[m] - mx); p[m] = e; sm += e; }
#pragma unroll
    for (int o = 1; o < 64; o <<= 1) sm += __shfl_xor(sm, o);
    __syncthreads(); if ((tid & 63) == 0) red2[tid >> 6] = sm; __syncthreads(); sm = red2[0] + red2[1];
    float o = 0.f;
    for (int m = 0; m < MEM_LEN; ++m) o += p[m] * bf2f(KV[(size_t)m * 1024 + 512 + h * 128 + tid]);
    const float gate = bf2f(WSP(const bf16, WS_QC)[(size_t)row * 1024 + 512 + h * 128 + tid]);
    Q[tid] = (bf16)f2bf(o / sm * gate);
}

extern "C" void kernel_launch(void* const* d_in, const int* in_sizes, int n_in, void* d_out, int out_size, void* d_ws, size_t ws_size, hipStream_t stream) {
    (void)in_sizes; (void)n_in; (void)out_size;
    if (ws_size < WS_END) { fprintf(stderr, "workspace too small: %zu < %zu\n", ws_size, (size_t)WS_END); return; }
    Bufs B{};
    B.x = (const float*)d_in[0]; B.mem = (const float*)d_in[1]; B.ln_in_g = (const float*)d_in[2]; B.ln_in_b = (const float*)d_in[3]; B.w_in = (const float*)d_in[4];
    B.w_mem_kv = (const float*)d_in[5]; B.diff_lambda = (const float*)d_in[6]; B.diff_norm_g = (const float*)d_in[7]; B.w_proj_a = (const float*)d_in[8];
    B.w_proj_b = (const float*)d_in[9]; B.w_proj_c = (const float*)d_in[10]; B.w_out = (const float*)d_in[11]; B.ln_g = (const float*)d_in[12]; B.ln_b = (const float*)d_in[13];
    B.out = (float*)d_out; B.ws = (unsigned char*)d_ws;
    unsigned char* ws = B.ws;
    k_ln_in<<<M / 4, 256, 0, stream>>>(B);
    k_wconv<<<dim3(NPOS / 32, 16), 256, 0, stream>>>(B, 0, NPOS, WS_WIN);
    k_wconv<<<dim3(3072 / 32, 16), 256, 0, stream>>>(B, 1, 3072, WS_WMG);
    k_wconv<<<dim3(1024 / 32, 16), 256, 0, stream>>>(B, 2, 1024, WS_WMEM);
    k_wconv<<<dim3(1024 / 32, 16), 256, 0, stream>>>(B, 3, 1024, WS_WAB);
    k_wconv<<<dim3(1024 / 32, 16), 256, 0, stream>>>(B, 4, 1024, WS_WC);
    k_wconv<<<dim3(1024 / 32, 16), 256, 0, stream>>>(B, 5, 1024, WS_WOUT);
    k_misc<<<256, 256, 0, stream>>>(B);
    k_ngemm<EpiInproj><<<dim3(NPOS / 128, M / 64), 256, 0, stream>>>((const bf16*)(ws + WS_XN), (const bf16*)(ws + WS_WIN), 1024, 1024, 1024, 0, EpiInproj{B});
    k_ngemm<EpiPlainBf16><<<dim3(1024 / 128, MM / 64), 256, 0, stream>>>((const bf16*)(ws + WS_MEMB), (const bf16*)(ws + WS_WMEM), 1024, 1024, 1024, 0, EpiPlainBf16{(bf16*)(ws + WS_MKV), 1024, 0});
    k_nmask<<<M, 256, 0, stream>>>(B);
    k_nattnA<<<M * 8, 256, 0, stream>>>(B);
    k_nattnB<<<M * 4, 256, 0, stream>>>(B);
    k_nattnC<<<M * 4, 128, 0, stream>>>(B);
    for (int br = 0; br < 3; ++br) {
        k_ngemm<EpiGate><<<dim3(1024 / 128, M / 64), 256, 0, stream>>>((const bf16*)(ws + WS_XN), (const bf16*)(ws + WS_WMG) + (size_t)br * 1024 * 1024, 1024, 1024, 1024, 0, EpiGate{(bf16*)(ws + WS_GTMP)});
        const bf16* A = br < 2 ? (const bf16*)(ws + WS_QAB) + br * 512 : (const bf16*)(ws + WS_QC);
        const bf16* Bt = br < 2 ? (const bf16*)(ws + WS_WAB) + br * 512 : (const bf16*)(ws + WS_WC);
        k_ngemm<EpiYacc><<<dim3(1024 / 128, M / 64), 256, 0, stream>>>(A, Bt, 1024, 1024, 512, 0, EpiYacc{(const bf16*)(ws + WS_GTMP), (float*)d_out, br == 0 ? 1 : 0, 0});
    }
    k_f32_to_bf16<<<2048, 256, 0, stream>>>((const float*)d_out, (bf16*)(ws + WS_MERGED), (size_t)M * 1024 / 4);
    k_ngemm<EpiOut><<<dim3(1024 / 128, M / 64), 256, 0, stream>>>((const bf16*)(ws + WS_MERGED), (const bf16*)(ws + WS_WOUT), 1024, 1024, 1024, 0, EpiOut{B});
    k_ln_out<<<M / 4, 256, 0, stream>>>(B);
}
```

```cpp
#include <hip/hip_runtime.h>
#include <hip/hip_bf16.h>
#include <cstdint>
#include <cstdio>
#include <cmath>

typedef unsigned short bf16;
typedef unsigned v4u __attribute__((ext_vector_type(4)));
typedef float f32x4 __attribute__((ext_vector_type(4)));

constexpr int D = 1024, BATCH = 16, SEQ = 2048, M = BATCH * SEQ;
constexpr int MEM_LEN = 256, MM = BATCH * MEM_LEN;
constexpr int IN_WIDTH = 7592;
constexpr int NPOS = 4608;
constexpr int O_AQ = 0, O_AK = 512, O_AV = 576, O_AG = 640, O_IQ = 1152, O_IK = 1408, O_IW = 1440, O_BQ = 1448, O_BK = 1960, O_BV = 2472,
              O_BG = 2984, O_CQ = 3496, O_CG = 4008, O_MG = 4520;
constexpr float LN_EPS = 1e-5f;
constexpr float LOG2E = 1.4426950408889634f;
constexpr float ALPHA = 1.189207115002721f;
constexpr float LAM_INIT = 0.2f;

constexpr size_t MiB = 1u << 20;
constexpr size_t WS_CTL = 0;
constexpr size_t WS_TAB = 1 * MiB;
constexpr size_t WS_TAB32 = WS_TAB + 128 * 1024;
constexpr size_t WS_LAM = WS_TAB + 256 * 1024;
constexpr size_t WS_STATS = WS_TAB + 512 * 1024;
constexpr size_t WS_WIN = 2 * MiB;
constexpr size_t WS_WMG = 11 * MiB;
constexpr size_t WS_WMEM = 17 * MiB;
constexpr size_t WS_WAB = 19 * MiB;
constexpr size_t WS_WC = 21 * MiB;
constexpr size_t WS_WOUT = 23 * MiB;
constexpr size_t WS_MEMB = 25 * MiB;
constexpr size_t WS_MKV = 33 * MiB;
constexpr size_t WS_XN = 41 * MiB;
constexpr size_t WS_QAB = 105 * MiB;
constexpr size_t WS_QC = 169 * MiB;
constexpr size_t WS_AG = 233 * MiB;
constexpr size_t WS_BK = 265 * MiB;
constexpr size_t WS_BV = 297 * MiB;
constexpr size_t WS_BG = 329 * MiB;
constexpr size_t WS_IQ = 361 * MiB;
constexpr size_t WS_AK = 377 * MiB;
constexpr size_t WS_AV = 381 * MiB;
constexpr size_t WS_IK = 385 * MiB;
constexpr size_t WS_IW = 387 * MiB;
constexpr size_t WS_MASK = 388 * MiB;
constexpr size_t WS_MERGED = WS_BK;
constexpr size_t WS_GTMP = WS_BG;
constexpr size_t WS_END = 400 * MiB;

__device__ __forceinline__ unsigned f2bf(float f) { unsigned u = __float_as_uint(f); return (u + 0x7fffu + ((u >> 16) & 1u)) >> 16; }
__device__ __forceinline__ float bf2f(unsigned v) { return __uint_as_float(v << 16); }
__device__ __forceinline__ unsigned pk2(float lo, float hi) { return f2bf(lo) | (f2bf(hi) << 16); }
__device__ __forceinline__ float silu_f(float x) { return x / (1.f + __expf(-x)); }
__device__ __forceinline__ float sigmoid_f(float x) { return 1.f / (1.f + __expf(-x)); }

__host__ __device__ __forceinline__ int rp64(int j) { return j < 16 ? ((j >> 1) + 8 * (j & 1)) : j; }
__host__ __device__ __forceinline__ int rp32(int j) { return j < 8 ? ((j >> 1) + 4 * (j & 1)) : j; }
__host__ __device__ __forceinline__ int orig_of_pos(int p) {
    const int tile = p >> 8;
    if (tile < 2) { return O_AQ + (p & ~63) + rp64(p & 63); }
    if (tile < 4) { return O_AG + (p - 512); }
    if (tile < 6) { const int c = p - 1024; return O_BQ + (c & ~63) + rp64(c & 63); }
    if (tile < 8) { const int c = p - 1536; return O_BK + (c & ~63) + rp64(c & 63); }
    if (tile < 10) { return O_BV + (p - 2048); }
    if (tile < 12) { return O_BG + (p - 2560); }
    if (tile < 14) { return O_CQ + (p - 3072); }
    if (tile < 16) { return O_CG + (p - 3584); }
    if (tile == 16) { const int c = p - 4096; return O_IQ + (c & ~31) + rp32(c & 31); }
    const int j = p - 4352;
    if (j < 64) return O_AK + rp64(j);
    if (j < 128) return O_AV + (j - 64);
    if (j < 160) return O_IK + rp32(j - 128);
    if (j < 168) return O_IW + (j - 160);
    return -1;
}

struct Bufs {
    const float *x, *mem, *ln_in_g, *ln_in_b, *w_in, *w_mem_kv, *diff_lambda, *diff_norm_g, *w_proj_a, *w_proj_b, *w_proj_c, *w_out, *ln_g, *ln_b;
    float* out; unsigned char* ws;
};
#define WSP(T, off) ((T*)(B.ws + (off)))

__device__ __forceinline__ void rope8_64(float* v, const float* tab, int i0) {
    const f32x4 c = *(const f32x4*)(tab + i0), s = *(const f32x4*)(tab + 8 + i0);
#pragma unroll
    for (int j = 0; j < 4; ++j) { const float x1 = v[2 * j], x2 = v[2 * j + 1]; v[2 * j] = x1 * c[j] - x2 * s[j]; v[2 * j + 1] = x2 * c[j] + x1 * s[j]; }
}
__device__ __forceinline__ void store8(bf16* dst, const float* v) {
    v4u o; o.x = pk2(v[0], v[1]); o.y = pk2(v[2], v[3]); o.z = pk2(v[4], v[5]); o.w = pk2(v[6], v[7]); *(v4u*)dst = o;
}
enum { K_AQ = 0, K_AG, K_BQ, K_BK, K_BV, K_BG, K_CQ, K_CG, K_IQ, K_MISC };
__host__ __device__ __forceinline__ int kind_of_tile(int tile) { return tile < 16 ? (tile >> 1) : (tile == 16 ? K_IQ : K_MISC); }
__device__ __forceinline__ void rope8_32(float* v, const float* tab32) {
    const f32x4 cs = *(const f32x4*)(tab32), sn = *(const f32x4*)(tab32 + 4);
#pragma unroll
    for (int j = 0; j < 4; ++j) { const float x1 = v[2 * j], x2 = v[2 * j + 1]; v[2 * j] = x1 * cs[j] - x2 * sn[j]; v[2 * j + 1] = x2 * cs[j] + x1 * sn[j]; }
}
template <int KIND> __device__ __forceinline__ void emit8k(const Bufs& B, int t, int c, float* v) {
    const int pos = t & (SEQ - 1);
    const float* tab64 = WSP(const float, WS_TAB) + pos * 16;
    const float* tab32 = WSP(const float, WS_TAB32) + pos * 8;
    const float SQ64 = 0.125f * LOG2E, SQ128 = 0.08838834764831845f * LOG2E;
    if constexpr (KIND == K_AQ || KIND == K_BQ) {
        const int w = c & 63; if (w < 16) rope8_64(v, tab64, w >> 1);
#pragma unroll
        for (int j = 0; j < 8; ++j) v[j] *= SQ64;
        store8(WSP(bf16, WS_QAB) + (size_t)t * 1024 + (KIND == K_BQ ? 512 : 0) + c, v);
    } else if constexpr (KIND == K_AG || KIND == K_BG) {
#pragma unroll
        for (int j = 0; j < 8; ++j) v[j] = silu_f(v[j]);
        store8(WSP(bf16, KIND == K_AG ? WS_AG : WS_BG) + (size_t)t * 512 + c, v);
    } else if constexpr (KIND == K_BK) {
        const int w = c & 63; if (w < 16) rope8_64(v, tab64, w >> 1);
        store8(WSP(bf16, WS_BK) + (size_t)t * 512 + c, v);
    } else if constexpr (KIND == K_BV) {
        store8(WSP(bf16, WS_BV) + (size_t)t * 512 + c, v);
    } else if constexpr (KIND == K_CQ) {
#pragma unroll
        for (int j = 0; j < 8; ++j) v[j] *= SQ128;
        store8(WSP(bf16, WS_QC) + (size_t)t * 1024 + c, v);
    } else if constexpr (KIND == K_CG) {
#pragma unroll
        for (int j = 0; j < 8; ++j) v[j] = silu_f(v[j]);
        store8(WSP(bf16, WS_QC) + (size_t)t * 1024 + 512 + c, v);
    } else if constexpr (KIND == K_IQ) {
        if ((c & 31) < 8) rope8_32(v, tab32);
        store8(WSP(bf16, WS_IQ) + (size_t)t * 256 + c, v);
    } else {
        if (c < 64) { if (c < 16) rope8_64(v, tab64, c >> 1); store8(WSP(bf16, WS_AK) + (size_t)t * 64 + c, v); }
        else if (c < 128) { store8(WSP(bf16, WS_AV) + (size_t)t * 64 + (c - 64), v); }
        else if (c < 160) { const int w = c - 128; if (w < 8) rope8_32(v, tab32); store8(WSP(bf16, WS_IK) + (size_t)t * 32 + w, v); }
        else if (c == 160) { float* o = WSP(float, WS_IW) + (size_t)t * 8; *(f32x4*)o = (f32x4){v[0] * 0.0625f, v[1] * 0.0625f, v[2] * 0.0625f, v[3] * 0.0625f}; *(f32x4*)(o + 4) = (f32x4){v[4] * 0.0625f, v[5] * 0.0625f, v[6] * 0.0625f, v[7] * 0.0625f}; }
    }
}
__device__ __forceinline__ void inproj_emit8(const Bufs& B, int t, int p0, float* v) {
    const int tile = p0 >> 8, c = (tile < 16) ? (p0 & 511) : (p0 & 255);
    switch (kind_of_tile(tile)) {
    case K_AQ: emit8k<K_AQ>(B, t, c, v); break;  case K_AG: emit8k<K_AG>(B, t, c, v); break;
    case K_BQ: emit8k<K_BQ>(B, t, c, v); break;  case K_BK: emit8k<K_BK>(B, t, c, v); break;
    case K_BV: emit8k<K_BV>(B, t, c, v); break;  case K_BG: emit8k<K_BG>(B, t, c, v); break;
    case K_CQ: emit8k<K_CQ>(B, t, c, v); break;  case K_CG: emit8k<K_CG>(B, t, c, v); break;
    case K_IQ: emit8k<K_IQ>(B, t, c, v); break;  default:   emit8k<K_MISC>(B, t, c, v); break;
    }
}
__device__ __forceinline__ float wsrc(const Bufs& B, int kind, int k, int n) {
    switch (kind) {
    case 0: { const int o = orig_of_pos(n); return o < 0 ? 0.f : B.w_in[(size_t)k * IN_WIDTH + o]; }
    case 1: return B.w_in[(size_t)k * IN_WIDTH + O_MG + n];
    case 2: return B.w_mem_kv[(size_t)k * 1024 + n];
    case 3: return k < 512 ? B.w_proj_a[(size_t)k * 1024 + n] : B.w_proj_b[(size_t)(k - 512) * 1024 + n];
    case 4: return k < 512 ? B.w_proj_c[(size_t)k * 1024 + n] : 0.f;
    default: return B.w_out[(size_t)k * 1024 + n];
    }
}

namespace pg8 {
#define PG8_LAS __attribute__((address_space(3)))
typedef unsigned short bf16_t;
typedef short bf16x8 __attribute__((ext_vector_type(8)));
typedef float f32x4 __attribute__((ext_vector_type(4)));
typedef unsigned u32x4 __attribute__((ext_vector_type(4)));
constexpr int BM = 256, BK = 64, HALF = 128, HTB = HALF * BK * 2, STAGE_BYTES = 8 * HTB, NXCD = 8, WGM = 8, KP = 1024;
constexpr size_t TSTEP = (size_t)BM * KP * 2;

__host__ __device__ __forceinline__ int lds_byte(int r, int c) { const int st = (r >> 4) * 2 + (c >> 5), rr = r & 15, cc = c & 31, ob = rr * 64 + cc * 2; return st * 1024 + (ob ^ (((ob >> 9) & 1) << 5)); }
__host__ __device__ __forceinline__ void stage_rc(int b, int& R, int& C) { const int st = b / 1024, sb = b % 1024, swz = sb ^ (((sb >> 9) & 1) << 5); R = (st >> 1) * 16 + swz / 64; C = (st & 1) * 32 + (swz % 64) / 2; }
__host__ __device__ __forceinline__ int perm32(int rho) { const int n = rho >> 4, i = rho & 15; return 8 * (i >> 2) + 4 * n + (i & 3); }

struct Unit { int pm, pn; const char* A; const char* B; int nt; int kind; };

struct TileOrder {
    int nM, nN, nwg;
    __host__ __device__ void init(int nM_, int nN_) { nM = nM_; nN = nN_; nwg = nM * nN; }
    __host__ __device__ void tile(int L, int& pm, int& pn) const {
        int wgid = L; { const int q = nwg / NXCD, r = nwg % NXCD, xcd = wgid % NXCD, off = wgid / NXCD; wgid = (xcd < r ? xcd * (q + 1) : r * (q + 1) + (xcd - r) * q) + off; }
        const int nig = WGM * nN, gid = wgid / nig, fm = gid * WGM, gsz = (nM - fm) < WGM ? (nM - fm) : WGM;
        pm = fm + ((wgid % nig) % gsz); pn = (wgid % nig) / gsz;
    }
};
__device__ __forceinline__ unsigned cvt_pk_bf16(float lo, float hi) { unsigned r; asm volatile("v_cvt_pk_bf16_f32 %0, %1, %2" : "=v"(r) : "v"(lo), "v"(hi)); return r; }

template <class Epi, class Sched, bool ALIGN_EPI = false, bool SP2 = false>
__device__ __forceinline__ void gemm_phase(PG8_LAS unsigned char* lds, const Sched& S, const Epi& E) {
    const int tid = threadIdx.x, wid = __builtin_amdgcn_readfirstlane(tid >> 6), lane = tid & 63, wr = wid >> 2, wc = wid & 3, fr = lane & 15, fq = lane >> 4;
    constexpr int K = KP; int nt;
    unsigned voffA[2], voffB[2];
#pragma unroll
    for (int i = 0; i < 2; ++i) { int R, C; stage_rc(tid * 16 + i * 8192, R, C); const int Rb = Epi::PERM ? ((R & ~31) + perm32(R & 31)) : R;
        voffA[i] = (unsigned)(R * K + C) * 2u; voffB[i] = (unsigned)(Rb * K + C) * 2u; }
    const size_t kstep = (size_t)(BK * 2);
    const size_t hstep = (size_t)HALF * K * 2;
    const size_t tstep = 2 * hstep;
    const unsigned ldsw = (unsigned)wid * 1024u;
    const int aoff = lds_byte(wr * 64 + fr, fq * 8), boff = lds_byte(wc * 32 + fr, fq * 8);
#define PG8_SA(b, h) (((b) * 2 + (h)) * HTB)
#define PG8_SB(b, h) ((4 + (b) * 2 + (h)) * HTB)
#define PG8_STAGE(bufoff, gbase, voff) do { _Pragma("unroll") for (int _i = 0; _i < 2; ++_i) \
        __builtin_amdgcn_global_load_lds((const unsigned*)((const char*)(gbase) + (voff)[_i]), (PG8_LAS unsigned*)(lds + (bufoff) + ldsw + _i * 8192), 16, 0, 0); } while (0)
#define PG8_LDA(dst, b, h) do { _Pragma("unroll") for (int m = 0; m < 4; ++m) _Pragma("unroll") for (int k = 0; k < 2; ++k) dst[m][k] = *(const PG8_LAS bf16x8*)(lds + PG8_SA(b, h) + aoff + m * 2048 + k * 1024); } while (0)
#define PG8_LDB(dst, b, h) do { _Pragma("unroll") for (int n = 0; n < 2; ++n) _Pragma("unroll") for (int k = 0; k < 2; ++k) dst[n][k] = *(const PG8_LAS bf16x8*)(lds + PG8_SB(b, h) + boff + n * 2048 + k * 1024); } while (0)
#define PG8_MMA(ai, bj, At, Bt) do { __builtin_amdgcn_s_setprio(1); _Pragma("unroll") for (int m = 0; m < 4; ++m) _Pragma("unroll") for (int n = 0; n < 2; ++n) _Pragma("unroll") for (int k = 0; k < 2; ++k) \
        acc[ai][bj][m][n] = __builtin_amdgcn_mfma_f32_16x16x32_bf16(Bt[n][k], At[m][k], acc[ai][bj][m][n], 0, 0, 0); __builtin_amdgcn_s_setprio(0); } while (0)
#define PG8_WAIT_V(n) asm volatile("s_waitcnt vmcnt(" #n ")" ::: "memory")
#define PG8_WAIT_L(n) asm volatile("s_waitcnt lgkmcnt(" #n ")" ::: "memory")
#define PG8_BAR __builtin_amdgcn_s_barrier()
#define PG8_SCHED __builtin_amdgcn_sched_barrier(0)
    Unit cur, nxt; int ui = 0;
    if (!S.next(0, cur)) return;
    f32x4 acc[2][2][4][2];
#pragma unroll
    for (int a = 0; a < 2; ++a)
#pragma unroll
        for (int b = 0; b < 2; ++b)
#pragma unroll
            for (int m = 0; m < 4; ++m)
#pragma unroll
                for (int n = 0; n < 2; ++n) acc[a][b][m][n] = (f32x4){0.f, 0.f, 0.f, 0.f};
    bf16x8 At[4][2], B0[2][2], B1[2][2];
    const char* cA = cur.A; const char* cB = cur.B; nt = cur.nt;
    S.a_ready(cur);
    if constexpr (SP2) {
        PG8_STAGE(PG8_SB(0, 0), cB, voffB); PG8_STAGE(PG8_SB(0, 1), cB + hstep, voffB); PG8_STAGE(PG8_SA(0, 0), cA, voffA); PG8_STAGE(PG8_SA(0, 1), cA + hstep, voffA);
        if (wr == 1) PG8_BAR;
        PG8_WAIT_V(2); PG8_BAR;
        PG8_STAGE(PG8_SB(1, 0), cB + kstep, voffB); PG8_STAGE(PG8_SA(1, 0), cA + kstep, voffA); PG8_STAGE(PG8_SB(1, 1), cB + hstep + kstep, voffB);
        PG8_WAIT_V(6); PG8_BAR;
    } else {
        PG8_STAGE(PG8_SB(0, 0), cB, voffB); PG8_STAGE(PG8_SA(0, 0), cA, voffA); PG8_STAGE(PG8_SB(0, 1), cB + hstep, voffB); PG8_STAGE(PG8_SA(0, 1), cA + hstep, voffA);
        if (wr == 1) PG8_BAR;
        PG8_WAIT_V(4); PG8_BAR;
        PG8_STAGE(PG8_SB(1, 0), cB + kstep, voffB); PG8_STAGE(PG8_SA(1, 0), cA + kstep, voffA); PG8_STAGE(PG8_SB(1, 1), cB + hstep + kstep, voffB);
        PG8_WAIT_V(6); PG8_BAR;
    }
    for (;;) {
        const bool has_next = S.next(ui + 1, nxt);
        const char* nA = has_next ? nxt.A : cA; const char* nB = has_next ? nxt.B : cB;
        for (int t = 0; t < nt; t += 2) {
            const bool last = (t == nt - 2);
            const char* a1 = cA + (size_t)(t + 1) * kstep;
            const char* a2 = last ? nA : cA + (size_t)(t + 2) * kstep; const char* b2 = last ? nB : cB + (size_t)(t + 2) * kstep;
            const char* a3 = a2 + kstep; const char* b3 = b2 + kstep;
            if (last && has_next) S.a_ready(nxt);
            if constexpr (SP2) {
            PG8_LDB(B0, 0, 0); PG8_LDB(B1, 0, 1); PG8_SCHED; PG8_LDA(At, 0, 0); PG8_STAGE(PG8_SA(1, 1), a1 + hstep, voffA);
            PG8_WAIT_V(8); PG8_WAIT_L(0); PG8_BAR; PG8_MMA(0, 0, At, B0); PG8_MMA(0, 1, At, B1); PG8_BAR; PG8_SCHED;
            PG8_LDA(At, 0, 1); PG8_STAGE(PG8_SB(0, 0), b2, voffB); PG8_STAGE(PG8_SB(0, 1), b2 + hstep, voffB); PG8_STAGE(PG8_SA(0, 0), a2, voffA);
            PG8_WAIT_V(8); PG8_WAIT_L(0); PG8_BAR; PG8_MMA(1, 0, At, B0); PG8_MMA(1, 1, At, B1); PG8_BAR; PG8_SCHED;
            PG8_LDB(B0, 1, 0); PG8_LDB(B1, 1, 1); PG8_SCHED; PG8_LDA(At, 1, 0); PG8_STAGE(PG8_SA(0, 1), a2 + hstep, voffA);
            PG8_WAIT_V(8); PG8_WAIT_L(0); PG8_BAR; PG8_MMA(0, 0, At, B0); PG8_MMA(0, 1, At, B1); PG8_BAR; PG8_SCHED;
            PG8_LDA(At, 1, 1); PG8_STAGE(PG8_SB(1, 0), b3, voffB); PG8_STAGE(PG8_SB(1, 1), b3 + hstep, voffB); PG8_STAGE(PG8_SA(1, 0), a3, voffA);
            PG8_WAIT_V(8); PG8_WAIT_L(0); PG8_BAR; PG8_MMA(1, 0, At, B0); PG8_MMA(1, 1, At, B1); PG8_BAR; PG8_SCHED;
            } else {
            PG8_LDB(B0, 0, 0); PG8_SCHED; PG8_LDA(At, 0, 0); PG8_STAGE(PG8_SA(1, 1), a1 + hstep, voffA);
            PG8_WAIT_L(8); PG8_BAR; PG8_WAIT_L(0); PG8_MMA(0, 0, At, B0); PG8_BAR; PG8_SCHED;
            PG8_LDB(B1, 0, 1); PG8_STAGE(PG8_SB(0, 0), b2, voffB);
            PG8_BAR; PG8_WAIT_L(0); PG8_MMA(0, 1, At, B1); PG8_BAR;
            PG8_LDA(At, 0, 1); PG8_STAGE(PG8_SA(0, 0), a2, voffA);
            PG8_BAR; PG8_WAIT_L(0); PG8_MMA(1, 0, At, B0); PG8_BAR; PG8_SCHED;
            PG8_STAGE(PG8_SB(0, 1), b2 + hstep, voffB);
            PG8_WAIT_V(6); PG8_BAR; PG8_MMA(1, 1, At, B1); PG8_BAR;
            PG8_LDB(B0, 1, 0); PG8_SCHED; PG8_LDA(At, 1, 0); PG8_STAGE(PG8_SA(0, 1), a2 + hstep, voffA);
            PG8_WAIT_L(8); PG8_BAR; PG8_WAIT_L(0); PG8_MMA(0, 0, At, B0); PG8_BAR; PG8_SCHED;
            PG8_LDB(B1, 1, 1); PG8_STAGE(PG8_SB(1, 0), b3, voffB);
            PG8_BAR; PG8_WAIT_L(0); PG8_MMA(0, 1, At, B1); PG8_BAR;
            PG8_LDA(At, 1, 1); PG8_STAGE(PG8_SA(1, 0), a3, voffA);
            PG8_BAR; PG8_WAIT_L(0); PG8_MMA(1, 0, At, B0); PG8_BAR; PG8_SCHED;
            PG8_STAGE(PG8_SB(1, 1), b3 + hstep, voffB);
            PG8_WAIT_V(6); PG8_BAR; PG8_MMA(1, 1, At, B1); PG8_BAR;
            }
        }
        if constexpr (ALIGN_EPI) { if (wr == 0) PG8_BAR; }
        if constexpr (!Epi::AFTER_DRAIN) { E(acc, cur, wr, wc, fr, fq); S.done(cur); }
        if (!has_next) break;
#pragma unroll
        for (int a = 0; a < 2; ++a)
#pragma unroll
            for (int b = 0; b < 2; ++b)
#pragma unroll
                for (int m = 0; m < 4; ++m)
#pragma unroll
                    for (int n = 0; n < 2; ++n) acc[a][b][m][n] = (f32x4){0.f, 0.f, 0.f, 0.f};
        cur = nxt; cA = nA; cB = nB; nt = cur.nt; ++ui;
        if constexpr (ALIGN_EPI) { if (wr == 1) PG8_BAR; }
    }
    PG8_WAIT_V(0);
    if constexpr (!ALIGN_EPI) { if (wr == 0) PG8_BAR; }
    PG8_BAR;
    if constexpr (Epi::AFTER_DRAIN) { E.fused(acc, cur, wr, wc, fr, fq, lds, wid, lane); S.done(cur); }
#undef PG8_SA
#undef PG8_SB
#undef PG8_STAGE
#undef PG8_LDA
#undef PG8_LDB
#undef PG8_MMA
#undef PG8_WAIT_V
#undef PG8_WAIT_L
#undef PG8_BAR
#undef PG8_SCHED
}
}

#define GAS __attribute__((address_space(1)))
#define LAS __attribute__((address_space(3)))
typedef GAS unsigned gu32;
#define RLX_AGENT __ATOMIC_RELAXED, __HIP_MEMORY_SCOPE_AGENT
#define LDS_WAIT() asm volatile("s_waitcnt lgkmcnt(0)" ::: "memory")
#define VM_WAIT() asm volatile("s_waitcnt vmcnt(0)" ::: "memory")
#define XB_TMO      128
#define XB_XCNT(j)  (256  + 64 * (j))
#define XB_XSUB(j)  (1280 + 64 * (j))
#define XB_XGEN(j)  (2304 + 64 * (j))
#define XB_TOP      3328
#define XB_TOPGEN   3392
#define XCD_BAR_WORDS 3456
#define XB_SPIN_CAP (1u << 20)
__device__ __forceinline__ unsigned xb_ld(unsigned* p)              { return __hip_atomic_load(p, __ATOMIC_RELAXED, __HIP_MEMORY_SCOPE_AGENT); }
__device__ __forceinline__ unsigned xb_add(unsigned* p, unsigned v) { return __hip_atomic_fetch_add(p, v, __ATOMIC_RELAXED, __HIP_MEMORY_SCOPE_AGENT); }
__device__ __forceinline__ unsigned xb_xcc_id() { return (unsigned)__builtin_amdgcn_s_getreg((3 << 11) | 20) & 0xFu; }
#define XB_SPIN(cond, bar) do { unsigned _sp = 0; while (cond) { __builtin_amdgcn_s_sleep(1); \
    if ((++_sp & 255u) == 0u) { if (xb_ld(&(bar)[XB_TMO])) break; if (_sp > XB_SPIN_CAP) { atomicAdd(&(bar)[XB_TMO], 1u); break; } } } } while (0)
struct XcdBarrier { unsigned* bar; unsigned x; volatile LAS unsigned* st; };
__device__ __forceinline__ XcdBarrier xcd_barrier_post(unsigned* bar, volatile LAS unsigned* st) {
    XcdBarrier b; b.bar = bar; b.x = xb_xcc_id(); b.st = st;
    if (threadIdx.x == 0) (void)xb_add(&bar[XB_XCNT(b.x)], 1u);
    return b;
}
__device__ __forceinline__ void xcd_barrier_complete(unsigned* bar, unsigned x, unsigned& nloc, unsigned& nx) {
    const unsigned G = gridDim.x * gridDim.y * gridDim.z;
    unsigned sum, cnt, mine, sp = 0u;
    for (;;) {
        sum = 0u; cnt = 0u; mine = 0u;
#pragma unroll
        for (unsigned j = 0; j < 16; ++j) { const unsigned c = xb_ld(&bar[XB_XCNT(j)]); sum += c; cnt += (c > 0u) ? 1u : 0u; mine = (j == x) ? c : mine; }
        if (sum == G) break;
        __builtin_amdgcn_s_sleep(1);
        if ((++sp & 255u) == 0u) { if (xb_ld(&bar[XB_TMO])) break; if (sp > XB_SPIN_CAP) { atomicAdd(&bar[XB_TMO], 1u); break; } }
    }
    nloc = mine > 0u ? mine : 1u; nx = cnt > 0u ? cnt : 1u;
}
__device__ __forceinline__ void xcd_barrier(const XcdBarrier& b) {
    asm volatile("s_waitcnt vmcnt(0)" ::: "memory");
    __syncthreads();
    if (threadIdx.x == 0) {
        unsigned* bar = b.bar;
        __builtin_amdgcn_s_waitcnt(0);
        unsigned nloc = b.st[0], nx = b.st[1];
        if (nloc == 0u) { xcd_barrier_complete(bar, b.x, nloc, nx); b.st[0] = nloc; b.st[1] = nx; }
        const unsigned old = xb_add(&bar[XB_XSUB(b.x)], 1u);
        const unsigned gen = old / nloc;
        if (old + 1u == (gen + 1u) * nloc) {
            __builtin_amdgcn_fence(__ATOMIC_RELEASE, "agent");
            asm volatile("s_waitcnt vmcnt(0)" ::: "memory");
            const unsigned og = xb_add(&bar[XB_TOP], 1u);
            const unsigned tg = og / nx;
            if (og + 1u == (tg + 1u) * nx) xb_add(&bar[XB_TOPGEN], 1u);
            else XB_SPIN(xb_ld(&bar[XB_TOPGEN]) == tg, bar);
            __builtin_amdgcn_fence(__ATOMIC_ACQUIRE, "agent");
            xb_add(&bar[XB_XGEN(b.x)], 1u);
            asm volatile("s_waitcnt vmcnt(0)" ::: "memory");
        } else {
            XB_SPIN(xb_ld(&bar[XB_XGEN(b.x)]) == gen, bar);
            __builtin_amdgcn_fence(__ATOMIC_ACQUIRE, "agent");
            asm volatile("s_waitcnt vmcnt(0)" ::: "memory");
        }
    }
    __syncthreads();
}

constexpr int NWAVES = 8;
constexpr int RING_OFF = 0, RING_BYTES = 131072;
constexpr int LDSCTL_OFF = RING_BYTES, MISC_OFF = LDSCTL_OFF + 320;
constexpr int LDS_BYTES = 147456;
constexpr int CW_TMO = 0, CW_CODE = 1, CW_BAR = 4096, CW_QUEUE = 8192, CW_SEAM = 16384;
constexpr size_t CTL_ZERO_BYTES = 1 * MiB;

struct Frame {
    LAS unsigned char* lds; volatile LAS unsigned* MISC; unsigned* ctl;
    int tid, lane, wave, vcu, G;
    Bufs B;
};

__device__ __forceinline__ void p0_transpose_item(const Bufs& B, int kind, int N, size_t dst_off, LAS float* scr, int item, int lane) {
    const int nblk = N / 32, kb = item / nblk, nb = item % nblk, k0 = 64 * kb, n0 = 32 * nb;
#pragma unroll 4
    for (int i = 0; i < 32; ++i) { const int kk = 2 * i + (lane >> 5); scr[kk * 33 + (lane & 31)] = wsrc(B, kind, k0 + kk, n0 + (lane & 31)); }
    LDS_WAIT(); asm volatile("" ::: "memory");
    const int c = lane & 7; bf16* WT = WSP(bf16, dst_off);
#pragma unroll
    for (int j = 0; j < 4; ++j) { const int n = (lane >> 3) + 8 * j; const LAS float* s = scr + (8 * c) * 33 + n;
        v4u o; o.x = pk2(s[0 * 33], s[1 * 33]); o.y = pk2(s[2 * 33], s[3 * 33]); o.z = pk2(s[4 * 33], s[5 * 33]); o.w = pk2(s[6 * 33], s[7 * 33]);
        *(v4u*)(WT + (size_t)(n0 + n) * 1024 + k0 + 8 * c) = o; }
    LDS_WAIT(); asm volatile("" ::: "memory");
}
__device__ __forceinline__ float wave_sum(float v) {
#pragma unroll
    for (int o = 1; o < 64; o <<= 1) v += __shfl_xor(v, o);
    return v;
}
__device__ __forceinline__ void ln_in_row(const Bufs& B, int row, int lane) {
    const f32x4* xr = (const f32x4*)(B.x + (size_t)row * D) + lane;
    f32x4 v[4]; float s = 0.f;
#pragma unroll
    for (int j = 0; j < 4; ++j) { v[j] = xr[64 * j]; s += (v[j].x + v[j].y) + (v[j].z + v[j].w); }
    const float mean = wave_sum(s) * (1.f / D); float s2 = 0.f;
#pragma unroll
    for (int j = 0; j < 4; ++j) { v[j] = v[j] - mean; s2 += (v[j].x * v[j].x + v[j].y * v[j].y) + (v[j].z * v[j].z + v[j].w * v[j].w); }
    const float rstd = rsqrtf(wave_sum(s2) * (1.f / D) + LN_EPS);
    if (lane == 0) { float* st = WSP(float, WS_STATS) + (size_t)row * 2; st[0] = mean; st[1] = rstd; }
    unsigned long long* o8 = (unsigned long long*)(WSP(bf16, WS_XN) + (size_t)row * D) + lane;
#pragma unroll
    for (int j = 0; j < 4; ++j) { const f32x4 g = *((const f32x4*)B.ln_in_g + lane + 64 * j), b = *((const f32x4*)B.ln_in_b + lane + 64 * j);
        const f32x4 y = v[j] * rstd * g + b;
        o8[64 * j] = (unsigned long long)pk2(y.x, y.y) | ((unsigned long long)pk2(y.z, y.w) << 32); }
}
__device__ __forceinline__ void p0_prologue(Frame& F) {
    const Bufs& B = F.B;
    LAS float* scr = (LAS float*)(F.lds + RING_OFF + F.wave * 16384);
    const int gw = F.vcu * NWAVES + F.wave, NGW = F.G * NWAVES;
    constexpr int I0 = 16 * (NPOS / 32), I1 = 16 * (3072 / 32), I2 = 16 * 32;
    constexpr int NITEMS = I0 + I1 + 4 * I2;
    for (int it = gw; it < NITEMS; it += NGW) {
        int r = it;
        if (r < I0) { p0_transpose_item(B, 0, NPOS, WS_WIN, scr, r, F.lane); continue; } r -= I0;
        if (r < I1) { p0_transpose_item(B, 1, 3072, WS_WMG, scr, r, F.lane); continue; } r -= I1;
        if (r < I2) { p0_transpose_item(B, 2, 1024, WS_WMEM, scr, r, F.lane); continue; } r -= I2;
        if (r < I2) { p0_transpose_item(B, 3, 1024, WS_WAB, scr, r, F.lane); continue; } r -= I2;
        if (r < I2) { p0_transpose_item(B, 4, 1024, WS_WC, scr, r, F.lane); continue; } r -= I2;
        p0_transpose_item(B, 5, 1024, WS_WOUT, scr, r, F.lane);
    }
    for (int m = gw; m < M; m += NGW) ln_in_row(B, m, F.lane);
    const int gid = gw * 64 + F.lane, nth = NGW * 64;
    for (int i = gid; i < MM * D / 4; i += nth) { const f32x4 v = ((const f32x4*)B.mem)[i]; ((unsigned long long*)WSP(bf16, WS_MEMB))[i] = (unsigned long long)pk2(v.x, v.y) | ((unsigned long long)pk2(v.z, v.w) << 32); }
    for (int i = gid; i < SEQ * 8; i += nth) { const int pos = i >> 3, f = i & 7;
        const float inv = powf(500000.0f, -(float)f * 0.125f); const float ang = (float)pos * inv;
        float* t64 = WSP(float, WS_TAB) + pos * 16; t64[f] = cosf(ang); t64[8 + f] = sinf(ang);
        if ((f & 1) == 0) { float* t32 = WSP(float, WS_TAB32) + pos * 8; t32[f >> 1] = cosf(ang); t32[4 + (f >> 1)] = sinf(ang); } }
    if (gid == 0) { float a = 0.f, b = 0.f; for (int i = 0; i < 64; ++i) { a += B.diff_lambda[i] * B.diff_lambda[64 + i]; b += B.diff_lambda[128 + i] * B.diff_lambda[192 + i]; }
        *WSP(float, WS_LAM) = expf(a) - expf(b) + LAM_INIT; }
}

struct SchedIn {
    pg8::TileOrder T; int G, c; const char* XN; const char* WIN; const char* MEMB; const char* WMEM;
    __device__ __forceinline__ bool next(int i, pg8::Unit& u) const {
        const int L = i * G + c;
        if (L < T.nwg) { T.tile(L, u.pm, u.pn); u.A = XN + (size_t)u.pm * pg8::TSTEP; u.B = WIN + (size_t)u.pn * pg8::TSTEP; u.nt = 16; u.kind = 0; return true; }
        const int r = L - T.nwg; if (r >= 64) return false;
        u.pm = r >> 2; u.pn = r & 3; u.A = MEMB + (size_t)u.pm * pg8::TSTEP; u.B = WMEM + (size_t)u.pn * pg8::TSTEP; u.nt = 16; u.kind = 1; return true;
    }
    __device__ __forceinline__ void a_ready(const pg8::Unit&) const {}
    __device__ __forceinline__ void done(const pg8::Unit&) const {}
};
template <int KIND> __device__ __forceinline__ void epi_in_loops(const Bufs& B, const pg8::f32x4 (&acc)[2][2][4][2], int row0, int c0) {
#pragma unroll
    for (int ai = 0; ai < 2; ++ai)
#pragma unroll
        for (int m = 0; m < 4; ++m)
#pragma unroll
            for (int bj = 0; bj < 2; ++bj) {
                float v[8] = {acc[ai][bj][m][0][0], acc[ai][bj][m][0][1], acc[ai][bj][m][0][2], acc[ai][bj][m][0][3], acc[ai][bj][m][1][0], acc[ai][bj][m][1][1], acc[ai][bj][m][1][2], acc[ai][bj][m][1][3]};
                const int row = row0 + ai * 128 + m * 16, c = c0 + bj * 128;
                if constexpr (KIND == 100) store8(WSP(bf16, WS_MKV) + (size_t)row * 1024 + c, v);
                else emit8k<KIND>(B, row, c, v);
            }
}
struct EpiIn {
    static constexpr bool PERM = true, AFTER_DRAIN = false; Bufs B;
    __device__ __forceinline__ void operator()(const pg8::f32x4 (&acc)[2][2][4][2], const pg8::Unit& u, int wr, int wc, int fr, int fq) const {
        const int row0 = u.pm * 256 + wr * 64 + fr, cw = wc * 32 + 8 * fq;
        if (u.kind == 1) { epi_in_loops<100>(B, acc, row0, u.pn * 256 + cw); return; }
        const int c0 = (u.pn < 16 ? (u.pn & 1) * 256 : 0) + cw;
        switch (kind_of_tile(u.pn)) {
        case K_AQ: epi_in_loops<K_AQ>(B, acc, row0, c0); break;  case K_AG: epi_in_loops<K_AG>(B, acc, row0, c0); break;
        case K_BQ: epi_in_loops<K_BQ>(B, acc, row0, c0); break;  case K_BK: epi_in_loops<K_BK>(B, acc, row0, c0); break;
        case K_BV: epi_in_loops<K_BV>(B, acc, row0, c0); break;  case K_BG: epi_in_loops<K_BG>(B, acc, row0, c0); break;
        case K_CQ: epi_in_loops<K_CQ>(B, acc, row0, c0); break;  case K_CG: epi_in_loops<K_CG>(B, acc, row0, c0); break;
        case K_IQ: epi_in_loops<K_IQ>(B, acc, row0, c0); break;  default:   epi_in_loops<K_MISC>(B, acc, row0, c0); break;
        }
    }
};

#ifndef FAST_A
#define FAST_A 1
#endif
#ifndef FAST_B
#define FAST_B 1
#endif
#ifndef FAST_C
#define FAST_C 1
#endif
namespace att {
typedef short bf16x8 __attribute__((ext_vector_type(8)));
typedef short v4i16_t __attribute__((ext_vector_type(4)));
typedef float f32x16 __attribute__((ext_vector_type(16)));
constexpr int L_K = 0, L_V = 32768, L_MASK = 65536, L_X = 65536;
constexpr float NEG_BIG = -1.0e30f;

__device__ __forceinline__ float hswap_max(float v) { auto rr = __builtin_amdgcn_permlane32_swap(__float_as_uint(v), __float_as_uint(v), false, false); return fmaxf(__uint_as_float(rr[0]), __uint_as_float(rr[1])); }
__device__ __forceinline__ float hswap_sum(float v) { auto rr = __builtin_amdgcn_permlane32_swap(__float_as_uint(v), __float_as_uint(v), false, false); return __uint_as_float(rr[0]) + __uint_as_float(rr[1]); }
__device__ __forceinline__ unsigned cvtpk(float lo, float hi) { typedef float f2 __attribute__((ext_vector_type(2))); typedef __bf16 b2 __attribute__((ext_vector_type(2))); f2 v = {lo, hi}; b2 b = __builtin_convertvector(v, b2); return __builtin_bit_cast(unsigned, b); }

template <int DQK, int DV> struct WState { bf16x8 qf[DQK / 16]; f32x16 o[DV / 32]; float m, l; };

template <int KPB> __device__ __forceinline__ int ksw(int row) { return KPB == 128 ? ((row >> 1) & 7) : (row & 15); }
template <int KPB, int DV> struct Stage {
    static constexpr int NK = KPB / 128, NV = DV / 64;
    v4u kr[NK], vr[NV];
    __device__ __forceinline__ void load(const char* kg, size_t kpitch, const char* vg, size_t vpitch, int key0, int tid) {
#pragma unroll
        for (int i = 0; i < NK; ++i) { const int idx = tid + 512 * i, key = idx / (KPB / 16), ch = idx % (KPB / 16); kr[i] = *(const v4u*)(kg + (size_t)(key0 + key) * kpitch + ch * 16); }
#pragma unroll
        for (int i = 0; i < NV; ++i) { const int idx = tid + 512 * i, key = idx / (DV / 8), ch = idx % (DV / 8); vr[i] = *(const v4u*)(vg + (size_t)(key0 + key) * vpitch + ch * 16); }
    }
    __device__ __forceinline__ void store(LAS unsigned char* lds, int buf, int tid) const {
#pragma unroll
        for (int i = 0; i < NK; ++i) { const int idx = tid + 512 * i, key = idx / (KPB / 16), ch = idx % (KPB / 16); *(LAS v4u*)(lds + L_K + buf * 16384 + key * KPB + ((ch ^ ksw<KPB>(key)) << 4)) = kr[i]; }
#pragma unroll
        for (int i = 0; i < NV; ++i) { const int idx = tid + 512 * i, key = idx / (DV / 8), ch = idx % (DV / 8); *(LAS v4u*)(lds + L_V + buf * 16384 + (ch >> 2) * 4096 + key * 64 + (ch & 3) * 16) = vr[i]; }
    }
};

template <int DQK, int DV, int KPB, bool MASKED>
__device__ __forceinline__ void tile_compute(WState<DQK, DV>& W, LAS unsigned char* lds, int buf, int kc0, int lane, const LAS unsigned* mrow  ) {
    const int r32 = lane & 31, hi = lane >> 5;
    const LAS unsigned char* kb = lds + L_K + buf * 16384;
    const LAS unsigned char* vb = lds + L_V + buf * 16384 + ((lane >> 4) & 1) * 32 + (lane & 3) * 8 + (4 * hi + ((lane & 15) >> 2)) * 64;
#pragma unroll
    for (int kh = 0; kh < 2; ++kh) {
        const int row = 32 * kh + r32;
        f32x16 s = {};
#pragma unroll
        for (int ks = 0; ks < DQK / 16; ++ks) {
            const bf16x8 kf = *(const LAS bf16x8*)(kb + row * KPB + (((kc0 + 2 * ks + hi) ^ ksw<KPB>(row)) << 4));
            s = __builtin_amdgcn_mfma_f32_32x32x16_bf16(kf, W.qf[ks], s, 0, 0, 0);
        }
        if constexpr (MASKED) {
            const unsigned wsh = mrow[kh] >> (4 * hi);
#pragma unroll
            for (int r = 0; r < 16; ++r) { const unsigned mm = (unsigned)__builtin_amdgcn_sbfe((int)wsh, (r & 3) + 8 * (r >> 2), 1); s[r] = __uint_as_float((__float_as_uint(s[r]) & mm) | (0xFF800000u & ~mm)); }
        }
        float mx = s[0];
#pragma unroll
        for (int r = 1; r < 16; ++r) mx = fmaxf(mx, s[r]);
        mx = hswap_max(mx);
        const float mn = fmaxf(W.m, mx), alpha = __builtin_amdgcn_exp2f(W.m - mn);
        W.m = mn;
        float ps = 0.f;
#pragma unroll
        for (int r = 0; r < 16; ++r) { s[r] = __builtin_amdgcn_exp2f(s[r] - mn); ps += s[r]; }
        W.l = W.l * alpha + ps;
        if (__any(alpha != 1.0f)) {
#pragma unroll
            for (int dt = 0; dt < DV / 32; ++dt)
#pragma unroll
                for (int r = 0; r < 16; ++r) W.o[dt][r] *= alpha;
        }
        v4u pw0, pw1;
        pw0.x = cvtpk(s[0], s[1]); pw0.y = cvtpk(s[2], s[3]); pw0.z = cvtpk(s[4], s[5]); pw0.w = cvtpk(s[6], s[7]);
        pw1.x = cvtpk(s[8], s[9]); pw1.y = cvtpk(s[10], s[11]); pw1.z = cvtpk(s[12], s[13]); pw1.w = cvtpk(s[14], s[15]);
        const bf16x8 pf0 = __builtin_bit_cast(bf16x8, pw0), pf1 = __builtin_bit_cast(bf16x8, pw1);
#pragma unroll
        for (int dt = 0; dt < DV / 32; ++dt) {
#pragma unroll
            for (int sidx = 0; sidx < 2; ++sidx) {
                const LAS unsigned char* p = vb + dt * 4096 + (32 * kh + 16 * sidx) * 64;
                const v4i16_t lo = __builtin_amdgcn_ds_read_tr16_b64_v4i16((LAS v4i16_t*)p);
                const v4i16_t hh = __builtin_amdgcn_ds_read_tr16_b64_v4i16((LAS v4i16_t*)(p + 512));
                const bf16x8 vf = (bf16x8){lo[0], lo[1], lo[2], lo[3], hh[0], hh[1], hh[2], hh[3]};
                W.o[dt] = __builtin_amdgcn_mfma_f32_32x32x16_bf16(vf, sidx == 0 ? pf0 : pf1, W.o[dt], 0, 0, 0);
            }
        }
    }
}

template <int DQK, int DV, int KPB, bool MASKED>
__device__ __forceinline__ void tile_loop(WState<DQK, DV>& W, LAS unsigned char* lds, const char* kg, size_t kpitch, const char* vg, size_t vpitch, int nT, int my_nt, int kc0, int tid, int lane, const LAS unsigned* mq) {
    Stage<KPB, DV> st;
    st.load(kg, kpitch, vg, vpitch, 0, tid); st.store(lds, 0, tid);
    __syncthreads();
    for (int t = 0; t < nT; ++t) {
        if (t + 1 < nT) st.load(kg, kpitch, vg, vpitch, 64 * (t + 1), tid);
        if (t < my_nt) tile_compute<DQK, DV, KPB, MASKED>(W, lds, t & 1, kc0, lane, MASKED ? mq + 2 * t : mq);
        if (t + 1 < nT) st.store(lds, (t + 1) & 1, tid);
        __syncthreads();
    }
}
template <int DQK, int DV> __device__ __forceinline__ void wstate_init(WState<DQK, DV>& W, const bf16* qrow  , int hi) {
#pragma unroll
    for (int ks = 0; ks < DQK / 16; ++ks) W.qf[ks] = *(const bf16x8*)(qrow + 16 * ks + 8 * hi);
#pragma unroll
    for (int dt = 0; dt < DV / 32; ++dt) W.o[dt] = (f32x16){};
    W.m = NEG_BIG; W.l = 0.f;
}

__device__ __forceinline__ unsigned skey(float score, int idx) {
    const unsigned b = __float_as_uint(score); const unsigned k = b ^ ((unsigned)((int)b >> 31) | 0x80000000u);
    return (k & ~0x7FFu) | (unsigned)(2047 - idx);
}
template <int S> __device__ __forceinline__ void indexer_pass(const Bufs& B, LAS unsigned* masks, size_t rowb, int t0, int w, int lane, int ntl, int limit, bf16x8 a0, bf16x8 a1) {
    const int r32 = lane & 31, hi = lane >> 5;
    float wt[8];
    { const float* iwp = WSP(const float, WS_IW) + (rowb + t0 + 4 * w + 2 * hi + S) * 8;
      const f32x4 v0 = *(const f32x4*)iwp, v1 = *(const f32x4*)(iwp + 4); wt[0] = v0.x; wt[1] = v0.y; wt[2] = v0.z; wt[3] = v0.w; wt[4] = v1.x; wt[5] = v1.y; wt[6] = v1.z; wt[7] = v1.w; }
    const bf16* ikp = WSP(const bf16, WS_IK) + (rowb + r32) * 32 + 8 * hi;
    unsigned key[64];
#pragma unroll
    for (int t = 0; t < 64; ++t) {
        key[t] = 0u;
        if (t < ntl) {
            const bf16x8 b0 = *(const bf16x8*)(ikp + (size_t)t * 32 * 32), b1 = *(const bf16x8*)(ikp + (size_t)t * 32 * 32 + 16);
            f32x16 acc = {};
            acc = __builtin_amdgcn_mfma_f32_32x32x16_bf16(a0, b0, acc, 0, 0, 0);
            acc = __builtin_amdgcn_mfma_f32_32x32x16_bf16(a1, b1, acc, 0, 0, 0);
            float s0 = 0.f;
#pragma unroll
            for (int h = 0; h < 8; ++h) s0 += wt[h] * fmaxf(acc[8 * S + h], 0.f);
            key[t] = skey(s0, 32 * t + r32);
        }
    }
    unsigned tau = 1u;
    if (limit > 256) {
        unsigned lo = 1u, hb = 0xFFFFFFFFu; bool dn = false;
        for (int it = 0; it < 40; ++it) {
            if (!dn && hb - lo <= 1u) { tau = lo; dn = true; }
            if (__all(dn)) break;
            const unsigned mid = lo + ((hb - lo) >> 1);
            unsigned c = 0;
#pragma unroll
            for (int t = 0; t < 64; ++t) c += (key[t] >= mid) ? 1u : 0u;
#pragma unroll
            for (int o = 1; o < 32; o <<= 1) c += __shfl_xor(c, o);
            if (!dn) { if (c == 256u) { tau = mid; dn = true; } else if (c > 256u) lo = mid; else hb = mid; }
        }
    }
    unsigned wl = 0, wh = 0;
#pragma unroll
    for (int t = 0; t < 64; ++t) {
        const unsigned long long m0 = __ballot(key[t] >= tau);
        wl = (lane == t) ? (unsigned)m0 : wl; wh = (lane == t) ? (unsigned)(m0 >> 32) : wh;
    }
    masks[(4 * w + S) * 64 + lane] = wl; masks[(4 * w + 2 + S) * 64 + lane] = wh;
}
__device__ __forceinline__ void unit_A(Frame& F, int b, int qb32) {
    const Bufs& B = F.B; const int lane = F.lane, w = F.wave, r32 = lane & 31, hi = lane >> 5, tid = F.tid;
    const int t0 = qb32 * 32, limit = ((t0 >> 6) + 1) << 6, ntl = limit >> 5;
    const size_t rowb = (size_t)b * SEQ;
    LAS unsigned* masks = (LAS unsigned*)(F.lds + L_MASK);
    {
        const int rho = r32, qa = 2 * ((rho >> 2) & 1) + (rho >> 4), ha = 4 * ((rho >> 3) & 1) + (rho & 3);
        const bf16* iqp = WSP(const bf16, WS_IQ) + (rowb + t0 + 4 * w + qa) * 256 + ha * 32 + 8 * hi;
        const bf16x8 a0 = *(const bf16x8*)iqp, a1 = *(const bf16x8*)(iqp + 16);
        indexer_pass<0>(B, masks, rowb, t0, w, lane, ntl, limit, a0, a1);
        indexer_pass<1>(B, masks, rowb, t0, w, lane, ntl, limit, a0, a1);
    }
    __syncthreads();
    {
        const int ql = 4 * w + (r32 >> 3), head = r32 & 7; const size_t row = rowb + t0 + ql;
        bf16* qrow = WSP(bf16, WS_QAB) + row * 1024 + head * 64;
        WState<64, 64> W; wstate_init<64, 64>(W, qrow, hi);
        const int nT = limit >> 6;
        tile_loop<64, 64, 128, true>(W, F.lds, (const char*)(WSP(const bf16, WS_AK) + rowb * 64), 128, (const char*)(WSP(const bf16, WS_AV) + rowb * 64), 128, nT, nT, 0, tid, lane, masks + ql * 64);
        const float inv = 1.f / hswap_sum(W.l);
        const bf16* grow = WSP(const bf16, WS_AG) + row * 512 + head * 64;
#pragma unroll
        for (int dt = 0; dt < 2; ++dt)
#pragma unroll
            for (int g = 0; g < 4; ++g) { const int d = 32 * dt + 8 * g + 4 * hi;
                const uint2 gw = *(const uint2*)(grow + d);
                const float o0 = W.o[dt][4 * g] * inv * bf2f(gw.x & 0xffffu), o1 = W.o[dt][4 * g + 1] * inv * bf2f(gw.x >> 16), o2 = W.o[dt][4 * g + 2] * inv * bf2f(gw.y & 0xffffu), o3 = W.o[dt][4 * g + 3] * inv * bf2f(gw.y >> 16);
                uint2 ov; ov.x = cvtpk(o0, o1); ov.y = cvtpk(o2, o3); *(uint2*)(qrow + d) = ov; }
    }
    __syncthreads();
}

__device__ __forceinline__ void unit_B(Frame& F, int b, int h, int qb128) {
    const Bufs& B = F.B; const int lane = F.lane, w = F.wave, r32 = lane & 31, hi = lane >> 5, tid = F.tid;
    const int qb = w >> 1, c = w & 1, t0 = qb128 * 128 + qb * 32;
    const size_t rowb = (size_t)b * SEQ, row = rowb + t0 + r32;
    const int nT = 2 * qb128 + 2, my_nt = ((t0 >> 6) + 1);
    bf16* qrow = WSP(bf16, WS_QAB) + row * 1024 + 512 + h * 128;
    WState<64, 128> W; wstate_init<64, 128>(W, qrow + c * 64, hi);
    tile_loop<64, 128, 256, false>(W, F.lds, (const char*)(WSP(const bf16, WS_BK) + rowb * 512 + h * 128), 1024, (const char*)(WSP(const bf16, WS_BV) + rowb * 512 + h * 128), 1024, nT, my_nt, c * 8, tid, lane, nullptr);
    const float inv = 1.f / hswap_sum(W.l);
    LAS float* X = (LAS float*)(F.lds + L_X) + qb * 4096 + lane;
    if (c == 1) {
#pragma unroll
        for (int dt = 0; dt < 4; ++dt)
#pragma unroll
            for (int r = 0; r < 16; ++r) X[(dt * 16 + r) * 64] = W.o[dt][r] * inv;
    }
    __syncthreads();
    if (c == 0) {
        const float lam = *WSP(const float, WS_LAM);
        float ss = 0.f;
#pragma unroll
        for (int dt = 0; dt < 4; ++dt)
#pragma unroll
            for (int r = 0; r < 16; ++r) { const float v = W.o[dt][r] * inv - lam * X[(dt * 16 + r) * 64]; W.o[dt][r] = v; ss += v * v; }
        ss = hswap_sum(ss);
        const float rn = rsqrtf(ss * (1.f / 128.f) + LN_EPS) * (1.f - LAM_INIT);
        const bf16* grow = WSP(const bf16, WS_BG) + row * 512 + h * 128;
#pragma unroll
        for (int dt = 0; dt < 4; ++dt)
#pragma unroll
            for (int g = 0; g < 4; ++g) { const int d = 32 * dt + 8 * g + 4 * hi;
                const uint2 gw = *(const uint2*)(grow + d); const f32x4 ng = *(const f32x4*)(B.diff_norm_g + d);
                const float o0 = W.o[dt][4 * g] * rn * ng.x * bf2f(gw.x & 0xffffu), o1 = W.o[dt][4 * g + 1] * rn * ng.y * bf2f(gw.x >> 16), o2 = W.o[dt][4 * g + 2] * rn * ng.z * bf2f(gw.y & 0xffffu), o3 = W.o[dt][4 * g + 3] * rn * ng.w * bf2f(gw.y >> 16);
                uint2 ov; ov.x = cvtpk(o0, o1); ov.y = cvtpk(o2, o3); *(uint2*)(qrow + d) = ov; }
    }
    __syncthreads();
}

__device__ __forceinline__ void unit_C(Frame& F, int b, int h, int qb256) {
    const Bufs& B = F.B; const int lane = F.lane, w = F.wave, r32 = lane & 31, hi = lane >> 5, tid = F.tid;
    const size_t row = (size_t)b * SEQ + qb256 * 256 + w * 32 + r32;
    bf16* qrow = WSP(bf16, WS_QC) + row * 1024 + h * 128;
    WState<128, 128> W; wstate_init<128, 128>(W, qrow, hi);
    const char* kv = (const char*)(WSP(const bf16, WS_MKV) + (size_t)b * MEM_LEN * 1024 + h * 128);
    tile_loop<128, 128, 256, false>(W, F.lds, kv, 2048, kv + 1024, 2048, 4, 4, 0, tid, lane, nullptr);
    const float inv = 1.f / hswap_sum(W.l);
    const bf16* grow = qrow + 512;
#pragma unroll
    for (int dt = 0; dt < 4; ++dt)
#pragma unroll
        for (int g = 0; g < 4; ++g) { const int d = 32 * dt + 8 * g + 4 * hi;
            const uint2 gw = *(const uint2*)(grow + d);
            const float o0 = W.o[dt][4 * g] * inv * bf2f(gw.x & 0xffffu), o1 = W.o[dt][4 * g + 1] * inv * bf2f(gw.x >> 16), o2 = W.o[dt][4 * g + 2] * inv * bf2f(gw.y & 0xffffu), o3 = W.o[dt][4 * g + 3] * inv * bf2f(gw.y >> 16);
            uint2 ov; ov.x = cvtpk(o0, o1); ov.y = cvtpk(o2, o3); *(uint2*)(qrow + d) = ov; }
    __syncthreads();
}

constexpr int NUNITS = 2048 + 512;
__device__ __forceinline__ void attn_phase(Frame& F) {
    for (;;) {
        __syncthreads();
        if (F.tid == 0) F.MISC[0] = atomicAdd(F.ctl + CW_QUEUE, 1u);
        __syncthreads();
        const int idx = (int)F.MISC[0];
        if (idx >= NUNITS) break;
        if (idx < 2048) {
            const int L = 15 - (idx >> 7), r = idx & 127;
            if (r < 64) { if (FAST_A) unit_A(F, r & 15, 4 * L + 3 - (r >> 4)); }
            else { const int r2 = r - 64; if (FAST_B) unit_B(F, r2 & 15, r2 >> 4, L); }
        } else { const int cix = idx - 2048; if (FAST_C) unit_C(F, cix & 15, (cix >> 4) & 3, cix >> 6); }
    }
}
}
constexpr size_t WS_SCR = 329 * MiB;
constexpr size_t WS_END2 = WS_SCR + 128 * MiB;
struct SchedMerge {
    pg8::TileOrder T; int G, c; const char *XN, *WMG, *QAB, *QC, *WAB, *WC;
    __device__ __forceinline__ bool next(int i, pg8::Unit& u) const {
        const int ti = i / 6, st = i - ti * 6, L = ti * G + c;
        if (L >= T.nwg) return false;
        T.tile(L, u.pm, u.pn); u.kind = st;
        const int br = st >> 1;
        if ((st & 1) == 0) { u.A = XN + (size_t)u.pm * pg8::TSTEP; u.B = WMG + (size_t)(br * 4 + u.pn) * pg8::TSTEP; u.nt = 16; }
        else if (br == 0) { u.A = QAB + (size_t)u.pm * pg8::TSTEP; u.B = WAB + (size_t)u.pn * pg8::TSTEP; u.nt = 8; }
        else if (br == 1) { u.A = QAB + (size_t)u.pm * pg8::TSTEP + 1024; u.B = WAB + (size_t)u.pn * pg8::TSTEP + 1024; u.nt = 8; }
        else { u.A = QC + (size_t)u.pm * pg8::TSTEP; u.B = WC + (size_t)u.pn * pg8::TSTEP; u.nt = 8; }
        return true;
    }
    __device__ __forceinline__ void a_ready(const pg8::Unit&) const {}
    __device__ __forceinline__ void done(const pg8::Unit&) const {}
};
struct EpiMerge {
    static constexpr bool PERM = true, AFTER_DRAIN = false; void* scr; bf16* merged;
    __device__ __forceinline__ void operator()(const pg8::f32x4 (&acc)[2][2][4][2], const pg8::Unit& u, int wr, int wc, int fr, int fq) const {
        const int voff = (int)threadIdx.x * 16;
        const __amdgpu_buffer_rsrc_t rs = __builtin_amdgcn_make_buffer_rsrc(scr, 0, 524288, 0x00020000);
#define SCR_LD(i, part) __builtin_bit_cast(pg8::f32x4, __builtin_amdgcn_raw_buffer_load_b128(rs, voff, (part) * 262144 + (i) * 8192, 0))
#define SCR_ST(i, part, val) __builtin_amdgcn_raw_buffer_store_b128(__builtin_bit_cast(v4u, (val)), rs, voff, (part) * 262144 + (i) * 8192, 0)
        if ((u.kind & 1) == 0) {
#pragma unroll
            for (int ai = 0; ai < 2; ++ai)
#pragma unroll
                for (int bj = 0; bj < 2; ++bj)
#pragma unroll
                    for (int m = 0; m < 4; ++m)
#pragma unroll
                        for (int n = 0; n < 2; ++n) { const pg8::f32x4 a = acc[ai][bj][m][n]; pg8::f32x4 g;
#pragma unroll
                            for (int e = 0; e < 4; ++e) g[e] = __builtin_amdgcn_rcpf(1.f + __builtin_amdgcn_exp2f(-LOG2E * a[e]));
                            SCR_ST(((ai * 2 + bj) * 4 + m) * 2 + n, 0, g); }
        } else if (u.kind < 5) {
#pragma unroll
            for (int ai = 0; ai < 2; ++ai)
#pragma unroll
                for (int bj = 0; bj < 2; ++bj)
#pragma unroll
                    for (int m = 0; m < 4; ++m)
#pragma unroll
                        for (int n = 0; n < 2; ++n) { const int ix = ((ai * 2 + bj) * 4 + m) * 2 + n;
                            pg8::f32x4 t = SCR_LD(ix, 0) * acc[ai][bj][m][n]; if (u.kind == 3) t += SCR_LD(ix, 1); SCR_ST(ix, 1, t); if (n == 1 && (m & 1)) asm volatile("" ::: "memory"); }
        } else {
            const int row0 = u.pm * 256 + wr * 64 + fr, col0 = u.pn * 256 + wc * 32 + 8 * fq;
#pragma unroll
            for (int ai = 0; ai < 2; ++ai)
#pragma unroll
                for (int m = 0; m < 4; ++m)
#pragma unroll
                    for (int bj = 0; bj < 2; ++bj) { const int ix = ((ai * 2 + bj) * 4 + m) * 2;
                        const pg8::f32x4 t0 = SCR_LD(ix, 0) * acc[ai][bj][m][0] + SCR_LD(ix, 1), t1 = SCR_LD(ix + 1, 0) * acc[ai][bj][m][1] + SCR_LD(ix + 1, 1);
                        float v[8] = {t0[0], t0[1], t0[2], t0[3], t1[0], t1[1], t1[2], t1[3]};
                        store8(merged + (size_t)(row0 + ai * 128 + m * 16) * 1024 + col0 + bj * 128, v); if (bj == 1) asm volatile("" ::: "memory"); }
        }
#undef SCR_LD
#undef SCR_ST
    }
};
struct SchedOut {
    pg8::TileOrder T; int G, c; const char *MG, *WO;
    __device__ __forceinline__ bool next(int i, pg8::Unit& u) const {
        const int L = i * G + c; if (L >= T.nwg) return false;
        T.tile(L, u.pm, u.pn); u.A = MG + (size_t)u.pm * pg8::TSTEP; u.B = WO + (size_t)u.pn * pg8::TSTEP; u.nt = 16; u.kind = 0; return true;
    }
    __device__ __forceinline__ void a_ready(const pg8::Unit&) const {}
    __device__ __forceinline__ void done(const pg8::Unit&) const {}
};
struct EpiOutF {
    static constexpr bool PERM = false, AFTER_DRAIN = false; Bufs B;
    __device__ __forceinline__ void operator()(const pg8::f32x4 (&acc)[2][2][4][2], const pg8::Unit& u, int wr, int wc, int fr, int fq) const {
        const int row0 = u.pm * 256 + wr * 64 + fr, col0 = u.pn * 256 + wc * 32 + 4 * fq;
#pragma unroll
        for (int ai = 0; ai < 2; ++ai)
#pragma unroll
            for (int m = 0; m < 4; ++m) { const int row = row0 + ai * 128 + m * 16;
                const float* st = WSP(const float, WS_STATS) + (size_t)row * 2; const float mean = st[0], rstd = st[1];
#pragma unroll
                for (int bj = 0; bj < 2; ++bj)
#pragma unroll
                    for (int n = 0; n < 2; ++n) { const int col = col0 + bj * 128 + n * 16;
                        const pg8::f32x4 xv = *(const pg8::f32x4*)(B.x + (size_t)row * 1024 + col), g = *(const pg8::f32x4*)(B.ln_in_g + col), bb = *(const pg8::f32x4*)(B.ln_in_b + col);
                        const pg8::f32x4 h = (xv - mean) * rstd * g + bb;
                        *(pg8::f32x4*)(B.out + (size_t)row * 1024 + col) = h * ALPHA + acc[ai][bj][m][n]; } }
    }
};
__device__ __forceinline__ void ln_out_row(const Bufs& B, int row, int lane) {
    f32x4* xr = (f32x4*)(B.out + (size_t)row * D) + lane;
    f32x4 v[4]; float s = 0.f;
#pragma unroll
    for (int j = 0; j < 4; ++j) { v[j] = xr[64 * j]; s += (v[j].x + v[j].y) + (v[j].z + v[j].w); }
    const float mean = wave_sum(s) * (1.f / D); float s2 = 0.f;
#pragma unroll
    for (int j = 0; j < 4; ++j) { v[j] = v[j] - mean; s2 += (v[j].x * v[j].x + v[j].y * v[j].y) + (v[j].z * v[j].z + v[j].w * v[j].w); }
    const float rstd = rsqrtf(wave_sum(s2) * (1.f / D) + LN_EPS);
#pragma unroll
    for (int j = 0; j < 4; ++j) { const f32x4 g = *((const f32x4*)B.ln_g + lane + 64 * j), b = *((const f32x4*)B.ln_b + lane + 64 * j); xr[64 * j] = v[j] * rstd * g + b; }
}
struct Args { Bufs B; int ph_lo, ph_hi, li, pad; };
__global__ void __launch_bounds__(NWAVES * 64, 2) skel_fwd(Args args) {
    extern __shared__ __attribute__((aligned(16))) unsigned char lds[];
    Frame F;
    F.lds = (LAS unsigned char*)lds; F.MISC = (volatile LAS unsigned*)(F.lds + MISC_OFF);
    F.tid = threadIdx.x; F.lane = F.tid & 63; F.wave = __builtin_amdgcn_readfirstlane(F.tid >> 6);
    F.G = gridDim.x; { const int bx = blockIdx.x; F.vcu = (F.G % 8 == 0) ? (bx % 8) * (F.G / 8) + bx / 8 : bx; }
    F.B = args.B; F.ctl = (unsigned*)(args.B.ws + WS_CTL);
    const Bufs& B = F.B;
    for (int u = F.tid; u < (LDS_BYTES - LDSCTL_OFF) / 4; u += NWAVES * 64) ((LAS unsigned*)(F.lds + LDSCTL_OFF))[u] = 0u;
    __syncthreads();
    XcdBarrier bar = xcd_barrier_post(F.ctl + CW_BAR + args.li * XCD_BAR_WORDS, F.MISC + 8);
    const int lo = args.ph_lo, hi = args.ph_hi;
#define IN(k) (lo <= (k) && (k) < hi)
#define BOTH(k) (IN(k) && IN((k) + 1))
    if (IN(0)) { p0_prologue(F); if (BOTH(0)) xcd_barrier(bar); }
    if (IN(1)) {
        SchedIn S; S.T.init(M / 256, NPOS / 256); S.G = F.G; S.c = (int)blockIdx.x;
        S.XN = (const char*)(B.ws + WS_XN); S.WIN = (const char*)(B.ws + WS_WIN); S.MEMB = (const char*)(B.ws + WS_MEMB); S.WMEM = (const char*)(B.ws + WS_WMEM);
        EpiIn E{B};
        pg8::gemm_phase<EpiIn, SchedIn, true, true>(F.lds + RING_OFF, S, E);
        if (BOTH(1)) xcd_barrier(bar);
    }
    if (IN(2)) { att::attn_phase(F); if (BOTH(2)) xcd_barrier(bar); }
    if (IN(3)) {
        SchedMerge S; S.T.init(M / 256, 4); S.G = F.G; S.c = (int)blockIdx.x;
        S.XN = (const char*)(B.ws + WS_XN); S.WMG = (const char*)(B.ws + WS_WMG); S.QAB = (const char*)(B.ws + WS_QAB); S.QC = (const char*)(B.ws + WS_QC); S.WAB = (const char*)(B.ws + WS_WAB); S.WC = (const char*)(B.ws + WS_WC);
        EpiMerge E{(void*)(B.ws + WS_SCR + (size_t)blockIdx.x * 524288), WSP(bf16, WS_MERGED)};
        pg8::gemm_phase<EpiMerge, SchedMerge, true, true>(F.lds + RING_OFF, S, E);
        if (BOTH(3)) xcd_barrier(bar);
    }
    if (IN(4)) {
        SchedOut S; S.T.init(M / 256, 4); S.G = F.G; S.c = (int)blockIdx.x; S.MG = (const char*)(B.ws + WS_MERGED); S.WO = (const char*)(B.ws + WS_WOUT);
        EpiOutF E{B};
        pg8::gemm_phase<EpiOutF, SchedOut, true, true>(F.lds + RING_OFF, S, E);
        if (BOTH(4)) xcd_barrier(bar);
    }
    if (IN(5)) { const int gw = F.vcu * NWAVES + F.wave, NGW = F.G * NWAVES; for (int m = gw; m < M; m += NGW) ln_out_row(B, m, F.lane); }
#undef IN
#undef BOTH
}
__global__ void k_ln_in(Bufs B) {
    const int lane = threadIdx.x & 63, row = blockIdx.x * 4 + (threadIdx.x >> 6);
    const f32x4* xr = (const f32x4*)(B.x + (size_t)row * D) + lane;
    f32x4 v[4]; float s = 0.f;
#pragma unroll
    for (int j = 0; j < 4; ++j) { v[j] = xr[64 * j]; s += (v[j].x + v[j].y) + (v[j].z + v[j].w); }
#pragma unroll
    for (int o = 1; o < 64; o <<= 1) s += __shfl_xor(s, o);
    const float mean = s * (1.f / D); float s2 = 0.f;
#pragma unroll
    for (int j = 0; j < 4; ++j) { v[j] = v[j] - mean; s2 += (v[j].x * v[j].x + v[j].y * v[j].y) + (v[j].z * v[j].z + v[j].w * v[j].w); }
#pragma unroll
    for (int o = 1; o < 64; o <<= 1) s2 += __shfl_xor(s2, o);
    const float rstd = rsqrtf(s2 * (1.f / D) + LN_EPS);
    if (lane == 0) { float* st = WSP(float, WS_STATS) + (size_t)row * 2; st[0] = mean; st[1] = rstd; }
    unsigned long long* o8 = (unsigned long long*)(WSP(bf16, WS_XN) + (size_t)row * D) + lane;
#pragma unroll
    for (int j = 0; j < 4; ++j) { const f32x4 g = *((const f32x4*)B.ln_in_g + lane + 64 * j), b = *((const f32x4*)B.ln_in_b + lane + 64 * j);
        const f32x4 y = v[j] * rstd * g + b;
        o8[64 * j] = (unsigned long long)pk2(y.x, y.y) | ((unsigned long long)pk2(y.z, y.w) << 32); }
}
__global__ void k_wconv(Bufs B, int kind, int N, size_t dst_off) {
    __shared__ float scr[64][33];
    const int n0 = blockIdx.x * 32, k0 = blockIdx.y * 64, tx = threadIdx.x & 31, ty = threadIdx.x >> 5;
    for (int kk = ty; kk < 64; kk += 8) scr[kk][tx] = wsrc(B, kind, k0 + kk, n0 + tx);
    __syncthreads();
    bf16* dst = WSP(bf16, dst_off);
    const int n = threadIdx.x >> 3, c = threadIdx.x & 7;
    v4u o; o.x = pk2(scr[8 * c + 0][n], scr[8 * c + 1][n]); o.y = pk2(scr[8 * c + 2][n], scr[8 * c + 3][n]); o.z = pk2(scr[8 * c + 4][n], scr[8 * c + 5][n]); o.w = pk2(scr[8 * c + 6][n], scr[8 * c + 7][n]);
    *(v4u*)(dst + (size_t)(n0 + n) * 1024 + k0 + 8 * c) = o;
    (void)N;
}
__global__ void k_misc(Bufs B) {
    const int gid = blockIdx.x * blockDim.x + threadIdx.x, nth = gridDim.x * blockDim.x;
    for (int i = gid; i < MM * D / 4; i += nth) { const f32x4 v = ((const f32x4*)B.mem)[i]; unsigned long long o = (unsigned long long)pk2(v.x, v.y) | ((unsigned long long)pk2(v.z, v.w) << 32); ((unsigned long long*)WSP(bf16, WS_MEMB))[i] = o; }
    for (int i = gid; i < SEQ * 8; i += nth) { const int pos = i >> 3, f = i & 7;
        const float inv = powf(500000.0f, -(float)f * 0.125f); const float ang = (float)pos * inv;
        float* t64 = WSP(float, WS_TAB) + pos * 16; t64[f] = cosf(ang); t64[8 + f] = sinf(ang);
        if ((f & 1) == 0) { float* t32 = WSP(float, WS_TAB32) + pos * 8; t32[f >> 1] = cosf(ang); t32[4 + (f >> 1)] = sinf(ang); } }
    if (gid == 0) { float a = 0.f, b = 0.f; for (int i = 0; i < 64; ++i) { a += B.diff_lambda[i] * B.diff_lambda[64 + i]; b += B.diff_lambda[128 + i] * B.diff_lambda[192 + i]; }
        *WSP(float, WS_LAM) = expf(a) - expf(b) + LAM_INIT; }
}

template <class Epi> __global__ void __launch_bounds__(256) k_ngemm(const bf16* A, const bf16* Bt, int lda, int ldb, int K, int pad_, Epi E) {
    (void)pad_;
    __shared__ float As[32][65], Bs[32][129];
    const int t0 = blockIdx.y * 64, p0 = blockIdx.x * 128, tx = threadIdx.x & 15, ty = threadIdx.x >> 4;
    float acc[4][8];
#pragma unroll
    for (int i = 0; i < 4; ++i)
#pragma unroll
        for (int j = 0; j < 8; ++j) acc[i][j] = 0.f;
    for (int k0 = 0; k0 < K; k0 += 32) {
        for (int e = threadIdx.x; e < 64 * 32; e += 256) { const int r = e >> 5, c = e & 31; As[c][r] = bf2f(A[(size_t)(t0 + r) * lda + k0 + c]); }
        for (int e = threadIdx.x; e < 128 * 32; e += 256) { const int r = e >> 5, c = e & 31; Bs[c][r] = bf2f(Bt[(size_t)(p0 + r) * ldb + k0 + c]); }
        __syncthreads();
#pragma unroll 4
        for (int kk = 0; kk < 32; ++kk) { float a[4], b[8];
#pragma unroll
            for (int i = 0; i < 4; ++i) a[i] = As[kk][ty * 4 + i];
#pragma unroll
            for (int j = 0; j < 8; ++j) b[j] = Bs[kk][tx * 8 + j];
#pragma unroll
            for (int i = 0; i < 4; ++i)
#pragma unroll
                for (int j = 0; j < 8; ++j) acc[i][j] += a[i] * b[j]; }
        __syncthreads();
    }
#pragma unroll
    for (int i = 0; i < 4; ++i) E(t0 + ty * 4 + i, p0 + tx * 8, acc[i]);
}
struct EpiInproj { Bufs B; __device__ void operator()(int t, int p0, float* v) const { inproj_emit8(B, t, p0, v); } };
struct EpiPlainBf16 { bf16* O; int ldo; int pad; __device__ void operator()(int t, int p0, float* v) const { store8(O + (size_t)t * ldo + p0, v); } };
struct EpiGate { bf16* O; __device__ void operator()(int t, int p0, float* v) const { float g[8];
#pragma unroll
    for (int j = 0; j < 8; ++j) g[j] = sigmoid_f(v[j]); store8(O + (size_t)t * 1024 + p0, g); } };
struct EpiYacc { const bf16* G; float* acc; int first; int pad; __device__ void operator()(int t, int p0, float* v) const {
    const v4u gw = *(const v4u*)(G + (size_t)t * 1024 + p0); float* a = acc + (size_t)t * 1024 + p0;
    const unsigned gg[4] = {gw.x, gw.y, gw.z, gw.w};
#pragma unroll
    for (int j = 0; j < 8; ++j) { const float g = bf2f((gg[j >> 1] >> (16 * (j & 1))) & 0xffffu); const float r = g * v[j]; a[j] = first ? r : a[j] + r; } } };
struct EpiOut { Bufs B; __device__ void operator()(int t, int p0, float* v) const {
    const float* st = WSP(const float, WS_STATS) + (size_t)t * 2; const float mean = st[0], rstd = st[1];
    float* o = B.out + (size_t)t * 1024 + p0; const float* xr = B.x + (size_t)t * 1024 + p0;
#pragma unroll
    for (int j = 0; j < 8; ++j) { const float h = (xr[j] - mean) * rstd * B.ln_in_g[p0 + j] + B.ln_in_b[p0 + j]; o[j] = ALPHA * h + v[j]; } } };
__global__ void k_f32_to_bf16(const float* src, bf16* dst, size_t n4) {
    for (size_t i = (size_t)blockIdx.x * blockDim.x + threadIdx.x; i < n4; i += (size_t)gridDim.x * blockDim.x) { const f32x4 v = ((const f32x4*)src)[i];
        ((unsigned long long*)dst)[i] = (unsigned long long)pk2(v.x, v.y) | ((unsigned long long)pk2(v.z, v.w) << 32); }
}
__global__ void k_ln_out(Bufs B) {
    const int lane = threadIdx.x & 63, row = blockIdx.x * 4 + (threadIdx.x >> 6);
    f32x4* xr = (f32x4*)(B.out + (size_t)row * D) + lane;
    f32x4 v[4]; float s = 0.f;
#pragma unroll
    for (int j = 0; j < 4; ++j) { v[j] = xr[64 * j]; s += (v[j].x + v[j].y) + (v[j].z + v[j].w); }
#pragma unroll
    for (int o = 1; o < 64; o <<= 1) s += __shfl_xor(s, o);
    const float mean = s * (1.f / D); float s2 = 0.f;
#pragma unroll
    for (int j = 0; j < 4; ++j) { v[j] = v[j] - mean; s2 += (v[j].x * v[j].x + v[j].y * v[j].y) + (v[j].z * v[j].z + v[j].w * v[j].w); }
#pragma unroll
    for (int o = 1; o < 64; o <<= 1) s2 += __shfl_xor(s2, o);
    const float rstd = rsqrtf(s2 * (1.f / D) + LN_EPS);
#pragma unroll
    for (int j = 0; j < 4; ++j) { const f32x4 g = *((const f32x4*)B.ln_g + lane + 64 * j), b = *((const f32x4*)B.ln_b + lane + 64 * j); xr[64 * j] = v[j] * rstd * g + b; }
}

__device__ __forceinline__ unsigned sortable_key(float score, int idx) {
    const unsigned b = __float_as_uint(score); const unsigned k = b ^ ((unsigned)((int)b >> 31) | 0x80000000u);
    return (k & ~0x7FFu) | (unsigned)(2047 - idx);
}
__device__ __forceinline__ float block_sum(float v, float* red) {
#pragma unroll
    for (int o = 1; o < 64; o <<= 1) v += __shfl_xor(v, o);
    __syncthreads(); if ((threadIdx.x & 63) == 0) red[threadIdx.x >> 6] = v; __syncthreads();
    return red[0] + red[1] + red[2] + red[3];
}
__device__ __forceinline__ float block_max(float v, float* red) {
#pragma unroll
    for (int o = 1; o < 64; o <<= 1) v = fmaxf(v, __shfl_xor(v, o));
    __syncthreads(); if ((threadIdx.x & 63) == 0) red[threadIdx.x >> 6] = v; __syncthreads();
    return fmaxf(fmaxf(red[0], red[1]), fmaxf(red[2], red[3]));
}
__global__ void __launch_bounds__(256) k_nmask(Bufs B) {
    __shared__ unsigned keys[SEQ]; __shared__ float iq[256]; __shared__ float iw[8]; __shared__ unsigned cnts[4]; __shared__ unsigned tau_s;
    const int row = blockIdx.x, b = row >> 11, t = row & (SEQ - 1), limit = ((t >> 6) + 1) << 6, tid = threadIdx.x;
    iq[tid] = bf2f(WSP(const bf16, WS_IQ)[(size_t)row * 256 + tid]); if (tid < 8) iw[tid] = WSP(const float, WS_IW)[(size_t)row * 8 + tid];
    __syncthreads();
    const bf16* IK = WSP(const bf16, WS_IK) + (size_t)b * SEQ * 32;
    for (int s = tid; s < limit; s += 256) { float kk[32];
#pragma unroll
        for (int d = 0; d < 32; ++d) kk[d] = bf2f(IK[(size_t)s * 32 + d]);
        float sc = 0.f;
        for (int h = 0; h < 8; ++h) { float dt = 0.f;
#pragma unroll
            for (int d = 0; d < 32; ++d) dt += iq[h * 32 + d] * kk[d];
            sc += iw[h] * fmaxf(dt, 0.f); }
        keys[s] = sortable_key(sc, s); }
    __syncthreads();
    unsigned tau = 1u;
    if (limit > 256) { unsigned lo = 1u, hi = 0xFFFFFFFFu;
        for (;;) { if (hi - lo <= 1u) { tau = lo; break; }
            const unsigned mid = lo + ((hi - lo) >> 1); unsigned c = 0;
            for (int s = tid; s < limit; s += 256) c += (keys[s] >= mid) ? 1u : 0u;
#pragma unroll
            for (int o = 1; o < 64; o <<= 1) c += __shfl_xor(c, o);
            __syncthreads(); if ((tid & 63) == 0) cnts[tid >> 6] = c; __syncthreads();
            const unsigned tot = cnts[0] + cnts[1] + cnts[2] + cnts[3];
            if (tot == 256u) { tau = mid; break; } else if (tot > 256u) lo = mid; else hi = mid; } }
    if (tid < 64) { unsigned w = 0; for (int j = 0; j < 32; ++j) { const int s = tid * 32 + j; if (s < limit && keys[s] >= tau) w |= 1u << j; }
        WSP(unsigned, WS_MASK)[(size_t)row * 64 + tid] = w; }
}
__global__ void __launch_bounds__(256) k_nattnA(Bufs B) {
    __shared__ float q[64]; __shared__ float p[SEQ]; __shared__ float red[4];
    const int row = blockIdx.x >> 3, h = blockIdx.x & 7, b = row >> 11, t = row & (SEQ - 1), limit = ((t >> 6) + 1) << 6, tid = threadIdx.x;
    bf16* Q = WSP(bf16, WS_QAB) + (size_t)row * 1024 + h * 64;
    if (tid < 64) q[tid] = bf2f(Q[tid]);
    __syncthreads();
    const bf16* K = WSP(const bf16, WS_AK) + (size_t)b * SEQ * 64; const bf16* V = WSP(const bf16, WS_AV) + (size_t)b * SEQ * 64;
    const unsigned* mk = WSP(const unsigned, WS_MASK) + (size_t)row * 64;
    float mx = -INFINITY;
    for (int s = tid; s < limit; s += 256) { float l = -INFINITY;
        if ((mk[s >> 5] >> (s & 31)) & 1u) { l = 0.f; for (int d = 0; d < 64; ++d) l += q[d] * bf2f(K[(size_t)s * 64 + d]); }
        p[s] = l; mx = fmaxf(mx, l); }
    mx = block_max(mx, red);
    float sm = 0.f;
    for (int s = tid; s < limit; s += 256) { const float e = exp2f(p[s] - mx); p[s] = e; sm += e; }
    sm = block_sum(sm, red);
    __syncthreads();
    const int d = tid & 63, g = tid >> 6; float o = 0.f;
    for (int s = g; s < limit; s += 4) o += p[s] * bf2f(V[(size_t)s * 64 + d]);
    __shared__ float og[4][64]; og[g][d] = o; __syncthreads();
    if (tid < 64) { const float ov = (og[0][tid] + og[1][tid] + og[2][tid] + og[3][tid]) / sm; const float gate = bf2f(WSP(const bf16, WS_AG)[(size_t)row * 512 + h * 64 + tid]);
        Q[tid] = (bf16)f2bf(ov * gate); }
}
__global__ void __launch_bounds__(256) k_nattnB(Bufs B) {
    __shared__ float q[128]; __shared__ float p0[SEQ]; __shared__ float p1[SEQ]; __shared__ float red[4]; __shared__ float og[2][128];
    const int row = blockIdx.x >> 2, h = blockIdx.x & 3, b = row >> 11, t = row & (SEQ - 1), limit = ((t >> 6) + 1) << 6, tid = threadIdx.x;
    bf16* Q = WSP(bf16, WS_QAB) + (size_t)row * 1024 + 512 + h * 128;
    if (tid < 128) q[tid] = bf2f(Q[tid]);
    __syncthreads();
    const bf16* K = WSP(const bf16, WS_BK) + (size_t)b * SEQ * 512 + h * 128; const bf16* V = WSP(const bf16, WS_BV) + (size_t)b * SEQ * 512 + h * 128;
    const float lam = *WSP(const float, WS_LAM);
    float m0 = -INFINITY, m1 = -INFINITY;
    for (int s = tid; s < limit; s += 256) { float l0 = 0.f, l1 = 0.f;
        for (int d = 0; d < 64; ++d) { l0 += q[d] * bf2f(K[(size_t)s * 512 + d]); l1 += q[64 + d] * bf2f(K[(size_t)s * 512 + 64 + d]); }
        p0[s] = l0; p1[s] = l1; m0 = fmaxf(m0, l0); m1 = fmaxf(m1, l1); }
    m0 = block_max(m0, red); m1 = block_max(m1, red);
    float s0 = 0.f, s1 = 0.f;
    for (int s = tid; s < limit; s += 256) { const float e0 = exp2f(p0[s] - m0), e1 = exp2f(p1[s] - m1); p0[s] = e0; p1[s] = e1; s0 += e0; s1 += e1; }
    s0 = block_sum(s0, red); s1 = block_sum(s1, red);
    __syncthreads();
    for (int s = tid; s < limit; s += 256) p0[s] = p0[s] / s0 - lam * (p1[s] / s1);
    __syncthreads();
    const int e = tid & 127, g = tid >> 7; float o = 0.f;
    for (int s = g; s < limit; s += 2) o += p0[s] * bf2f(V[(size_t)s * 512 + e]);
    og[g][e] = o; __syncthreads();
    float ov = 0.f, sq = 0.f; if (tid < 128) { ov = og[0][tid] + og[1][tid]; sq = ov * ov; }
    sq = block_sum(sq, red);
    if (tid < 128) { const float r = rsqrtf(sq * (1.f / 128.f) + LN_EPS); const float gate = bf2f(WSP(const bf16, WS_BG)[(size_t)row * 512 + h * 128 + tid]);
        Q[tid] = (bf16)f2bf(ov * r * B.diff_norm_g[tid] * (1.f - LAM_INIT) * gate); }
}
__global__ void __launch_bounds__(128) k_nattnC(Bufs B) {
    __shared__ float q[128]; __shared__ float p[MEM_LEN]; __shared__ float red2[2];
    const int row = blockIdx.x >> 2, h = blockIdx.x & 3, b = row >> 11, tid = threadIdx.x;
    bf16* Q = WSP(bf16, WS_QC) + (size_t)row * 1024 + h * 128;
    q[tid] = bf2f(Q[tid]);
    __syncthreads();
    const bf16* KV = WSP(const bf16, WS_MKV) + (size_t)b * MEM_LEN * 1024;
    float mx = -INFINITY;
    for (int m = tid; m < MEM_LEN; m += 128) { float l = 0.f; for (int d = 0; d < 128; ++d) l += q[d] * bf2f(KV[(size_t)m * 1024 + h * 128 + d]); p[m] = l; mx = fmaxf(mx, l); }
#pragma unroll
    for (int o = 1; o < 64; o <<= 1) mx = fmaxf(mx, __shfl_xor(mx, o));
    __syncthreads(); if ((tid & 63) == 0) red2[tid >> 6] = mx; __syncthreads(); mx = fmaxf(red2[0], red2[1]);
    float sm = 0.f;
    for (int m = tid; m < MEM_LEN; m += 128) { const float e = exp2f(p[m] - mx); p[m] = e; sm += e; }
#pragma unroll
    for (int o = 1; o < 64; o <<= 1) sm += __shfl_xor(sm, o);
    __syncthreads(); if ((tid & 63) == 0) red2[tid >> 6] = sm; __syncthreads(); sm = red2[0] + red2[1];
    float o = 0.f;
    for (int m = 0; m < MEM_LEN; ++m) o += p[m] * bf2f(KV[(size_t)m * 1024 + 512 + h * 128 + tid]);
    const float gate = bf2f(WSP(const bf16, WS_QC)[(size_t)row * 1024 + 512 + h * 128 + tid]);
    Q[tid] = (bf16)f2bf(o / sm * gate);
}

#ifndef FAST_UPTO
#define FAST_UPTO 6
#endif
static void launch_skel(const Bufs& B, int lo, int hi, int li, hipStream_t stream, int grid) {
    Args a{}; a.B = B; a.ph_lo = lo; a.ph_hi = hi; a.li = li; a.pad = 0;
    hipLaunchKernelGGL(skel_fwd, dim3(grid), dim3(NWAVES * 64), LDS_BYTES, stream, a);
}
extern "C" void kernel_launch(void* const* d_in, const int* in_sizes, int n_in, void* d_out, int out_size, void* d_ws, size_t ws_size, hipStream_t stream) {
    (void)in_sizes; (void)n_in; (void)out_size;
    static int grid = 0;
    if (grid == 0) {
        if (ws_size < WS_END2) { fprintf(stderr, "workspace too small: %zu < %zu\n", ws_size, (size_t)WS_END2); grid = -1; return; }
        int dev = 0, cus = 0;
        if (hipGetDevice(&dev) != hipSuccess || hipDeviceGetAttribute(&cus, hipDeviceAttributeMultiprocessorCount, dev) != hipSuccess) { grid = -1; return; }
        if (hipFuncSetAttribute((const void*)skel_fwd, hipFuncAttributeMaxDynamicSharedMemorySize, LDS_BYTES) != hipSuccess) { fprintf(stderr, "hipFuncSetAttribute failed\n"); grid = -1; return; }
        int per_cu = 0; (void)hipOccupancyMaxActiveBlocksPerMultiprocessor(&per_cu, (const void*)skel_fwd, NWAVES * 64, LDS_BYTES); (void)hipGetLastError();
        if (per_cu < 1) fprintf(stderr, "note: occupancy query reports %d blocks/CU\n", per_cu);
        grid = cus;
    }
    if (grid < 0) return;
    Bufs B{};
    B.x = (const float*)d_in[0]; B.mem = (const float*)d_in[1]; B.ln_in_g = (const float*)d_in[2]; B.ln_in_b = (const float*)d_in[3]; B.w_in = (const float*)d_in[4];
    B.w_mem_kv = (const float*)d_in[5]; B.diff_lambda = (const float*)d_in[6]; B.diff_norm_g = (const float*)d_in[7]; B.w_proj_a = (const float*)d_in[8];
    B.w_proj_b = (const float*)d_in[9]; B.w_proj_c = (const float*)d_in[10]; B.w_out = (const float*)d_in[11]; B.ln_g = (const float*)d_in[12]; B.ln_b = (const float*)d_in[13];
    B.out = (float*)d_out; B.ws = (unsigned char*)d_ws;
    unsigned char* ws = B.ws;
    (void)hipMemsetAsync(ws + WS_CTL, 0, CTL_ZERO_BYTES, stream);
    launch_skel(B, 0, FAST_UPTO, 0, stream, grid);
#if FAST_UPTO < 1
    k_ln_in<<<M / 4, 256, 0, stream>>>(B);
    k_wconv<<<dim3(NPOS / 32, 16), 256, 0, stream>>>(B, 0, NPOS, WS_WIN);
    k_wconv<<<dim3(3072 / 32, 16), 256, 0, stream>>>(B, 1, 3072, WS_WMG);
    k_wconv<<<dim3(1024 / 32, 16), 256, 0, stream>>>(B, 2, 1024, WS_WMEM);
    k_wconv<<<dim3(1024 / 32, 16), 256, 0, stream>>>(B, 3, 1024, WS_WAB);
    k_wconv<<<dim3(1024 / 32, 16), 256, 0, stream>>>(B, 4, 1024, WS_WC);
    k_wconv<<<dim3(1024 / 32, 16), 256, 0, stream>>>(B, 5, 1024, WS_WOUT);
    k_misc<<<256, 256, 0, stream>>>(B);
#endif
#if FAST_UPTO < 2
    k_ngemm<EpiInproj><<<dim3(NPOS / 128, M / 64), 256, 0, stream>>>((const bf16*)(ws + WS_XN), (const bf16*)(ws + WS_WIN), 1024, 1024, 1024, 0, EpiInproj{B});
    k_ngemm<EpiPlainBf16><<<dim3(1024 / 128, MM / 64), 256, 0, stream>>>((const bf16*)(ws + WS_MEMB), (const bf16*)(ws + WS_WMEM), 1024, 1024, 1024, 0, EpiPlainBf16{(bf16*)(ws + WS_MKV), 1024, 0});
#endif
#if FAST_UPTO < 3 || !FAST_A
    k_nmask<<<M, 256, 0, stream>>>(B);
    k_nattnA<<<M * 8, 256, 0, stream>>>(B);
#endif
#if FAST_UPTO < 3 || !FAST_B
    k_nattnB<<<M * 4, 256, 0, stream>>>(B);
#endif
#if FAST_UPTO < 3 || !FAST_C
    k_nattnC<<<M * 4, 128, 0, stream>>>(B);
#endif
#if FAST_UPTO < 4
    for (int br = 0; br < 3; ++br) {
        k_ngemm<EpiGate><<<dim3(1024 / 128, M / 64), 256, 0, stream>>>((const bf16*)(ws + WS_XN), (const bf16*)(ws + WS_WMG) + (size_t)br * 1024 * 1024, 1024, 1024, 1024, 0, EpiGate{(bf16*)(ws + WS_GTMP)});
        const bf16* A = br < 2 ? (const bf16*)(ws + WS_QAB) + br * 512 : (const bf16*)(ws + WS_QC);
        const bf16* Bt = br < 2 ? (const bf16*)(ws + WS_WAB) + br * 512 : (const bf16*)(ws + WS_WC);
        k_ngemm<EpiYacc><<<dim3(1024 / 128, M / 64), 256, 0, stream>>>(A, Bt, 1024, 1024, 512, 0, EpiYacc{(const bf16*)(ws + WS_GTMP), (float*)d_out, br == 0 ? 1 : 0, 0});
    }
    k_f32_to_bf16<<<2048, 256, 0, stream>>>((const float*)d_out, (bf16*)(ws + WS_MERGED), (size_t)M * 1024 / 4);
#endif
#if FAST_UPTO < 6
    k_ngemm<EpiOut><<<dim3(1024 / 128, M / 64), 256, 0, stream>>>((const bf16*)(ws + WS_MERGED), (const bf16*)(ws + WS_WOUT), 1024, 1024, 1024, 0, EpiOut{B});
    k_ln_out<<<M / 4, 256, 0, stream>>>(B);
#endif
}
```

```cpp
#include <hip/hip_runtime.h>
#include <hip/hip_bf16.h>
#include <cstdint>
#include <cstdio>
#include <cmath>

typedef unsigned short bf16;
typedef unsigned v4u __attribute__((ext_vector_type(4)));
typedef float f32x4 __attribute__((ext_vector_type(4)));

constexpr int D = 1024, BATCH = 16, SEQ = 2048, M = BATCH * SEQ;
constexpr int MEM_LEN = 256, MM = BATCH * MEM_LEN;
constexpr int IN_WIDTH = 7592;
constexpr int NPOS = 7680;
constexpr int O_AQ = 0, O_AK = 512, O_AV = 576, O_AG = 640, O_IQ = 1152, O_IK = 1408, O_IW = 1440, O_BQ = 1448, O_BK = 1960, O_BV = 2472,
              O_BG = 2984, O_CQ = 3496, O_CG = 4008, O_MG = 4520;
constexpr float LN_EPS = 1e-5f;
constexpr float LOG2E = 1.4426950408889634f;
constexpr float ALPHA = 1.189207115002721f;
constexpr float LAM_INIT = 0.2f;

constexpr size_t MiB = 1u << 20;
constexpr size_t WS_CTL = 0;
constexpr size_t WS_TAB = 1 * MiB;
constexpr size_t WS_TAB32 = WS_TAB + 128 * 1024;
constexpr size_t WS_LAM = WS_TAB + 256 * 1024;
constexpr size_t WS_STATS = WS_TAB + 512 * 1024;
constexpr size_t WS_WIN = 2 * MiB;
constexpr size_t WS_WMG = 11 * MiB;
constexpr size_t WS_WMEM = 17 * MiB;
constexpr size_t WS_WAB = 19 * MiB;
constexpr size_t WS_WC = 21 * MiB;
constexpr size_t WS_WOUT = 23 * MiB;
constexpr size_t WS_MEMB = 25 * MiB;
constexpr size_t WS_MKV = 2 * MiB;
constexpr size_t WS_XN = 41 * MiB;
constexpr size_t WS_QAB = 105 * MiB;
constexpr size_t WS_QC = 169 * MiB;
constexpr size_t WS_AG = 233 * MiB;
constexpr size_t WS_BK = 265 * MiB;
constexpr size_t WS_BV = 297 * MiB;
constexpr size_t WS_BG = 329 * MiB;
constexpr size_t WS_IQ = 361 * MiB;
constexpr size_t WS_AK = 377 * MiB;
constexpr size_t WS_AV = 381 * MiB;
constexpr size_t WS_IK = 385 * MiB;
constexpr size_t WS_IW = 387 * MiB;
constexpr size_t WS_MASK = 388 * MiB;
constexpr size_t WS_MERGED = WS_BK;
constexpr size_t WS_GTMP = WS_BG;
constexpr size_t WS_GB = 388 * MiB;
constexpr size_t WS_GA = 452 * MiB;
constexpr size_t WS_GC = 484 * MiB;
constexpr size_t WS_GC2 = 33 * MiB;
constexpr int GC_SPLIT = 28672;
constexpr size_t WS_END = 512 * MiB;

__device__ __forceinline__ unsigned f2bf(float f) { unsigned u = __float_as_uint(f); return (u + 0x7fffu + ((u >> 16) & 1u)) >> 16; }
__device__ __forceinline__ float bf2f(unsigned v) { return __uint_as_float(v << 16); }
__device__ __forceinline__ unsigned pk2(float lo, float hi) { typedef float f2_ __attribute__((ext_vector_type(2))); typedef __bf16 b2_ __attribute__((ext_vector_type(2))); f2_ v = {lo, hi}; b2_ b = __builtin_convertvector(v, b2_); return __builtin_bit_cast(unsigned, b); }
__device__ __forceinline__ float silu_f(float x) { return x * __builtin_amdgcn_rcpf(1.f + __builtin_amdgcn_exp2f(-LOG2E * x)); }
__device__ __forceinline__ float sigmoid_f(float x) { return 1.f / (1.f + __expf(-x)); }

__host__ __device__ __forceinline__ int rp64(int j) { return j < 16 ? ((j >> 1) + 8 * (j & 1)) : j; }
__host__ __device__ __forceinline__ int rp32(int j) { return j < 8 ? ((j >> 1) + 4 * (j & 1)) : j; }
__host__ __device__ __forceinline__ int orig_of_pos(int p) {
    const int tile = p >> 8;
    if (tile < 2) { return O_AQ + (p & ~63) + rp64(p & 63); }
    if (tile < 4) { return O_AG + (p - 512); }
    if (tile < 6) { const int c = p - 1024; return O_BQ + (c & ~63) + rp64(c & 63); }
    if (tile < 8) { const int c = p - 1536; return O_BK + (c & ~63) + rp64(c & 63); }
    if (tile < 10) { return O_BV + (p - 2048); }
    if (tile < 12) { return O_BG + (p - 2560); }
    if (tile < 14) { return O_CQ + (p - 3072); }
    if (tile < 16) { return O_CG + (p - 3584); }
    if (tile == 16) { const int c = p - 4096; return O_IQ + (c & ~31) + rp32(c & 31); }
    if (tile >= 18) return O_MG + (p - 4608);
    const int j = p - 4352;
    if (j < 64) return O_AK + rp64(j);
    if (j < 128) return O_AV + (j - 64);
    if (j < 160) return O_IK + rp32(j - 128);
    if (j < 168) return O_IW + (j - 160);
    return -1;
}

struct Bufs {
    const float *x, *mem, *ln_in_g, *ln_in_b, *w_in, *w_mem_kv, *diff_lambda, *diff_norm_g, *w_proj_a, *w_proj_b, *w_proj_c, *w_out, *ln_g, *ln_b;
    float* out; unsigned char* ws;
};
#define WSP(T, off) ((T*)(B.ws + (off)))

__device__ __forceinline__ void rope8_64(float* v, const float* tab, int i0) {
    const f32x4 c = *(const f32x4*)(tab + i0), s = *(const f32x4*)(tab + 8 + i0);
#pragma unroll
    for (int j = 0; j < 4; ++j) { const float x1 = v[2 * j], x2 = v[2 * j + 1]; v[2 * j] = x1 * c[j] - x2 * s[j]; v[2 * j + 1] = x2 * c[j] + x1 * s[j]; }
}
__device__ __forceinline__ void store8c(bf16* dst, const float* v) {
    v4u o; o.x = pk2(v[0], v[1]); o.y = pk2(v[2], v[3]); o.z = pk2(v[4], v[5]); o.w = pk2(v[6], v[7]); *(v4u*)dst = o;
}
__device__ __forceinline__ void store8(bf16* dst, const float* v) {
    v4u o; o.x = pk2(v[0], v[1]); o.y = pk2(v[2], v[3]); o.z = pk2(v[4], v[5]); o.w = pk2(v[6], v[7]); __builtin_nontemporal_store(o, (v4u*)dst);
}
enum { K_AQ = 0, K_AG, K_BQ, K_BK, K_BV, K_BG, K_CQ, K_CG, K_IQ, K_MISC, K_MG };
__host__ __device__ __forceinline__ int kind_of_tile(int tile) { return tile < 16 ? (tile >> 1) : (tile == 16 ? K_IQ : (tile == 17 ? K_MISC : K_MG)); }
__device__ __forceinline__ void rope8_32(float* v, const float* tab32) {
    const f32x4 cs = *(const f32x4*)(tab32), sn = *(const f32x4*)(tab32 + 4);
#pragma unroll
    for (int j = 0; j < 4; ++j) { const float x1 = v[2 * j], x2 = v[2 * j + 1]; v[2 * j] = x1 * cs[j] - x2 * sn[j]; v[2 * j + 1] = x2 * cs[j] + x1 * sn[j]; }
}
template <int KIND> __device__ __forceinline__ void emit8k(const Bufs& B, int t, int c, float* v) {
    const int pos = t & (SEQ - 1);
    const float* tab64 = WSP(const float, WS_TAB) + pos * 16;
    const float* tab32 = WSP(const float, WS_TAB32) + pos * 8;
    const float SQ64 = 0.125f * LOG2E, SQ128 = 0.08838834764831845f * LOG2E;
    if constexpr (KIND == K_AQ || KIND == K_BQ) {
        const int w = c & 63; if (w < 16) rope8_64(v, tab64, w >> 1);
#pragma unroll
        for (int j = 0; j < 8; ++j) v[j] *= SQ64;
        store8(WSP(bf16, WS_QAB) + (size_t)t * 1024 + (KIND == K_BQ ? 512 : 0) + c, v);
    } else if constexpr (KIND == K_AG || KIND == K_BG) {
#pragma unroll
        for (int j = 0; j < 8; ++j) v[j] = silu_f(v[j]);
        store8(WSP(bf16, KIND == K_AG ? WS_AG : WS_BG) + (size_t)t * 512 + c, v);
    } else if constexpr (KIND == K_BK) {
        const int w = c & 63; if (w < 16) rope8_64(v, tab64, w >> 1);
        store8c(WSP(bf16, WS_BK) + (size_t)t * 512 + c, v);
    } else if constexpr (KIND == K_BV) {
        store8c(WSP(bf16, WS_BV) + (size_t)t * 512 + c, v);
    } else if constexpr (KIND == K_CQ) {
#pragma unroll
        for (int j = 0; j < 8; ++j) v[j] *= SQ128;
        store8(WSP(bf16, WS_QC) + (size_t)t * 1024 + c, v);
    } else if constexpr (KIND == K_CG) {
#pragma unroll
        for (int j = 0; j < 8; ++j) v[j] = silu_f(v[j]);
        store8(WSP(bf16, WS_QC) + (size_t)t * 1024 + 512 + c, v);
    } else if constexpr (KIND == K_IQ) {
        if ((c & 31) < 8) rope8_32(v, tab32);
        store8(WSP(bf16, WS_IQ) + (size_t)t * 256 + c, v);
    } else if constexpr (KIND == K_MG) {
#pragma unroll
        for (int j = 0; j < 8; ++j) v[j] = __builtin_amdgcn_rcpf(1.f + __builtin_amdgcn_exp2f(-LOG2E * v[j]));
        const int br = c >> 10, col = c & 1023, pm_ = t >> 8, r_ = t & 255, cc_ = col & 255;
        const int ix_ = (r_ >> 7) * 8 + (cc_ >> 7) * 4 + ((r_ >> 4) & 3), wv_ = ((r_ >> 6) & 1) * 4 + ((cc_ >> 5) & 3), ln_ = ((cc_ >> 3) & 3) * 16 + (r_ & 15);
        const size_t tl_ = (size_t)(pm_ * 4 + (col >> 8)) * 8 + wv_;
        if (br == 1) store8(WSP(bf16, WS_GB) + (tl_ * 16384 + (size_t)(ix_ * 64 + ln_) * 16) / 2, v);
        else { unsigned long long w = 0;
#pragma unroll
            for (int j = 0; j < 8; ++j) w |= (unsigned long long)(unsigned)__builtin_rintf(v[j] * 255.f) << (8 * j);
            const size_t o_ = tl_ * 8192 + (size_t)((ix_ >> 1) * 64 + ln_) * 16 + (ix_ & 1) * 8;
            unsigned char* gp = br == 0 ? WSP(unsigned char, WS_GA) + o_ : (t < GC_SPLIT ? WSP(unsigned char, WS_GC) + o_ : WSP(unsigned char, WS_GC2) + (o_ - (size_t)GC_SPLIT * 1024));
            __builtin_nontemporal_store(w, (unsigned long long*)gp); }
    } else {
        if (c < 64) { if (c < 16) rope8_64(v, tab64, c >> 1); store8c(WSP(bf16, WS_AK) + (size_t)t * 64 + c, v); }
        else if (c < 128) { store8c(WSP(bf16, WS_AV) + (size_t)t * 64 + (c - 64), v); }
        else if (c < 160) { const int w = c - 128; if (w < 8) rope8_32(v, tab32); store8c(WSP(bf16, WS_IK) + (size_t)t * 32 + w, v); }
        else if (c == 160) { float* o = WSP(float, WS_IW) + (size_t)t * 8; *(f32x4*)o = (f32x4){v[0] * 0.0625f, v[1] * 0.0625f, v[2] * 0.0625f, v[3] * 0.0625f}; *(f32x4*)(o + 4) = (f32x4){v[4] * 0.0625f, v[5] * 0.0625f, v[6] * 0.0625f, v[7] * 0.0625f}; }
    }
}
__device__ __forceinline__ void inproj_emit8(const Bufs& B, int t, int p0, float* v) {
    const int tile = p0 >> 8, c = (tile < 16) ? (p0 & 511) : (tile < 18 ? (p0 & 255) : p0 - 4608);
    switch (kind_of_tile(tile)) {
    case K_AQ: emit8k<K_AQ>(B, t, c, v); break;  case K_AG: emit8k<K_AG>(B, t, c, v); break;
    case K_BQ: emit8k<K_BQ>(B, t, c, v); break;  case K_BK: emit8k<K_BK>(B, t, c, v); break;
    case K_BV: emit8k<K_BV>(B, t, c, v); break;  case K_BG: emit8k<K_BG>(B, t, c, v); break;
    case K_CQ: emit8k<K_CQ>(B, t, c, v); break;  case K_CG: emit8k<K_CG>(B, t, c, v); break;
    case K_IQ: emit8k<K_IQ>(B, t, c, v); break;  case K_MG: emit8k<K_MG>(B, t, c, v); break;  default:   emit8k<K_MISC>(B, t, c, v); break;
    }
}
__device__ __forceinline__ float wsrc(const Bufs& B, int kind, int k, int n) {
    switch (kind) {
    case 0: { const int o = orig_of_pos(n); return o < 0 ? 0.f : __builtin_nontemporal_load(B.w_in + (size_t)k * IN_WIDTH + o); }
    case 1: return __builtin_nontemporal_load(B.w_in + (size_t)k * IN_WIDTH + O_MG + n);
    case 2: return __builtin_nontemporal_load(B.w_mem_kv + (size_t)k * 1024 + n);
    case 3: return k < 512 ? __builtin_nontemporal_load(B.w_proj_a + (size_t)k * 1024 + n) : __builtin_nontemporal_load(B.w_proj_b + (size_t)(k - 512) * 1024 + n);
    case 4: return k < 512 ? __builtin_nontemporal_load(B.w_proj_c + (size_t)k * 1024 + n) : 0.f;
    default: return __builtin_nontemporal_load(B.w_out + (size_t)k * 1024 + n);
    }
}

namespace pg8 {
#define PG8_LAS __attribute__((address_space(3)))
typedef unsigned short bf16_t;
typedef short bf16x8 __attribute__((ext_vector_type(8)));
typedef float f32x4 __attribute__((ext_vector_type(4)));
typedef unsigned u32x4 __attribute__((ext_vector_type(4)));
constexpr int BM = 256, BK = 64, HALF = 128, HTB = HALF * BK * 2, STAGE_BYTES = 8 * HTB, NXCD = 8, WGM = 8, KP = 1024;
constexpr size_t TSTEP = (size_t)BM * KP * 2;

__host__ __device__ __forceinline__ int lds_byte(int r, int c) { const int st = (r >> 4) * 2 + (c >> 5), rr = r & 15, cc = c & 31, ob = rr * 64 + cc * 2; return st * 1024 + (ob ^ (((ob >> 9) & 1) << 5)); }
__host__ __device__ __forceinline__ void stage_rc(int b, int& R, int& C) { const int st = b / 1024, sb = b % 1024, swz = sb ^ (((sb >> 9) & 1) << 5); R = (st >> 1) * 16 + swz / 64; C = (st & 1) * 32 + (swz % 64) / 2; }
__host__ __device__ __forceinline__ int perm32(int rho) { const int n = rho >> 4, i = rho & 15; return 8 * (i >> 2) + 4 * n + (i & 3); }

struct Unit { int pm, pn; const char* A; const char* B; int nt; int kind; int keep; int pad; };

struct TileOrder {
    int nM, nN, nwg;
    __host__ __device__ void init(int nM_, int nN_) { nM = nM_; nN = nN_; nwg = nM * nN; }
    __host__ __device__ void tile(int L, int& pm, int& pn) const {
        int wgid = L; { const int q = nwg / NXCD, r = nwg % NXCD, xcd = wgid % NXCD, off = wgid / NXCD; wgid = (xcd < r ? xcd * (q + 1) : r * (q + 1) + (xcd - r) * q) + off; }
        const int nig = WGM * nN, gid = wgid / nig, fm = gid * WGM, gsz = (nM - fm) < WGM ? (nM - fm) : WGM;
        pm = fm + ((wgid % nig) % gsz); pn = (wgid % nig) / gsz;
    }
};
__device__ __forceinline__ unsigned cvt_pk_bf16(float lo, float hi) { unsigned r; asm volatile("v_cvt_pk_bf16_f32 %0, %1, %2" : "=v"(r) : "v"(lo), "v"(hi)); return r; }

template <class Epi, class Sched, bool ALIGN_EPI = false, bool SP2 = false>
__device__ __forceinline__ void gemm_phase(PG8_LAS unsigned char* lds, const Sched& S, const Epi& E) {
    int tid_ = threadIdx.x; asm volatile("" : "+v"(tid_));
    const int tid = tid_, wid = __builtin_amdgcn_readfirstlane(tid >> 6), lane = tid & 63, wr = wid >> 2, wc = wid & 3, fr = lane & 15, fq = lane >> 4;
    constexpr int K = KP; int nt;
    unsigned voffA[2], voffB[2];
#pragma unroll
    for (int i = 0; i < 2; ++i) { int R, C; stage_rc(tid * 16 + i * 8192, R, C); const int Rb = Epi::PERM ? ((R & ~31) + perm32(R & 31)) : R;
        voffA[i] = (unsigned)(R * K + C) * 2u; voffB[i] = (unsigned)(Rb * K + C) * 2u; }
    const size_t kstep = (size_t)(BK * 2);
    const size_t hstep = (size_t)HALF * K * 2;
    const size_t tstep = 2 * hstep;
    const unsigned ldsw = (unsigned)wid * 1024u;
    const int aoff = lds_byte(wr * 64 + fr, fq * 8), boff = lds_byte(wc * 32 + fr, fq * 8);
#define PG8_SA(b, h) (((b) * 2 + (h)) * HTB)
#define PG8_SB(b, h) ((4 + (b) * 2 + (h)) * HTB)
#define PG8_STAGE(bufoff, gbase, voff) do { _Pragma("unroll") for (int _i = 0; _i < 2; ++_i) \
        __builtin_amdgcn_global_load_lds((const unsigned*)((const char*)(gbase) + (voff)[_i]), (PG8_LAS unsigned*)(lds + (bufoff) + ldsw + _i * 8192), 16, 0, 0); } while (0)
#define PG8_LDA(dst, b, h) do { _Pragma("unroll") for (int m = 0; m < 4; ++m) _Pragma("unroll") for (int k = 0; k < 2; ++k) dst[m][k] = *(const PG8_LAS bf16x8*)(lds + PG8_SA(b, h) + aoff + m * 2048 + k * 1024); } while (0)
#define PG8_LDB(dst, b, h) do { _Pragma("unroll") for (int n = 0; n < 2; ++n) _Pragma("unroll") for (int k = 0; k < 2; ++k) dst[n][k] = *(const PG8_LAS bf16x8*)(lds + PG8_SB(b, h) + boff + n * 2048 + k * 1024); } while (0)
#define PG8_MMA(ai, bj, At, Bt) do { __builtin_amdgcn_s_setprio(1); _Pragma("unroll") for (int m = 0; m < 4; ++m) _Pragma("unroll") for (int n = 0; n < 2; ++n) _Pragma("unroll") for (int k = 0; k < 2; ++k) \
        acc[ai][bj][m][n] = __builtin_amdgcn_mfma_f32_16x16x32_bf16(Bt[n][k], At[m][k], acc[ai][bj][m][n], 0, 0, 0); __builtin_amdgcn_s_setprio(0); } while (0)
#define PG8_WAIT_V(n) asm volatile("s_waitcnt vmcnt(" #n ")" ::: "memory")
#define PG8_WAIT_L(n) asm volatile("s_waitcnt lgkmcnt(" #n ")" ::: "memory")
#define PG8_BAR __builtin_amdgcn_s_barrier()
#define PG8_SCHED __builtin_amdgcn_sched_barrier(0)
    Unit cur, nxt; int ui = 0;
    if (!S.next(0, cur)) return;
    f32x4 acc[2][2][4][2];
#pragma unroll
    for (int a = 0; a < 2; ++a)
#pragma unroll
        for (int b = 0; b < 2; ++b)
#pragma unroll
            for (int m = 0; m < 4; ++m)
#pragma unroll
                for (int n = 0; n < 2; ++n) acc[a][b][m][n] = (f32x4){0.f, 0.f, 0.f, 0.f};
    bf16x8 At[4][2], B0[2][2], B1[2][2];
    const char* cA = cur.A; const char* cB = cur.B; nt = cur.nt;
    S.a_ready(cur);
    if constexpr (SP2) {
        PG8_STAGE(PG8_SB(0, 0), cB, voffB); PG8_STAGE(PG8_SB(0, 1), cB + hstep, voffB); PG8_STAGE(PG8_SA(0, 0), cA, voffA); PG8_STAGE(PG8_SA(0, 1), cA + hstep, voffA);
        if (wr == 1) PG8_BAR;
        PG8_WAIT_V(2); PG8_BAR;
        PG8_STAGE(PG8_SB(1, 0), cB + kstep, voffB); PG8_STAGE(PG8_SA(1, 0), cA + kstep, voffA); PG8_STAGE(PG8_SB(1, 1), cB + hstep + kstep, voffB);
        PG8_WAIT_V(6); PG8_BAR;
    } else {
        PG8_STAGE(PG8_SB(0, 0), cB, voffB); PG8_STAGE(PG8_SA(0, 0), cA, voffA); PG8_STAGE(PG8_SB(0, 1), cB + hstep, voffB); PG8_STAGE(PG8_SA(0, 1), cA + hstep, voffA);
        if (wr == 1) PG8_BAR;
        PG8_WAIT_V(4); PG8_BAR;
        PG8_STAGE(PG8_SB(1, 0), cB + kstep, voffB); PG8_STAGE(PG8_SA(1, 0), cA + kstep, voffA); PG8_STAGE(PG8_SB(1, 1), cB + hstep + kstep, voffB);
        PG8_WAIT_V(6); PG8_BAR;
    }
    for (;;) {
        const bool has_next = S.next(ui + 1, nxt);
        const char* nA = has_next ? nxt.A : cA; const char* nB = has_next ? nxt.B : cB;
        for (int t = 0; t < nt; t += 2) {
            const bool last = (t == nt - 2);
            const char* a1 = cA + (size_t)(t + 1) * kstep;
            const char* a2 = last ? nA : cA + (size_t)(t + 2) * kstep; const char* b2 = last ? nB : cB + (size_t)(t + 2) * kstep;
            const char* a3 = a2 + kstep; const char* b3 = b2 + kstep;
            if (last && has_next) S.a_ready(nxt);
            if constexpr (SP2) {
            PG8_LDB(B0, 0, 0); PG8_LDB(B1, 0, 1); PG8_SCHED; PG8_LDA(At, 0, 0); PG8_STAGE(PG8_SA(1, 1), a1 + hstep, voffA);
            PG8_WAIT_V(8); PG8_WAIT_L(0); PG8_BAR; PG8_MMA(0, 0, At, B0); PG8_MMA(0, 1, At, B1); PG8_BAR; PG8_SCHED;
            PG8_LDA(At, 0, 1); PG8_STAGE(PG8_SB(0, 0), b2, voffB); PG8_STAGE(PG8_SB(0, 1), b2 + hstep, voffB); PG8_STAGE(PG8_SA(0, 0), a2, voffA);
            PG8_WAIT_V(8); PG8_WAIT_L(0); PG8_BAR; PG8_MMA(1, 0, At, B0); PG8_MMA(1, 1, At, B1); PG8_BAR; PG8_SCHED;
            PG8_LDB(B0, 1, 0); PG8_LDB(B1, 1, 1); PG8_SCHED; PG8_LDA(At, 1, 0); PG8_STAGE(PG8_SA(0, 1), a2 + hstep, voffA);
            PG8_WAIT_V(8); PG8_WAIT_L(0); PG8_BAR; PG8_MMA(0, 0, At, B0); PG8_MMA(0, 1, At, B1); PG8_BAR; PG8_SCHED;
            PG8_LDA(At, 1, 1); PG8_STAGE(PG8_SB(1, 0), b3, voffB); PG8_STAGE(PG8_SB(1, 1), b3 + hstep, voffB); PG8_STAGE(PG8_SA(1, 0), a3, voffA);
            PG8_WAIT_V(8); PG8_WAIT_L(0); PG8_BAR; PG8_MMA(1, 0, At, B0); PG8_MMA(1, 1, At, B1); PG8_BAR; PG8_SCHED;
            } else {
            PG8_LDB(B0, 0, 0); PG8_SCHED; PG8_LDA(At, 0, 0); PG8_STAGE(PG8_SA(1, 1), a1 + hstep, voffA);
            PG8_WAIT_L(8); PG8_BAR; PG8_WAIT_L(0); PG8_MMA(0, 0, At, B0); PG8_BAR; PG8_SCHED;
            PG8_LDB(B1, 0, 1); PG8_STAGE(PG8_SB(0, 0), b2, voffB);
            PG8_BAR; PG8_WAIT_L(0); PG8_MMA(0, 1, At, B1); PG8_BAR;
            PG8_LDA(At, 0, 1); PG8_STAGE(PG8_SA(0, 0), a2, voffA);
            PG8_BAR; PG8_WAIT_L(0); PG8_MMA(1, 0, At, B0); PG8_BAR; PG8_SCHED;
            PG8_STAGE(PG8_SB(0, 1), b2 + hstep, voffB);
            PG8_WAIT_V(6); PG8_BAR; PG8_MMA(1, 1, At, B1); PG8_BAR;
            PG8_LDB(B0, 1, 0); PG8_SCHED; PG8_LDA(At, 1, 0); PG8_STAGE(PG8_SA(0, 1), a2 + hstep, voffA);
            PG8_WAIT_L(8); PG8_BAR; PG8_WAIT_L(0); PG8_MMA(0, 0, At, B0); PG8_BAR; PG8_SCHED;
            PG8_LDB(B1, 1, 1); PG8_STAGE(PG8_SB(1, 0), b3, voffB);
            PG8_BAR; PG8_WAIT_L(0); PG8_MMA(0, 1, At, B1); PG8_BAR;
            PG8_LDA(At, 1, 1); PG8_STAGE(PG8_SA(1, 0), a3, voffA);
            PG8_BAR; PG8_WAIT_L(0); PG8_MMA(1, 0, At, B0); PG8_BAR; PG8_SCHED;
            PG8_STAGE(PG8_SB(1, 1), b3 + hstep, voffB);
            PG8_WAIT_V(6); PG8_BAR; PG8_MMA(1, 1, At, B1); PG8_BAR;
            }
        }
        if constexpr (ALIGN_EPI) { if (wr == 0) PG8_BAR; }
        if constexpr (!Epi::AFTER_DRAIN) { E(acc, cur, wr, wc, fr, fq); S.done(cur); }
        if (!has_next) break;
        if (!cur.keep) {
#pragma unroll
        for (int a = 0; a < 2; ++a)
#pragma unroll
            for (int b = 0; b < 2; ++b)
#pragma unroll
                for (int m = 0; m < 4; ++m)
#pragma unroll
                    for (int n = 0; n < 2; ++n) acc[a][b][m][n] = (f32x4){0.f, 0.f, 0.f, 0.f};
        }
        cur = nxt; cA = nA; cB = nB; nt = cur.nt; ++ui;
        if constexpr (ALIGN_EPI) { if (wr == 1) PG8_BAR; }
    }
    PG8_WAIT_V(0);
    if constexpr (!ALIGN_EPI) { if (wr == 0) PG8_BAR; }
    PG8_BAR;
    if constexpr (Epi::AFTER_DRAIN) { E.fused(acc, cur, wr, wc, fr, fq, lds, wid, lane); S.done(cur); }
#undef PG8_SA
#undef PG8_SB
#undef PG8_STAGE
#undef PG8_LDA
#undef PG8_LDB
#undef PG8_MMA
#undef PG8_WAIT_V
#undef PG8_WAIT_L
#undef PG8_BAR
#undef PG8_SCHED
}
}

#define GAS __attribute__((address_space(1)))
#define LAS __attribute__((address_space(3)))
typedef GAS unsigned gu32;
#define RLX_AGENT __ATOMIC_RELAXED, __HIP_MEMORY_SCOPE_AGENT
#define LDS_WAIT() asm volatile("s_waitcnt lgkmcnt(0)" ::: "memory")
#define VM_WAIT() asm volatile("s_waitcnt vmcnt(0)" ::: "memory")
#define XB_TMO      128
#define XB_XCNT(j)  (256  + 64 * (j))
#define XB_XSUB(j)  (1280 + 64 * (j))
#define XB_XGEN(j)  (2304 + 64 * (j))
#define XB_TOP      3328
#define XB_TOPGEN   3392
#define XCD_BAR_WORDS 3456
#define XB_SPIN_CAP (1u << 20)
__device__ __forceinline__ unsigned xb_ld(unsigned* p)              { return __hip_atomic_load(p, __ATOMIC_RELAXED, __HIP_MEMORY_SCOPE_AGENT); }
__device__ __forceinline__ unsigned xb_add(unsigned* p, unsigned v) { return __hip_atomic_fetch_add(p, v, __ATOMIC_RELAXED, __HIP_MEMORY_SCOPE_AGENT); }
__device__ __forceinline__ unsigned xb_xcc_id() { return (unsigned)__builtin_amdgcn_s_getreg((3 << 11) | 20) & 0xFu; }
#define XB_SPIN(cond, bar) do { unsigned _sp = 0; while (cond) { __builtin_amdgcn_s_sleep(1); \
    if ((++_sp & 255u) == 0u) { if (xb_ld(&(bar)[XB_TMO])) break; if (_sp > XB_SPIN_CAP) { atomicAdd(&(bar)[XB_TMO], 1u); break; } } } } while (0)
struct XcdBarrier { unsigned* bar; unsigned x; volatile LAS unsigned* st; };
__device__ __forceinline__ XcdBarrier xcd_barrier_post(unsigned* bar, volatile LAS unsigned* st) {
    XcdBarrier b; b.bar = bar; b.x = xb_xcc_id(); b.st = st;
    if (threadIdx.x == 0) (void)xb_add(&bar[XB_XCNT(b.x)], 1u);
    return b;
}
__device__ __forceinline__ void xcd_barrier_complete(unsigned* bar, unsigned x, unsigned& nloc, unsigned& nx) {
    const unsigned G = gridDim.x * gridDim.y * gridDim.z;
    unsigned sum, cnt, mine, sp = 0u;
    for (;;) {
        sum = 0u; cnt = 0u; mine = 0u;
#pragma unroll
        for (unsigned j = 0; j < 16; ++j) { const unsigned c = xb_ld(&bar[XB_XCNT(j)]); sum += c; cnt += (c > 0u) ? 1u : 0u; mine = (j == x) ? c : mine; }
        if (sum == G) break;
        __builtin_amdgcn_s_sleep(1);
        if ((++sp & 255u) == 0u) { if (xb_ld(&bar[XB_TMO])) break; if (sp > XB_SPIN_CAP) { atomicAdd(&bar[XB_TMO], 1u); break; } }
    }
    nloc = mine > 0u ? mine : 1u; nx = cnt > 0u ? cnt : 1u;
}
__device__ __forceinline__ void xcd_barrier(const XcdBarrier& b) {
    asm volatile("s_waitcnt vmcnt(0)" ::: "memory");
    __syncthreads();
    if (threadIdx.x == 0) {
        unsigned* bar = b.bar;
        __builtin_amdgcn_s_waitcnt(0);
        unsigned nloc = b.st[0], nx = b.st[1];
        if (nloc == 0u) { xcd_barrier_complete(bar, b.x, nloc, nx); b.st[0] = nloc; b.st[1] = nx; }
        const unsigned old = xb_add(&bar[XB_XSUB(b.x)], 1u);
        const unsigned gen = old / nloc;
        if (old + 1u == (gen + 1u) * nloc) {
            __builtin_amdgcn_fence(__ATOMIC_RELEASE, "agent");
            asm volatile("s_waitcnt vmcnt(0)" ::: "memory");
            const unsigned og = xb_add(&bar[XB_TOP], 1u);
            const unsigned tg = og / nx;
            if (og + 1u == (tg + 1u) * nx) xb_add(&bar[XB_TOPGEN], 1u);
            else XB_SPIN(xb_ld(&bar[XB_TOPGEN]) == tg, bar);
            __builtin_amdgcn_fence(__ATOMIC_ACQUIRE, "agent");
            xb_add(&bar[XB_XGEN(b.x)], 1u);
            asm volatile("s_waitcnt vmcnt(0)" ::: "memory");
        } else {
            XB_SPIN(xb_ld(&bar[XB_XGEN(b.x)]) == gen, bar);
            __builtin_amdgcn_fence(__ATOMIC_ACQUIRE, "agent");
            asm volatile("s_waitcnt vmcnt(0)" ::: "memory");
        }
    }
    __syncthreads();
}

constexpr int NWAVES = 8;
constexpr int RING_OFF = 0, RING_BYTES = 131072;
constexpr int LDSCTL_OFF = RING_BYTES, MISC_OFF = LDSCTL_OFF + 320;
constexpr int LDS_BYTES = 147456;
constexpr int CW_TMO = 0, CW_CODE = 1, CW_BAR = 4096, CW_QUEUE = 8192, CW_MKV = 10240, CW_TIME = 12288, CW_SEAM = 16384;
constexpr size_t CTL_ZERO_BYTES = 1 * MiB;

struct Frame {
    LAS unsigned char* lds; volatile LAS unsigned* MISC; unsigned* ctl;
    int tid, lane, wave, vcu, G;
    unsigned long long tprev;
    Bufs B;
};

__device__ __forceinline__ void p0_transpose_item(const Bufs& B, int kind, int N, size_t dst_off, LAS float* scr, int item, int lane) {
    const int nblk = N / 32, kb = item / nblk, nb = item % nblk, k0 = 64 * kb, n0 = 32 * nb;
#pragma unroll
    for (int h = 0; h < 2; ++h) { float tv[16];
#pragma unroll
        for (int i = 0; i < 16; ++i) tv[i] = wsrc(B, kind, k0 + 2 * (16 * h + i) + (lane >> 5), n0 + (lane & 31));
#pragma unroll
        for (int i = 0; i < 16; ++i) scr[(2 * (16 * h + i) + (lane >> 5)) * 33 + (lane & 31)] = tv[i]; }
    LDS_WAIT(); asm volatile("" ::: "memory");
    const int c = lane & 7; bf16* WT = WSP(bf16, dst_off);
#pragma unroll
    for (int j = 0; j < 4; ++j) { const int n = (lane >> 3) + 8 * j; const LAS float* s = scr + (8 * c) * 33 + n;
        v4u o; o.x = pk2(s[0 * 33], s[1 * 33]); o.y = pk2(s[2 * 33], s[3 * 33]); o.z = pk2(s[4 * 33], s[5 * 33]); o.w = pk2(s[6 * 33], s[7 * 33]);
        *(v4u*)(WT + (size_t)(n0 + n) * 1024 + k0 + 8 * c) = o; }
    LDS_WAIT(); asm volatile("" ::: "memory");
}
__device__ __forceinline__ float wave_sum(float v) {
#pragma unroll
    for (int o = 1; o < 64; o <<= 1) v += __shfl_xor(v, o);
    return v;
}
__device__ __forceinline__ void ln_in_rows(const Bufs& B, int gw, int NGW, int lane) {
    f32x4 v[4], nx[4];
    if (gw < M) { const f32x4* xr = (const f32x4*)(B.x + (size_t)gw * D) + lane;
#pragma unroll
        for (int j = 0; j < 4; ++j) v[j] = __builtin_nontemporal_load(xr + 64 * j); }
    f32x4 g[4], b[4];
#pragma unroll
    for (int j = 0; j < 4; ++j) { g[j] = *((const f32x4*)B.ln_in_g + lane + 64 * j); b[j] = *((const f32x4*)B.ln_in_b + lane + 64 * j); }
    for (int row = gw; row < M; row += NGW) {
        const int nr = row + NGW;
        if (nr < M) { const f32x4* xr = (const f32x4*)(B.x + (size_t)nr * D) + lane;
#pragma unroll
            for (int j = 0; j < 4; ++j) nx[j] = __builtin_nontemporal_load(xr + 64 * j); }
        float s = 0.f;
#pragma unroll
        for (int j = 0; j < 4; ++j) s += (v[j].x + v[j].y) + (v[j].z + v[j].w);
        const float mean = wave_sum(s) * (1.f / D); float s2 = 0.f;
#pragma unroll
        for (int j = 0; j < 4; ++j) { v[j] = v[j] - mean; s2 += (v[j].x * v[j].x + v[j].y * v[j].y) + (v[j].z * v[j].z + v[j].w * v[j].w); }
        const float rstd = rsqrtf(wave_sum(s2) * (1.f / D) + LN_EPS);
        if (lane == 0) { float* st = WSP(float, WS_STATS) + (size_t)row * 2; st[0] = mean; st[1] = rstd; }
        unsigned long long* o8 = (unsigned long long*)(WSP(bf16, WS_XN) + (size_t)row * D) + lane;
#pragma unroll
        for (int j = 0; j < 4; ++j) { const f32x4 y = v[j] * rstd * g[j] + b[j];
            o8[64 * j] = (unsigned long long)pk2(y.x, y.y) | ((unsigned long long)pk2(y.z, y.w) << 32); }
#pragma unroll
        for (int j = 0; j < 4; ++j) v[j] = nx[j];
    }
}
__device__ __forceinline__ void p0_prologue(Frame& F) {
    const Bufs& B = F.B;
    LAS float* scr = (LAS float*)(F.lds + RING_OFF + F.wave * 16384);
    const int gw = F.vcu * NWAVES + F.wave, NGW = F.G * NWAVES;
    constexpr int I0 = 16 * (NPOS / 32), I2 = 16 * 32;
    constexpr int NITEMS = I0 + 4 * I2;
    for (int it = gw; it < NITEMS; it += NGW) {
        int r = it;
        if (r < I0) { p0_transpose_item(B, 0, NPOS, WS_WIN, scr, r, (int)(threadIdx.x & 63u)); continue; } r -= I0;
        if (r < I2) { p0_transpose_item(B, 2, 1024, WS_WMEM, scr, r, (int)(threadIdx.x & 63u)); continue; } r -= I2;
        if (r < I2) { p0_transpose_item(B, 3, 1024, WS_WAB, scr, r, (int)(threadIdx.x & 63u)); continue; } r -= I2;
        if (r < I2) { p0_transpose_item(B, 4, 1024, WS_WC, scr, r, (int)(threadIdx.x & 63u)); continue; } r -= I2;
        p0_transpose_item(B, 5, 1024, WS_WOUT, scr, r, (int)(threadIdx.x & 63u));
    }
    ln_in_rows(B, gw, NGW, (int)(threadIdx.x & 63u));
    const int gid = gw * 64 + (int)(threadIdx.x & 63u), nth = NGW * 64;
    for (int i = gid; i < MM * D / 4; i += nth) { const f32x4 v = __builtin_nontemporal_load((const f32x4*)B.mem + i); ((unsigned long long*)WSP(bf16, WS_MEMB))[i] = (unsigned long long)pk2(v.x, v.y) | ((unsigned long long)pk2(v.z, v.w) << 32); }
    for (int i = gid; i < SEQ * 8; i += nth) { const int pos = i >> 3, f = i & 7;
        const float inv = powf(500000.0f, -(float)f * 0.125f); const float ang = (float)pos * inv;
        float* t64 = WSP(float, WS_TAB) + pos * 16; t64[f] = cosf(ang); t64[8 + f] = sinf(ang);
        if ((f & 1) == 0) { float* t32 = WSP(float, WS_TAB32) + pos * 8; t32[f >> 1] = cosf(ang); t32[4 + (f >> 1)] = sinf(ang); } }
    if (gid == 0) { float a = 0.f, b = 0.f; for (int i = 0; i < 64; ++i) { a += B.diff_lambda[i] * B.diff_lambda[64 + i]; b += B.diff_lambda[128 + i] * B.diff_lambda[192 + i]; }
        *WSP(float, WS_LAM) = expf(a) - expf(b) + LAM_INIT; }
}

struct SchedOne {
    int pm, pn; const char* MEMB; const char* WMEM;
    __device__ __forceinline__ bool next(int i, pg8::Unit& u) const {
        if (i > 0) return false;
        u.pm = pm; u.pn = pn; u.A = MEMB + (size_t)pm * pg8::TSTEP; u.B = WMEM + (size_t)pn * pg8::TSTEP; u.nt = 16; u.kind = 1; u.keep = 0; return true;
    }
    __device__ __forceinline__ void a_ready(const pg8::Unit&) const {}
    __device__ __forceinline__ void done(const pg8::Unit&) const {}
};
struct SchedIn {
    pg8::TileOrder T; int G, c; const char* XN; const char* WIN; const char* MEMB; const char* WMEM;
    __device__ __forceinline__ bool next(int i, pg8::Unit& u) const {
        const int L = i * G + c;
        if (L < T.nwg) { T.tile(L, u.pm, u.pn); u.A = XN + (size_t)u.pm * pg8::TSTEP; u.B = WIN + (size_t)u.pn * pg8::TSTEP; u.nt = 16; u.kind = 0; u.keep = 0; return true; }
        return false;
    }
    __device__ __forceinline__ void a_ready(const pg8::Unit&) const {}
    __device__ __forceinline__ void done(const pg8::Unit&) const {}
};
template <int KIND> __device__ __forceinline__ void epi_in_loops(const Bufs& B, const pg8::f32x4 (&acc)[2][2][4][2], int row0, int c0) {
#pragma unroll
    for (int ai = 0; ai < 2; ++ai)
#pragma unroll
        for (int m = 0; m < 4; ++m)
#pragma unroll
            for (int bj = 0; bj < 2; ++bj) {
                float v[8] = {acc[ai][bj][m][0][0], acc[ai][bj][m][0][1], acc[ai][bj][m][0][2], acc[ai][bj][m][0][3], acc[ai][bj][m][1][0], acc[ai][bj][m][1][1], acc[ai][bj][m][1][2], acc[ai][bj][m][1][3]};
                const int row = row0 + ai * 128 + m * 16, c = c0 + bj * 128;
                if constexpr (KIND == 100) store8(WSP(bf16, WS_MKV) + (size_t)row * 1024 + c, v);
                else emit8k<KIND>(B, row, c, v);
            }
}
struct EpiIn {
    static constexpr bool PERM = true, AFTER_DRAIN = false; Bufs B;
    __device__ __forceinline__ void operator()(const pg8::f32x4 (&acc)[2][2][4][2], const pg8::Unit& u, int wr, int wc, int fr, int fq) const {
        const int row0 = u.pm * 256 + wr * 64 + fr, cw = wc * 32 + 8 * fq;
        if (u.kind == 1) { epi_in_loops<100>(B, acc, row0, u.pn * 256 + cw); return; }
        const int c0 = (u.pn < 16 ? (u.pn & 1) * 256 : (u.pn < 18 ? 0 : (u.pn - 18) * 256)) + cw;
        switch (kind_of_tile(u.pn)) {
        case K_AQ: epi_in_loops<K_AQ>(B, acc, row0, c0); break;  case K_AG: epi_in_loops<K_AG>(B, acc, row0, c0); break;
        case K_BQ: epi_in_loops<K_BQ>(B, acc, row0, c0); break;  case K_BK: epi_in_loops<K_BK>(B, acc, row0, c0); break;
        case K_BV: epi_in_loops<K_BV>(B, acc, row0, c0); break;  case K_BG: epi_in_loops<K_BG>(B, acc, row0, c0); break;
        case K_CQ: epi_in_loops<K_CQ>(B, acc, row0, c0); break;  case K_CG: epi_in_loops<K_CG>(B, acc, row0, c0); break;
        case K_IQ: epi_in_loops<K_IQ>(B, acc, row0, c0); break;  case K_MG: epi_in_loops<K_MG>(B, acc, row0, c0); break;  default:   epi_in_loops<K_MISC>(B, acc, row0, c0); break;
        }
    }
};

#ifndef PROBE_DRY
#define PROBE_DRY 0
#endif
#ifndef PROBE_DMODE
#define PROBE_DMODE 1
#endif
#ifndef FAST_A
#define FAST_A 1
#endif
#ifndef FAST_B
#define FAST_B 1
#endif
#ifndef FAST_C
#define FAST_C 1
#endif
#ifndef TIMING_SEL
#define TIMING_SEL -1
#endif
#define TIMING (TIMING_SEL >= 0)
#define TST(k) do { if (TIMING && threadIdx.x == 0) { const unsigned now_ = (unsigned)__builtin_amdgcn_s_memrealtime(); F.MISC[16 + (k)] += now_ - F.MISC[14]; F.MISC[14] = now_; } } while (0)
namespace att {
typedef short bf16x8 __attribute__((ext_vector_type(8)));
typedef short v4i16_t __attribute__((ext_vector_type(4)));
typedef float f32x16 __attribute__((ext_vector_type(16)));
constexpr int L_K = 0, L_V = 32768, L_MASK = 131072 + 1024, L_X = 65536, L_NG = 141312;
constexpr float NEG_BIG = -1.0e30f;

__device__ __forceinline__ float hswap_max(float v) { auto rr = __builtin_amdgcn_permlane32_swap(__float_as_uint(v), __float_as_uint(v), false, false); return fmaxf(__uint_as_float(rr[0]), __uint_as_float(rr[1])); }
__device__ __forceinline__ float hswap_sum(float v) { auto rr = __builtin_amdgcn_permlane32_swap(__float_as_uint(v), __float_as_uint(v), false, false); return __uint_as_float(rr[0]) + __uint_as_float(rr[1]); }
__device__ __forceinline__ unsigned cvtpk(float lo, float hi) { typedef float f2 __attribute__((ext_vector_type(2))); typedef __bf16 b2 __attribute__((ext_vector_type(2))); f2 v = {lo, hi}; b2 b = __builtin_convertvector(v, b2); return __builtin_bit_cast(unsigned, b); }

template <int DQK, int DV> struct WState { bf16x8 qf[DQK / 16]; f32x16 o[DV / 32]; float m, l; };

template <int KPB> __device__ __forceinline__ int ksw(int row) { return KPB == 128 ? ((row >> 1) & 7) : (row & 15); }
template <int KPB, int DV> struct Stage {
    static constexpr int NK = KPB / 128, NV = DV / 64;
    v4u kr[NK], vr[NV];
    __device__ __forceinline__ void load(const char* kg, size_t kpitch, const char* vg, size_t vpitch, int key0, int tid) {
#pragma unroll
        for (int i = 0; i < NK; ++i) { const int idx = tid + 512 * i, key = idx / (KPB / 16), ch = idx % (KPB / 16); kr[i] = *(const v4u*)(kg + (size_t)(key0 + key) * kpitch + ch * 16); }
#pragma unroll
        for (int i = 0; i < NV; ++i) { const int idx = tid + 512 * i, key = idx / (DV / 8), ch = idx % (DV / 8); vr[i] = *(const v4u*)(vg + (size_t)(key0 + key) * vpitch + ch * 16); }
    }
    __device__ __forceinline__ void store(LAS unsigned char* lds, int buf, int tid) const {
#pragma unroll
        for (int i = 0; i < NK; ++i) { const int idx = tid + 512 * i, key = idx / (KPB / 16), ch = idx % (KPB / 16); *(LAS v4u*)(lds + L_K + buf * 16384 + key * KPB + ((ch ^ ksw<KPB>(key)) << 4)) = kr[i]; }
#pragma unroll
        for (int i = 0; i < NV; ++i) { const int idx = tid + 512 * i, key = idx / (DV / 8), ch = idx % (DV / 8); *(LAS v4u*)(lds + L_V + buf * 16384 + (ch >> 2) * 4096 + key * 64 + (ch & 3) * 16) = vr[i]; }
    }
};

template <int DQK, int DV, int KPB, bool MASKED>
__device__ __forceinline__ void tile_compute(WState<DQK, DV>& W, LAS unsigned char* lds, int buf, int kc0, int lane, const LAS unsigned* mrow  , int koff = -1, int voff = -1) {
    const int r32 = lane & 31, hi = lane >> 5;
    const LAS unsigned char* kb = lds + (koff >= 0 ? koff : L_K + buf * 16384);
    const LAS unsigned char* vb = lds + (voff >= 0 ? voff : L_V + buf * 16384) + ((lane >> 4) & 1) * 32 + (lane & 3) * 8 + (4 * hi + ((lane & 15) >> 2)) * 64;
#pragma unroll
    for (int kh = 0; kh < 2; ++kh) {
        const int row = 32 * kh + r32;
        f32x16 s = {};
#pragma unroll
        for (int ks = 0; ks < DQK / 16; ++ks) {
            const bf16x8 kf = *(const LAS bf16x8*)(kb + row * KPB + (((kc0 + 2 * ks + hi) ^ ksw<KPB>(row)) << 4));
            s = __builtin_amdgcn_mfma_f32_32x32x16_bf16(kf, W.qf[ks], s, 0, 0, 0);
        }
        if constexpr (MASKED) {
            const unsigned wsh = mrow[kh] >> (4 * hi);
#pragma unroll
            for (int r = 0; r < 16; ++r) { const unsigned mm = (unsigned)__builtin_amdgcn_sbfe((int)wsh, (r & 3) + 8 * (r >> 2), 1); s[r] = __uint_as_float((__float_as_uint(s[r]) & mm) | (0xFF800000u & ~mm)); }
        }
        float mx = s[0];
#pragma unroll
        for (int r = 1; r < 16; ++r) mx = fmaxf(mx, s[r]);
        mx = hswap_max(mx);
        const float mn = fmaxf(W.m, mx), alpha = __builtin_amdgcn_exp2f(W.m - mn);
        W.m = mn;
        float ps = 0.f;
#pragma unroll
        for (int r = 0; r < 16; ++r) { s[r] = __builtin_amdgcn_exp2f(s[r] - mn); ps += s[r]; }
        W.l = W.l * alpha + ps;
        if (__any(alpha != 1.0f)) {
#pragma unroll
            for (int dt = 0; dt < DV / 32; ++dt)
#pragma unroll
                for (int r = 0; r < 16; ++r) W.o[dt][r] *= alpha;
        }
        v4u pw0, pw1;
        pw0.x = cvtpk(s[0], s[1]); pw0.y = cvtpk(s[2], s[3]); pw0.z = cvtpk(s[4], s[5]); pw0.w = cvtpk(s[6], s[7]);
        pw1.x = cvtpk(s[8], s[9]); pw1.y = cvtpk(s[10], s[11]); pw1.z = cvtpk(s[12], s[13]); pw1.w = cvtpk(s[14], s[15]);
        const bf16x8 pf0 = __builtin_bit_cast(bf16x8, pw0), pf1 = __builtin_bit_cast(bf16x8, pw1);
#pragma unroll
        for (int dt = 0; dt < DV / 32; ++dt) {
#pragma unroll
            for (int sidx = 0; sidx < 2; ++sidx) {
                const LAS unsigned char* p = vb + dt * 4096 + (32 * kh + 16 * sidx) * 64;
                const v4i16_t lo = __builtin_amdgcn_ds_read_tr16_b64_v4i16((LAS v4i16_t*)p);
                const v4i16_t hh = __builtin_amdgcn_ds_read_tr16_b64_v4i16((LAS v4i16_t*)(p + 512));
                const bf16x8 vf = (bf16x8){lo[0], lo[1], lo[2], lo[3], hh[0], hh[1], hh[2], hh[3]};
                W.o[dt] = __builtin_amdgcn_mfma_f32_32x32x16_bf16(vf, sidx == 0 ? pf0 : pf1, W.o[dt], 0, 0, 0);
            }
        }
    }
}

template <int DQK, int DV, int KPB, bool MASKED>
__device__ __forceinline__ void tile_loop_simple(WState<DQK, DV>& W, LAS unsigned char* lds, const char* kg, size_t kpitch, const char* vg, size_t vpitch, int nT, int my_nt, int kc0, int tid, int lane, const LAS unsigned* mq) {
    Stage<KPB, DV> st;
    st.load(kg, kpitch, vg, vpitch, 0, tid); st.store(lds, 0, tid);
    __syncthreads();
    for (int t = 0; t < nT; ++t) {
        if (t + 1 < nT) st.load(kg, kpitch, vg, vpitch, 64 * (t + 1), tid);
        if (t < my_nt) tile_compute<DQK, DV, KPB, MASKED>(W, lds, t & 1, kc0, lane, MASKED ? mq + 2 * t : mq);
        if (t + 1 < nT) st.store(lds, (t + 1) & 1, tid);
        __syncthreads();
    }
}
template <int KPB> struct StageK {
    static constexpr int NK = KPB / 128; v4u kr[NK];
    __device__ __forceinline__ void load(const char* kg, size_t kpitch, int key0, int tid) {
#pragma unroll
        for (int i = 0; i < NK; ++i) { const int idx = tid + 512 * i, key = idx / (KPB / 16), ch = idx % (KPB / 16); kr[i] = *(const v4u*)(kg + (size_t)(key0 + key) * kpitch + ch * 16); }
    }
    __device__ __forceinline__ void store(LAS unsigned char* lds, int slot, int tid) const {
#pragma unroll
        for (int i = 0; i < NK; ++i) { const int idx = tid + 512 * i, key = idx / (KPB / 16), ch = idx % (KPB / 16); *(LAS v4u*)(lds + L_K + slot * 16384 + key * KPB + ((ch ^ ksw<KPB>(key)) << 4)) = kr[i]; }
    }
};
template <int DV> struct StageV {
    static constexpr int NV = DV / 64; v4u vr[NV];
    __device__ __forceinline__ void load(const char* vg, size_t vpitch, int key0, int tid) {
#pragma unroll
        for (int i = 0; i < NV; ++i) { const int idx = tid + 512 * i, key = idx / (DV / 8), ch = idx % (DV / 8); vr[i] = *(const v4u*)(vg + (size_t)(key0 + key) * vpitch + ch * 16); }
    }
    __device__ __forceinline__ void store(LAS unsigned char* lds, int slot, int tid) const { store_off(lds, slot * 16384, tid); }
    __device__ __forceinline__ void store_off(LAS unsigned char* lds, int off, int tid) const {
#pragma unroll
        for (int i = 0; i < NV; ++i) { const int idx = tid + 512 * i, key = idx / (DV / 8), ch = idx % (DV / 8); *(LAS v4u*)(lds + L_V + off + (ch >> 2) * 4096 + key * 64 + (ch & 3) * 16) = vr[i]; }
    }
};
#define SBAR() __builtin_amdgcn_sched_barrier(0)
template <int DQK, int KPB> __device__ __forceinline__ void k_frags(bf16x8 (&kf)[DQK / 16], const LAS unsigned char* kb, int kc0, int r32, int hi, int kh) {
    const int row = 32 * kh + r32;
#pragma unroll
    for (int ks = 0; ks < DQK / 16; ++ks) kf[ks] = *(const LAS bf16x8*)(kb + row * KPB + (((kc0 + 2 * ks + hi) ^ ksw<KPB>(row)) << 4));
}
template <int DQK, int KPB> __device__ __forceinline__ void qk_tile(f32x16 (&s)[2], const bf16x8* qf, const LAS unsigned char* kb, int kc0, int r32, int hi) {
    bf16x8 kf0[DQK / 16], kf1[DQK / 16]; k_frags<DQK, KPB>(kf0, kb, kc0, r32, hi, 0); k_frags<DQK, KPB>(kf1, kb, kc0, r32, hi, 1);
    f32x16 a = {}, b = {};
#pragma unroll
    for (int ks = 0; ks < DQK / 16; ++ks) a = __builtin_amdgcn_mfma_f32_32x32x16_bf16(kf0[ks], qf[ks], a, 0, 0, 0);
#pragma unroll
    for (int ks = 0; ks < DQK / 16; ++ks) b = __builtin_amdgcn_mfma_f32_32x32x16_bf16(kf1[ks], qf[ks], b, 0, 0, 0);
    s[0] = a; s[1] = b;
}
template <int DQK, int DV, int KPB, bool MASKED> __device__ __forceinline__ void step_sm(WState<DQK, DV>& W, f32x16 (&sc)[2], f32x16 (&sn)[2], bf16x8 (&pf)[4], const LAS unsigned char* kb_next, int kc0, int lane, const LAS unsigned* mrow) {
    const int r32 = lane & 31, hi = lane >> 5;
    bf16x8 kf0[DQK / 16]; k_frags<DQK, KPB>(kf0, kb_next, kc0, r32, hi, 0);
    if constexpr (MASKED) {
#pragma unroll
        for (int kh = 0; kh < 2; ++kh) { const unsigned wsh = mrow[kh] >> (4 * hi);
#pragma unroll
            for (int r = 0; r < 16; ++r) { const unsigned mm = (unsigned)__builtin_amdgcn_sbfe((int)wsh, (r & 3) + 8 * (r >> 2), 1); sc[kh][r] = __uint_as_float((__float_as_uint(sc[kh][r]) & mm) | (0xFF800000u & ~mm)); } }
    }
    float mx = fmaxf(sc[0][0], sc[1][0]);
#pragma unroll
    for (int r = 1; r < 16; ++r) mx = fmaxf(fmaxf(mx, sc[0][r]), sc[1][r]);
    mx = hswap_max(mx);
    const float mn = (mx > W.m + 8.0f) ? mx : W.m, alpha = __builtin_amdgcn_exp2f(W.m - mn);
    W.m = mn;
    if (__any(alpha != 1.0f)) {
#pragma unroll
        for (int dt = 0; dt < DV / 32; ++dt)
#pragma unroll
            for (int r = 0; r < 16; ++r) W.o[dt][r] *= alpha;
    }
    SBAR();
    float mn_ = mn; asm volatile("" : "+v"(kf0[0]), "+v"(mn_));
    float ps0 = 0.f, ps1 = 0.f;
    { f32x16 a = {}, b = {};
#pragma unroll
      for (int ks = 0; ks < DQK / 16; ++ks) a = __builtin_amdgcn_mfma_f32_32x32x16_bf16(kf0[ks], W.qf[ks], a, 0, 0, 0);
      k_frags<DQK, KPB>(kf0, kb_next, kc0, r32, hi, 1);
#pragma unroll
      for (int ks = 0; ks < DQK / 16; ++ks) b = __builtin_amdgcn_mfma_f32_32x32x16_bf16(kf0[ks], W.qf[ks], b, 0, 0, 0);
      sn[0] = a; sn[1] = b; }
#pragma unroll
    for (int r = 0; r < 16; ++r) { sc[0][r] = __builtin_amdgcn_exp2f(sc[0][r] - mn_); ps0 += sc[0][r]; sc[1][r] = __builtin_amdgcn_exp2f(sc[1][r] - mn_); ps1 += sc[1][r]; }
#pragma unroll
    for (int i = 0; i < 2 * (DQK / 16); ++i) { __builtin_amdgcn_sched_group_barrier(0x008, 1, 0); __builtin_amdgcn_sched_group_barrier(0x002, (96 + 2 * (DQK / 16) - 1) / (2 * (DQK / 16)), 0); }
    SBAR();
    W.l = W.l * alpha + (ps0 + ps1);
#pragma unroll
    for (int kh = 0; kh < 2; ++kh) { v4u a, b;
        a.x = cvtpk(sc[kh][0], sc[kh][1]); a.y = cvtpk(sc[kh][2], sc[kh][3]); a.z = cvtpk(sc[kh][4], sc[kh][5]); a.w = cvtpk(sc[kh][6], sc[kh][7]);
        b.x = cvtpk(sc[kh][8], sc[kh][9]); b.y = cvtpk(sc[kh][10], sc[kh][11]); b.z = cvtpk(sc[kh][12], sc[kh][13]); b.w = cvtpk(sc[kh][14], sc[kh][15]);
        pf[2 * kh] = __builtin_bit_cast(bf16x8, a); pf[2 * kh + 1] = __builtin_bit_cast(bf16x8, b); }
}
template <int DQK, int DV> __device__ __forceinline__ void step_pv(WState<DQK, DV>& W, const bf16x8 (&pf)[4], const LAS unsigned char* vbase, int lane) {
    const int hi = lane >> 5;
    const LAS unsigned char* vb = vbase + ((lane >> 4) & 1) * 32 + (lane & 3) * 8 + (4 * hi + ((lane & 15) >> 2)) * 64;
    if constexpr (DV <= 64) {
        v4i16_t vl[2][4], vh[2][4];
#pragma unroll
        for (int k4 = 0; k4 < 4; ++k4) { vl[0][k4] = __builtin_amdgcn_ds_read_tr16_b64_v4i16((LAS v4i16_t*)(vb + (16 * k4) * 64)); vh[0][k4] = __builtin_amdgcn_ds_read_tr16_b64_v4i16((LAS v4i16_t*)(vb + (16 * k4) * 64 + 512)); }
#pragma unroll
        for (int dt = 0; dt < DV / 32; ++dt) {
            if (dt + 1 < DV / 32) {
#pragma unroll
                for (int k4 = 0; k4 < 4; ++k4) { vl[(dt + 1) & 1][k4] = __builtin_amdgcn_ds_read_tr16_b64_v4i16((LAS v4i16_t*)(vb + (dt + 1) * 4096 + (16 * k4) * 64)); vh[(dt + 1) & 1][k4] = __builtin_amdgcn_ds_read_tr16_b64_v4i16((LAS v4i16_t*)(vb + (dt + 1) * 4096 + (16 * k4) * 64 + 512)); }
            }
            SBAR();
#pragma unroll
            for (int k4 = 0; k4 < 4; ++k4) { const v4i16_t lo = vl[dt & 1][k4], hh = vh[dt & 1][k4];
                const bf16x8 vf = (bf16x8){lo[0], lo[1], lo[2], lo[3], hh[0], hh[1], hh[2], hh[3]};
                W.o[dt] = __builtin_amdgcn_mfma_f32_32x32x16_bf16(vf, pf[k4], W.o[dt], 0, 0, 0); }
            SBAR();
        }
    } else {
#pragma unroll
        for (int dt = 0; dt < DV / 32; ++dt) {
            v4i16_t vl[4], vh[4];
#pragma unroll
            for (int k4 = 0; k4 < 4; ++k4) { vl[k4] = __builtin_amdgcn_ds_read_tr16_b64_v4i16((LAS v4i16_t*)(vb + dt * 4096 + (16 * k4) * 64)); vh[k4] = __builtin_amdgcn_ds_read_tr16_b64_v4i16((LAS v4i16_t*)(vb + dt * 4096 + (16 * k4) * 64 + 512)); }
            SBAR();
#pragma unroll
            for (int k4 = 0; k4 < 4; ++k4) { const v4i16_t lo = vl[k4], hh = vh[k4];
                const bf16x8 vf = (bf16x8){lo[0], lo[1], lo[2], lo[3], hh[0], hh[1], hh[2], hh[3]};
                W.o[dt] = __builtin_amdgcn_mfma_f32_32x32x16_bf16(vf, pf[k4], W.o[dt], 0, 0, 0); }
            SBAR();
        }
    }
}
template <int DQK, int DV, int KPB, bool MASKED>
__device__ __forceinline__ void tile_loop(WState<DQK, DV>& W, LAS unsigned char* lds, const char* kg, size_t kpitch, const char* vg, size_t vpitch, int nT, int my_nt, int kc0, int tid, int lane, const LAS unsigned* mq, int mode = 0) {
    const int r32 = lane & 31, hi = lane >> 5;
    const bool lag = __builtin_amdgcn_readfirstlane(tid) >= 256;
    StageK<KPB> sk; StageV<DV> sv;
    sk.load(kg, kpitch, 0, tid); sv.load(vg, vpitch, 0, tid); sk.store(lds, 0, tid); sv.store(lds, 0, tid);
    if (nT > 1) { sk.load(kg, kpitch, 64, tid); sk.store(lds, 1, tid); }
    __syncthreads();
    f32x16 sc[2], sn[2]; bf16x8 pf[4];
    qk_tile<DQK, KPB>(sc, W.qf, lds + L_K, kc0, r32, hi);
    __syncthreads();
    volatile LAS unsigned* mstat = (volatile LAS unsigned*)(lds + MISC_OFF + 64);
    const bool tw = TIMING && (tid == 0);
    int vs_prev = 0, vs_cur = 0, vs_next = 16384;
    for (int t = 0; t < nT; ++t) {
        if (t + 2 < nT && mode != 3) sk.load(kg, kpitch, 64 * (t + 2), tid);
        if (t + 1 < nT && mode != 3) sv.load(vg, vpitch, 64 * (t + 1), tid);
        if (mode != 2 && t < my_nt) {
            if (lag && t > 0) step_pv<DQK, DV>(W, pf, lds + L_V + vs_prev, lane);
            step_sm<DQK, DV, KPB, MASKED>(W, sc, sn, pf, lds + L_K + ((t + 1) & 1) * 16384, kc0, lane, MASKED ? mq + 2 * t : mq);
            if (!lag) step_pv<DQK, DV>(W, pf, lds + L_V + vs_cur, lane);
#pragma unroll
            for (int r = 0; r < 16; ++r) { sc[0][r] = sn[0][r]; sc[1][r] = sn[1][r]; }
        }
        if (t + 2 < nT && mode != 3) sk.store(lds, t & 1, tid);
        if (t + 1 < nT && mode != 3) sv.store_off(lds, vs_next, tid);
        asm volatile("s_waitcnt vmcnt(0) lgkmcnt(0)" ::: "memory");
        __syncthreads();
        vs_prev = vs_cur; vs_cur = vs_next; vs_next = (vs_next == 32768) ? 0 : vs_next + 16384;
    }
    if (lag && mode != 2 && my_nt > 0) step_pv<DQK, DV>(W, pf, lds + L_V + vs_prev, lane);
    __syncthreads();
}
template <int DQK, int DV> __device__ __forceinline__ void wstate_init(WState<DQK, DV>& W, const bf16* qrow  , int hi) {
#pragma unroll
    for (int ks = 0; ks < DQK / 16; ++ks) W.qf[ks] = *(const bf16x8*)(qrow + 16 * ks + 8 * hi);
#pragma unroll
    for (int dt = 0; dt < DV / 32; ++dt) W.o[dt] = (f32x16){};
    W.m = NEG_BIG; W.l = 0.f;
}

__device__ __forceinline__ unsigned skey(float score, int idx) {
    const unsigned b = __float_as_uint(score); const unsigned k = b ^ ((unsigned)((int)b >> 31) | 0x80000000u);
    return ((k >> 1) & 0x7FFFF800u) | (unsigned)(2047 - idx);
}
__device__ __forceinline__ unsigned dpp_u(unsigned v, int ctrl_sel) {
    switch (ctrl_sel) {
    case 0: return (unsigned)__builtin_amdgcn_update_dpp(0, (int)v, 0xB1, 0xF, 0xF, true);
    case 1: return (unsigned)__builtin_amdgcn_update_dpp(0, (int)v, 0x4E, 0xF, 0xF, true);
    case 2: return (unsigned)__builtin_amdgcn_update_dpp(0, (int)v, 0x141, 0xF, 0xF, true);
    default: return (unsigned)__builtin_amdgcn_update_dpp(0, (int)v, 0x140, 0xF, 0xF, true);
    }
}
__device__ __forceinline__ unsigned half_sum(unsigned v, int hi) {
#pragma unroll
    for (int s = 0; s < 4; ++s) v += dpp_u(v, s);
    const unsigned s0 = (unsigned)__builtin_amdgcn_readlane((int)v, 0) + (unsigned)__builtin_amdgcn_readlane((int)v, 16), s1 = (unsigned)__builtin_amdgcn_readlane((int)v, 32) + (unsigned)__builtin_amdgcn_readlane((int)v, 48);
    return hi ? s1 : s0;
}
__device__ __forceinline__ unsigned half_max(unsigned v, int hi) {
#pragma unroll
    for (int s = 0; s < 4; ++s) { const unsigned o = dpp_u(v, s); v = v > o ? v : o; }
    const unsigned a0 = (unsigned)__builtin_amdgcn_readlane((int)v, 0), a1 = (unsigned)__builtin_amdgcn_readlane((int)v, 16), b0 = (unsigned)__builtin_amdgcn_readlane((int)v, 32), b1 = (unsigned)__builtin_amdgcn_readlane((int)v, 48);
    const unsigned s0 = a0 > a1 ? a0 : a1, s1 = b0 > b1 ? b0 : b1;
    return hi ? s1 : s0;
}
__device__ __forceinline__ float unskey(unsigned k31) { const unsigned k = k31 << 1; const unsigned b = (k & 0x80000000u) ? (k ^ 0x80000000u) : ~k; return __uint_as_float(b); }
__device__ __forceinline__ unsigned skey_f(float f) { const unsigned b = __float_as_uint(f); return ((b ^ ((unsigned)((int)b >> 31) | 0x80000000u)) >> 1) & 0x7FFFF800u; }
__device__ __forceinline__ void indexer_pass(const Bufs& B, const int S, const LAS unsigned char* ikl, LAS unsigned* masks, size_t rowb, int t0, int w, int lane, int ntl, int limit, bf16x8 a0, bf16x8 a1) {
    const int r32 = lane & 31, hi = lane >> 5;
    volatile LAS unsigned* mstat = (volatile LAS unsigned*)(ikl + MISC_OFF + 64);
    unsigned long long tstart_ = 0; if (TIMING && w == 0) tstart_ = __builtin_amdgcn_s_memrealtime();
    float wt[8];
    { const float* iwp = WSP(const float, WS_IW) + (rowb + t0 + 4 * w + 2 * hi + S) * 8;
      const f32x4 v0 = *(const f32x4*)iwp, v1 = *(const f32x4*)(iwp + 4); wt[0] = v0.x; wt[1] = v0.y; wt[2] = v0.z; wt[3] = v0.w; wt[4] = v1.x; wt[5] = v1.y; wt[6] = v1.z; wt[7] = v1.w; }
    const int sw = (r32 >> 2) & 3;
    const LAS unsigned char* p0 = ikl + r32 * 64 + ((hi ^ sw) << 4);
    const LAS unsigned char* p1 = ikl + r32 * 64 + (((2 + hi) ^ sw) << 4);
    unsigned key[64]; unsigned kmax = 0u, kmin = 0xFFFFFFFFu;
#pragma unroll
    for (int tb = 0; tb < 16; ++tb) {
        if (4 * tb < ntl) {
#pragma unroll
            for (int tt = 0; tt < 4; ++tt) { const int t = 4 * tb + tt;
                const bf16x8 b0 = *(const LAS bf16x8*)(p0 + t * 2048), b1 = *(const LAS bf16x8*)(p1 + t * 2048);
                f32x16 acc = {};
                acc = __builtin_amdgcn_mfma_f32_32x32x16_bf16(a0, b0, acc, 0, 0, 0);
                acc = __builtin_amdgcn_mfma_f32_32x32x16_bf16(a1, b1, acc, 0, 0, 0);
                float s0 = 0.f;
#pragma unroll
                for (int h = 0; h < 8; ++h) { const int ai = __float_as_int(acc[h]); s0 += wt[h] * __int_as_float(ai > 0 ? ai : 0); }
                const unsigned k = skey(s0, 32 * t + r32);
                if (tt < 2) { key[t] = k; kmax = kmax > k ? kmax : k; kmin = kmin < k ? kmin : k; }
                else { const bool valid = t < ntl; key[t] = valid ? k : 0u; const unsigned kx = valid ? k : 0u, kn = valid ? k : 0xFFFFFFFFu; kmax = kmax > kx ? kmax : kx; kmin = kmin < kn ? kmin : kn; }
            }
        } else {
#pragma unroll
            for (int tt = 0; tt < 4; ++tt) key[4 * tb + tt] = 0u;
        }
    }
    unsigned long long ti0_ = 0; if (TIMING && w == 0) { ti0_ = __builtin_amdgcn_s_memrealtime(); if (lane == 0) mstat[8] += (unsigned)(ti0_ - tstart_); }
    unsigned tau = 1u;
    if (limit > 256) {
        kmax = half_max(kmax, hi); kmin = ~half_max(~kmin, hi);
        unsigned lo = kmin & ~0x7FFu, hb = kmax + 1u; float lof = unskey(lo), hbf = unskey(kmax); bool dn = false;
        float flo = (float)limit - 256.5f, fhb = -256.5f; int lastside = 0;
        for (int it = 0; it < 64; ++it) {
            if (!dn && hb - lo <= 1u) { tau = lo; dn = true; }
            if (__all(dn)) break;
            if (TIMING && w == 0 && lane == 0) mstat[11] += 100u;
            unsigned mid = skey_f((lof * fhb - hbf * flo) * __builtin_amdgcn_rcpf(fhb - flo));
            { const unsigned m2 = skey_f(0.5f * (lof + hbf)); const bool bad = (mid <= lo) | (mid >= hb); mid = bad ? m2 : mid; const bool bad2 = (mid <= lo) | (mid >= hb); mid = bad2 ? lo + ((hb - lo) >> 1) : mid; }
            const unsigned mm1 = mid - 1u;
            unsigned c0 = 0, c1 = 0, c2 = 0, c3 = 0;
#pragma unroll
            for (int tb = 0; tb < 4; ++tb) {
                if (16 * tb < ntl) {
                    unsigned a0_ = 0, a1_ = 0;
#pragma unroll
                    for (int tt = 0; tt < 16; tt += 2) { a0_ = __builtin_amdgcn_alignbit(a0_, mm1 - key[16 * tb + tt], 31); a1_ = __builtin_amdgcn_alignbit(a1_, mm1 - key[16 * tb + tt + 1], 31); }
                    if (tb & 1) { c1 += __builtin_popcount(a0_); c3 += __builtin_popcount(a1_); } else { c0 += __builtin_popcount(a0_); c2 += __builtin_popcount(a1_); }
                }
            }
            const unsigned c = half_sum((c0 + c1) + (c2 + c3), hi);
            if (!dn) {
                if (c == 256u) { tau = mid; dn = true; }
                else if (c > 256u) { lo = mid; lof = unskey(mid); flo = (float)c - 256.5f; if (lastside == 1) fhb *= 0.5f; lastside = 1; }
                else { hb = mid; hbf = unskey(mid); fhb = (float)c - 256.5f; if (lastside == 2) flo *= 0.5f; lastside = 2; }
            }
        }
    }
    unsigned long long ti1_ = 0; if (TIMING && w == 0) { ti1_ = __builtin_amdgcn_s_memrealtime(); if (lane == 0) mstat[9] += (unsigned)(ti1_ - ti0_); }
    LAS unsigned* mb = (r32 == 0) ? masks + (4 * w + 2 * hi + S) * 64 : masks + 2048 + lane;
#pragma unroll
    for (int t = 0; t < 64; ++t) {
        const unsigned long long m0 = __ballot(key[t] >= tau);
        mb[t] = hi ? (unsigned)(m0 >> 32) : (unsigned)m0;
    }
    if (TIMING && w == 0) { const unsigned long long ti2_ = __builtin_amdgcn_s_memrealtime(); if (lane == 0) mstat[10] += (unsigned)(ti2_ - ti1_); }
}
__device__ __forceinline__ void gather8(float (&v)[8], const f32x16& o, int gp) {
#pragma unroll
    for (int i = 0; i < 4; ++i) { auto rr = __builtin_amdgcn_permlane32_swap(__float_as_uint(o[8 * gp + i]), __float_as_uint(o[8 * gp + 4 + i]), false, false); v[i] = __uint_as_float(rr[0]); v[4 + i] = __uint_as_float(rr[1]); }
}
__device__ __forceinline__ v4u pack8(const float (&v)[8]) { v4u o; o.x = cvtpk(v[0], v[1]); o.y = cvtpk(v[2], v[3]); o.z = cvtpk(v[4], v[5]); o.w = cvtpk(v[6], v[7]); return o; }
__device__ __forceinline__ void unpack8(float (&g)[8], v4u w) { g[0] = bf2f(w.x & 0xffffu); g[1] = bf2f(w.x >> 16); g[2] = bf2f(w.y & 0xffffu); g[3] = bf2f(w.y >> 16); g[4] = bf2f(w.z & 0xffffu); g[5] = bf2f(w.z >> 16); g[6] = bf2f(w.w & 0xffffu); g[7] = bf2f(w.w >> 16); }
__device__ __forceinline__ void unit_A(Frame& F, int b, int qb32, int dmode) {
    const bool dry = dmode != 0;
    const Bufs& B = F.B; int tid_ = F.tid; asm volatile("" : "+v"(tid_)); const int tid = tid_, lane = tid & 63, w = F.wave, r32 = lane & 31, hi = lane >> 5;
    const int t0 = qb32 * 32, limit = ((t0 >> 6) + 1) << 6, ntl = limit >> 5;
    const size_t rowb = (size_t)b * SEQ;
    LAS unsigned* masks = (LAS unsigned*)(F.lds + L_MASK);
    {
        { const char* src = (const char*)(WSP(const bf16, WS_IK) + rowb * 32);
          const int P0 = w * 1024 + lane * 16, key0 = P0 >> 6, slot = (P0 >> 4) & 3;
#pragma unroll 1
          for (int s0 = 0; s0 < limit * 64; s0 += 8192) {
              const int key = key0 + (s0 >> 6);
              __builtin_amdgcn_global_load_lds((const unsigned*)(src + (size_t)key * 64 + ((slot ^ ((key >> 2) & 3)) << 4)), (LAS unsigned*)(F.lds + s0 + w * 1024), 16, 0, 0);
          } }
        asm volatile("s_waitcnt vmcnt(0)" ::: "memory");
        __syncthreads();
        TST(1);
        if (dmode != 3) {
#pragma unroll 1
        for (int sl = 0; sl < 2; ++sl) {
            const int rho = r32, qa = 2 * ((rho >> 2) & 1) + ((rho >> 4) ^ sl), ha = 4 * ((rho >> 3) & 1) + (rho & 3);
            const bf16* iqp = WSP(const bf16, WS_IQ) + (rowb + t0 + 4 * w + qa) * 256 + ha * 32 + 8 * hi;
            const bf16x8 a0 = *(const bf16x8*)iqp, a1 = *(const bf16x8*)(iqp + 16);
            indexer_pass(B, sl, F.lds, masks, rowb, t0, w, lane, ntl, limit, a0, a1);
        }
        }
    }
    __syncthreads();
    TST(2);
    {
        const int ql = 4 * w + (r32 >> 3), head = r32 & 7; const size_t row = rowb + t0 + ql;
        bf16* qrow = WSP(bf16, WS_QAB) + row * 1024 + head * 64;
        WState<64, 64> W; wstate_init<64, 64>(W, qrow, hi);
        const int nT = limit >> 6;
        __builtin_amdgcn_global_load_lds((const unsigned*)(WSP(const bf16, WS_AG) + row * 512 + head * 64), (LAS unsigned*)(F.lds + 98304 + w * 256), 4, 0, 0);
        tile_loop<64, 64, 128, true>(W, F.lds, (const char*)(WSP(const bf16, WS_AK) + rowb * 64), 128, (const char*)(WSP(const bf16, WS_AV) + rowb * 64), 128, dmode == 2 ? 1 : nT, dmode == 2 ? 1 : nT, 0, tid, lane, masks + ql * 64);
        TST(3);
        const float inv = 1.f / hswap_sum(W.l);
        const bf16* grow = WSP(const bf16, WS_AG) + row * 512 + head * 64;
        v4u gw[4];
#pragma unroll
        for (int q = 0; q < 4; ++q) gw[q] = *(const v4u*)(grow + 16 * q + 8 * hi);
#pragma unroll
        for (int dt = 0; dt < 2; ++dt)
#pragma unroll
            for (int gp = 0; gp < 2; ++gp) { const int d0 = 32 * dt + 16 * gp + 8 * hi;
                float v[8], g[8]; gather8(v, W.o[dt], gp); unpack8(g, gw[2 * dt + gp]);
#pragma unroll
                for (int i = 0; i < 8; ++i) v[i] = v[i] * inv * g[i];
                if (!dry) *(v4u*)(qrow + d0) = pack8(v); }
    }
    __syncthreads();
    TST(4);
}

__device__ __forceinline__ void unit_B(Frame& F, int b, int h, int qb128, int dmode) {
    const bool dry = dmode != 0;
    const Bufs& B = F.B; int tid_ = F.tid; asm volatile("" : "+v"(tid_)); const int tid = tid_, lane = tid & 63, w = F.wave, r32 = lane & 31, hi = lane >> 5;
    const int qb = w >> 1, c = w & 1, t0 = qb128 * 128 + qb * 32;
    const size_t rowb = (size_t)b * SEQ, row = rowb + t0 + r32;
    const int nT = 2 * qb128 + 2, my_nt = ((t0 >> 6) + 1);
    bf16* qrow = WSP(bf16, WS_QAB) + row * 1024 + 512 + h * 128;
    WState<64, 128> W; wstate_init<64, 128>(W, qrow + c * 64, hi);
    tile_loop<64, 128, 256, false>(W, F.lds, (const char*)(WSP(const bf16, WS_BK) + rowb * 512 + h * 128), 1024, (const char*)(WSP(const bf16, WS_BV) + rowb * 512 + h * 128), 1024, nT, my_nt, c * 8, tid, lane, nullptr, dmode);
    TST(5);
    const float inv = 1.f / hswap_sum(W.l);
    LAS float* X = (LAS float*)(F.lds + L_X) + qb * 4096 + lane;
    const bf16* grow = WSP(const bf16, WS_BG) + row * 512 + h * 128;
    v4u gpre[8];
    if (c == 0) {
#pragma unroll
        for (int q = 0; q < 8; ++q) gpre[q] = *(const v4u*)(grow + 16 * q + 8 * hi);
    }
    if (c == 1) {
#pragma unroll
        for (int dt = 0; dt < 4; ++dt)
#pragma unroll
            for (int r = 0; r < 16; ++r) X[(dt * 16 + r) * 64] = W.o[dt][r] * inv;
    }
    __syncthreads();
    if (c == 0) {
        const float lam = *(const LAS float*)(F.lds + L_NG + 512);
        float ss = 0.f;
#pragma unroll
        for (int dt = 0; dt < 4; ++dt)
#pragma unroll
            for (int r = 0; r < 16; ++r) { const float v = W.o[dt][r] * inv - lam * X[(dt * 16 + r) * 64]; W.o[dt][r] = v; ss += v * v; }
        ss = hswap_sum(ss);
        const float rn = rsqrtf(ss * (1.f / 128.f) + LN_EPS) * (1.f - LAM_INIT);
#pragma unroll
        for (int dt = 0; dt < 4; ++dt)
#pragma unroll
            for (int gp = 0; gp < 2; ++gp) { const int d0 = 32 * dt + 16 * gp + 8 * hi;
                float v[8], g[8]; gather8(v, W.o[dt], gp); unpack8(g, gpre[2 * dt + gp]);
                const f32x4 n0 = *(const LAS f32x4*)(F.lds + L_NG + d0 * 4), n1 = *(const LAS f32x4*)(F.lds + L_NG + d0 * 4 + 16);
#pragma unroll
                for (int i = 0; i < 8; ++i) v[i] = v[i] * rn * (i < 4 ? n0[i] : n1[i - 4]) * g[i];
                if (!dry) *(v4u*)(qrow + d0) = pack8(v); }
    }
    __syncthreads();
    TST(6);
}

__device__ __forceinline__ void unit_C(Frame& F, int b, int h, int qb256, bool dry) {
    const Bufs& B = F.B; int tid_ = F.tid; asm volatile("" : "+v"(tid_)); const int tid = tid_, lane = tid & 63, w = F.wave, r32 = lane & 31, hi = lane >> 5;
    const size_t row = (size_t)b * SEQ + qb256 * 256 + w * 32 + r32;
    bf16* qrow = WSP(bf16, WS_QC) + row * 1024 + h * 128;
    WState<128, 128> W; wstate_init<128, 128>(W, qrow, hi);
    const char* kv = (const char*)(WSP(const bf16, WS_MKV) + (size_t)b * MEM_LEN * 1024 + h * 128);
    __builtin_amdgcn_global_load_lds((const unsigned*)(qrow + 512 + hi * 64), (LAS unsigned*)(F.lds + L_MASK + w * 256), 4, 0, 0);
    { v4u kr[8], vr[8];
#pragma unroll
      for (int i = 0; i < 8; ++i) { const int idx = tid + 512 * i, key = idx >> 4, ch = idx & 15; kr[i] = *(const v4u*)(kv + (size_t)key * 2048 + ch * 16); vr[i] = *(const v4u*)(kv + 1024 + (size_t)key * 2048 + ch * 16); }
#pragma unroll
      for (int i = 0; i < 8; ++i) { const int idx = tid + 512 * i, key = idx >> 4, ch = idx & 15, t = key >> 6, k64 = key & 63;
          *(LAS v4u*)(F.lds + t * 16384 + k64 * 256 + ((ch ^ ksw<256>(k64)) << 4)) = kr[i];
          *(LAS v4u*)(F.lds + 65536 + t * 16384 + (ch >> 2) * 4096 + k64 * 64 + (ch & 3) * 16) = vr[i]; } }
    __syncthreads();
    { f32x16 sc[2], sn[2]; bf16x8 pf[4];
      qk_tile<128, 256>(sc, W.qf, F.lds, 0, r32, hi);
#pragma unroll 1
      for (int t = 0; t < 4; ++t) {
          step_sm<128, 128, 256, false>(W, sc, sn, pf, F.lds + ((t + 1) & 3) * 16384, 0, lane, nullptr);
          step_pv<128, 128>(W, pf, F.lds + 65536 + t * 16384, lane);
#pragma unroll
          for (int r = 0; r < 16; ++r) { sc[0][r] = sn[0][r]; sc[1][r] = sn[1][r]; }
      } }
    const float inv = 1.f / hswap_sum(W.l);
    const bf16* grow = qrow + 512;
    v4u gwc[8];
#pragma unroll
    for (int q = 0; q < 8; ++q) gwc[q] = *(const v4u*)(grow + 16 * q + 8 * hi);
#pragma unroll
    for (int dt = 0; dt < 4; ++dt)
#pragma unroll
        for (int gp = 0; gp < 2; ++gp) { const int d0 = 32 * dt + 16 * gp + 8 * hi;
            float v[8], g[8]; gather8(v, W.o[dt], gp); unpack8(g, gwc[2 * dt + gp]);
#pragma unroll
            for (int i = 0; i < 8; ++i) v[i] = v[i] * inv * g[i];
            if (!dry) *(v4u*)(qrow + d0) = pack8(v); }
    __syncthreads();
    TST(7);
}

__device__ __forceinline__ void unit_MKV(Frame& F, int b, int pn) {
    const Bufs& B = F.B;
    SchedOne S; S.pm = b; S.pn = pn; S.MEMB = (const char*)(B.ws + WS_MEMB); S.WMEM = (const char*)(B.ws + WS_WMEM);
    EpiIn E{B};
    pg8::gemm_phase<EpiIn, SchedOne, true, true>(F.lds + RING_OFF, S, E);
    asm volatile("s_waitcnt vmcnt(0)" ::: "memory");
    __syncthreads();
    if (F.tid == 0) { __builtin_amdgcn_fence(__ATOMIC_RELEASE, "agent"); asm volatile("s_waitcnt vmcnt(0)" ::: "memory"); __hip_atomic_fetch_add(F.ctl + CW_MKV + 64 * b, 1u, __ATOMIC_RELAXED, __HIP_MEMORY_SCOPE_AGENT); }
    __syncthreads();
}
__device__ __forceinline__ void wait_MKV(Frame& F, int b) {
    if (F.tid == 0) {
        unsigned sp = 0;
        while (__hip_atomic_load(F.ctl + CW_MKV + 64 * b, __ATOMIC_RELAXED, __HIP_MEMORY_SCOPE_AGENT) < 4u) { __builtin_amdgcn_s_sleep(2); if (++sp > (1u << 22)) break; }
        __builtin_amdgcn_fence(__ATOMIC_ACQUIRE, "agent"); asm volatile("s_waitcnt vmcnt(0)" ::: "memory");
    }
    __syncthreads();
}
constexpr int QUNITS = 328;
__device__ __forceinline__ void attn_phase(Frame& F, unsigned* qctr) {
    const int q0 = (int)(xb_xcc_id() & 7u);
    if (F.tid < 128) ((LAS float*)(F.lds + L_NG))[F.tid] = F.B.diff_norm_g[F.tid];
    if (F.tid == 128) ((LAS float*)(F.lds + L_NG))[128] = *(const float*)(F.B.ws + WS_LAM);
    if (TIMING && threadIdx.x == 0) F.MISC[14] = (unsigned)__builtin_amdgcn_s_memrealtime();
    for (int k = 0; k < 8; ++k) {
        const int q = (q0 + k) & 7;
        for (;;) {
            __syncthreads();
            if (F.tid == 0) F.MISC[0] = atomicAdd(qctr + 64 * q, 1u);
            __syncthreads();
            int pos = (int)F.MISC[0]; int dmode = 0;
            TST(0);
#if PROBE_DRY
            if (pos < 128) { dmode = PROBE_DMODE; pos = ((pos >> 2) << 3) + (pos & 3) + (PROBE_DRY == 1 ? 0 : 4); } else pos -= 128;
#endif
            if (pos >= QUNITS) break;
            if (pos < 8) { unit_MKV(F, q + 8 * (pos >> 2), pos & 3); continue; }
            pos -= 8;
            if (pos < 256) {
                const int b = q + 8 * (pos >> 7), p = pos & 127, L = 15 - (p >> 3), r = p & 7;
                if (r < 4) unit_A(F, b, 4 * L + 3 - r, dmode);
                else unit_B(F, b, r - 4, L, dmode);
            } else { const int c = pos - 256, b = q + 8 * (c >> 5), cc = c & 31; wait_MKV(F, b); unit_C(F, b, cc & 3, cc >> 2, false); }
        }
    }
    if (TIMING) { __syncthreads(); if (F.tid < 16) atomicAdd(F.ctl + CW_TIME + F.tid, F.MISC[16 + F.tid]); }
}
}
constexpr size_t WS_SCR = WS_XN;
struct SchedMerge {
    pg8::TileOrder T; int G, c; const char *QAB, *QC, *WAB, *WC;
    __device__ __forceinline__ bool next(int i, pg8::Unit& u) const {
        const int ti = i / 3, br = i - ti * 3, L = ti * G + c;
        if (L >= T.nwg) return false;
        T.tile(L, u.pm, u.pn); u.kind = br; u.nt = 8; u.keep = br < 2 ? 1 : 0;
        if (br == 0) { u.A = QAB + (size_t)u.pm * pg8::TSTEP; u.B = WAB + (size_t)u.pn * pg8::TSTEP; }
        else if (br == 1) { u.A = QAB + (size_t)u.pm * pg8::TSTEP + 1024; u.B = WAB + (size_t)u.pn * pg8::TSTEP + 1024; }
        else { u.A = QC + (size_t)u.pm * pg8::TSTEP; u.B = WC + (size_t)u.pn * pg8::TSTEP; }
        return true;
    }
    __device__ __forceinline__ void a_ready(const pg8::Unit&) const {}
    __device__ __forceinline__ void done(const pg8::Unit&) const {}
};
struct EpiMerge {
    static constexpr bool PERM = true, AFTER_DRAIN = false; bf16* merged; const unsigned char* ws_;
    __device__ __forceinline__ static void ld_u8(pg8::f32x4& a, pg8::f32x4& b, const unsigned char* p) {
        const uint2 gw = *(const uint2*)p; const float s = 1.f / 255.f;
        a = (pg8::f32x4){fmaxf((float)(gw.x & 255u), 1.f), fmaxf((float)((gw.x >> 8) & 255u), 1.f), fmaxf((float)((gw.x >> 16) & 255u), 1.f), fmaxf((float)(gw.x >> 24), 1.f)} * s;
        b = (pg8::f32x4){fmaxf((float)(gw.y & 255u), 1.f), fmaxf((float)((gw.y >> 8) & 255u), 1.f), fmaxf((float)((gw.y >> 16) & 255u), 1.f), fmaxf((float)(gw.y >> 24), 1.f)} * s;
    }
    __device__ __forceinline__ static void ld_bf(pg8::f32x4& a, pg8::f32x4& b, const bf16* p) {
        const v4u gw = *(const v4u*)p;
        a = (pg8::f32x4){bf2f(gw.x & 0xffffu), bf2f(gw.x >> 16), bf2f(gw.y & 0xffffu), bf2f(gw.y >> 16)}; b = (pg8::f32x4){bf2f(gw.z & 0xffffu), bf2f(gw.z >> 16), bf2f(gw.w & 0xffffu), bf2f(gw.w >> 16)};
    }
    __device__ __forceinline__ static pg8::f32x4 rcp4(pg8::f32x4 v) { return (pg8::f32x4){__builtin_amdgcn_rcpf(v[0]), __builtin_amdgcn_rcpf(v[1]), __builtin_amdgcn_rcpf(v[2]), __builtin_amdgcn_rcpf(v[3])}; }
    __device__ __forceinline__ static void cv_u8(pg8::f32x4& a, pg8::f32x4& b, uint2 gw) {
        const float s = 1.f / 255.f;
        a = (pg8::f32x4){fmaxf((float)(gw.x & 255u), 1.f), fmaxf((float)((gw.x >> 8) & 255u), 1.f), fmaxf((float)((gw.x >> 16) & 255u), 1.f), fmaxf((float)(gw.x >> 24), 1.f)} * s;
        b = (pg8::f32x4){fmaxf((float)(gw.y & 255u), 1.f), fmaxf((float)((gw.y >> 8) & 255u), 1.f), fmaxf((float)((gw.y >> 16) & 255u), 1.f), fmaxf((float)(gw.y >> 24), 1.f)} * s;
    }
    __device__ __forceinline__ static void cv_bf(pg8::f32x4& a, pg8::f32x4& b, v4u gw) {
        a = (pg8::f32x4){bf2f(gw.x & 0xffffu), bf2f(gw.x >> 16), bf2f(gw.y & 0xffffu), bf2f(gw.y >> 16)}; b = (pg8::f32x4){bf2f(gw.z & 0xffffu), bf2f(gw.z >> 16), bf2f(gw.w & 0xffffu), bf2f(gw.w >> 16)};
    }
    __device__ __forceinline__ void operator()(pg8::f32x4 (&acc)[2][2][4][2], const pg8::Unit& u, int wr, int wc, int fr, int fq) const {
        const int row0 = u.pm * 256 + wr * 64 + fr, col0 = u.pn * 256 + wc * 32 + 8 * fq;
        const size_t rt = (size_t)u.pm * 256, lo = (size_t)(wr * 64 + fr) * 1024 + col0;
        const int wv = wr * 4 + wc, ln = fq * 16 + fr;
        const size_t tA = ((size_t)(u.pm * 4 + u.pn) * 8 + wv) * 8192, tB = ((size_t)(u.pm * 4 + u.pn) * 8 + wv) * 16384;
        const __amdgpu_buffer_rsrc_t rA = __builtin_amdgcn_make_buffer_rsrc((void*)(ws_ + WS_GA + tA), 0, 8192, 0x00020000);
        const __amdgpu_buffer_rsrc_t rC = __builtin_amdgcn_make_buffer_rsrc((void*)(rt < GC_SPLIT ? ws_ + WS_GC + tA : ws_ + WS_GC2 + (tA - (size_t)GC_SPLIT * 1024)), 0, 8192, 0x00020000);
        const __amdgpu_buffer_rsrc_t rB = __builtin_amdgcn_make_buffer_rsrc((void*)(ws_ + WS_GB + tB), 0, 16384, 0x00020000);
        const int vl = ln * 16;
#define LD8P(r, p) __builtin_amdgcn_raw_buffer_load_b128(r, vl, (p) * 1024, 2)
#define LD16(ix) __builtin_amdgcn_raw_buffer_load_b128(rB, vl, (ix) * 1024, 2)
#define OFS(ix) ((((((ix) >> 3) & 1) * 128 + ((ix) & 3) * 16) * 1024) + (((ix) >> 2) & 1) * 128)
        if (u.kind == 2) {
            v4u qn[8];
#pragma unroll
            for (int j = 0; j < 8; ++j) qn[j] = LD8P(rC, j);
#pragma unroll
            for (int j = 0; j < 8; ++j) {
#pragma unroll
                for (int s2 = 0; s2 < 2; ++s2) { const int ix = 2 * j + s2; pg8::f32x4 na, nb; cv_u8(na, nb, s2 ? make_uint2(qn[j].z, qn[j].w) : make_uint2(qn[j].x, qn[j].y)); const int ai = ix >> 3, bj = (ix >> 2) & 1, m = ix & 3;
                    const pg8::f32x4 t0 = acc[ai][bj][m][0] * na, t1 = acc[ai][bj][m][1] * nb; float v[8] = {t0[0], t0[1], t0[2], t0[3], t1[0], t1[1], t1[2], t1[3]};
                    store8c(merged + (size_t)(row0 + ai * 128 + m * 16) * 1024 + col0 + bj * 128, v); } }
        } else
#pragma unroll
        for (int h = 0; h < 2; ++h) {
            uint2 q8[8]; v4u q16[8];
            if (u.kind == 0) {
#pragma unroll
                for (int j = 0; j < 4; ++j) { const v4u t_ = LD8P(rA, h * 4 + j); q8[2 * j] = make_uint2(t_.x, t_.y); q8[2 * j + 1] = make_uint2(t_.z, t_.w); }
#pragma unroll
                for (int j = 0; j < 8; ++j) q16[j] = LD16(h * 8 + j);
#pragma unroll
                for (int j = 0; j < 8; ++j) { const int ix = h * 8 + j; pg8::f32x4 na, nb, da, db; cv_u8(na, nb, q8[j]); cv_bf(da, db, q16[j]);
                    acc[ix >> 3][(ix >> 2) & 1][ix & 3][0] *= na * rcp4(da); acc[ix >> 3][(ix >> 2) & 1][ix & 3][1] *= nb * rcp4(db); }
            } else if (u.kind == 1) {
#pragma unroll
                for (int j = 0; j < 4; ++j) { const v4u t_ = LD8P(rC, h * 4 + j); q8[2 * j] = make_uint2(t_.x, t_.y); q8[2 * j + 1] = make_uint2(t_.z, t_.w); }
#pragma unroll
                for (int j = 0; j < 8; ++j) q16[j] = LD16(h * 8 + j);
#pragma unroll
                for (int j = 0; j < 8; ++j) { const int ix = h * 8 + j; pg8::f32x4 na, nb, da, db; cv_bf(na, nb, q16[j]); cv_u8(da, db, q8[j]);
                    acc[ix >> 3][(ix >> 2) & 1][ix & 3][0] *= na * rcp4(da); acc[ix >> 3][(ix >> 2) & 1][ix & 3][1] *= nb * rcp4(db); }
            } else {
#pragma unroll
                for (int j = 0; j < 4; ++j) { const v4u t_ = LD8P(rC, h * 4 + j); q8[2 * j] = make_uint2(t_.x, t_.y); q8[2 * j + 1] = make_uint2(t_.z, t_.w); }
#pragma unroll
                for (int j = 0; j < 8; ++j) { const int ix = h * 8 + j; pg8::f32x4 na, nb; cv_u8(na, nb, q8[j]); const int ai = ix >> 3, bj = (ix >> 2) & 1, m = ix & 3;
                    const pg8::f32x4 t0 = acc[ai][bj][m][0] * na, t1 = acc[ai][bj][m][1] * nb; float v[8] = {t0[0], t0[1], t0[2], t0[3], t1[0], t1[1], t1[2], t1[3]};
                    store8c(merged + (size_t)(row0 + ai * 128 + m * 16) * 1024 + col0 + bj * 128, v); }
            }
            asm volatile("" ::: "memory");
        }
#undef LD8P
#undef LD16
#undef OFS
    }
};
struct SchedOut {
    pg8::TileOrder T; int G, c; const char *MG, *WO;
    __device__ __forceinline__ bool next(int i, pg8::Unit& u) const {
        const int L = i * G + c; if (L >= T.nwg) return false;
        T.tile(L, u.pm, u.pn); u.A = MG + (size_t)u.pm * pg8::TSTEP; u.B = WO + (size_t)u.pn * pg8::TSTEP; u.nt = 16; u.kind = 0; u.keep = 0; return true;
    }
    __device__ __forceinline__ void a_ready(const pg8::Unit&) const {}
    __device__ __forceinline__ void done(const pg8::Unit&) const {}
};
struct EpiOutF {
    static constexpr bool PERM = true, AFTER_DRAIN = false; bf16* Y;
    __device__ __forceinline__ void operator()(const pg8::f32x4 (&acc)[2][2][4][2], const pg8::Unit& u, int wr, int wc, int fr, int fq) const {
        const int row0 = u.pm * 256 + wr * 64 + fr, col0 = u.pn * 256 + wc * 32 + 8 * fq;
#pragma unroll
        for (int ai = 0; ai < 2; ++ai)
#pragma unroll
            for (int m = 0; m < 4; ++m)
#pragma unroll
                for (int bj = 0; bj < 2; ++bj) { const pg8::f32x4 t0 = acc[ai][bj][m][0], t1 = acc[ai][bj][m][1];
                    float v[8] = {t0[0], t0[1], t0[2], t0[3], t1[0], t1[1], t1[2], t1[3]};
                    store8c(Y + (size_t)(row0 + ai * 128 + m * 16) * 1024 + col0 + bj * 128, v); }
    }
};
__device__ __forceinline__ void ln_out_rows(const Bufs& B, const bf16* Y, int gw, int NGW, int lane) {
    f32x4 gi[4], bi[4];
#pragma unroll
    for (int j = 0; j < 4; ++j) { gi[j] = *((const f32x4*)B.ln_in_g + lane + 64 * j) * ALPHA; bi[j] = *((const f32x4*)B.ln_in_b + lane + 64 * j) * ALPHA; }
    f32x4 v[4], nx[4]; uint2 yv[4], ny[4]; float2 st = {0.f, 0.f}, nst = {0.f, 0.f};
    if (gw < M) { const f32x4* xr = (const f32x4*)(B.x + (size_t)gw * D) + lane; const uint2* yr = (const uint2*)(Y + (size_t)gw * D) + lane;
#pragma unroll
        for (int j = 0; j < 4; ++j) { v[j] = __builtin_nontemporal_load(xr + 64 * j); { typedef unsigned v2u_ __attribute__((ext_vector_type(2))); const v2u_ t_ = __builtin_nontemporal_load((const v2u_*)(yr + 64 * j)); yv[j] = make_uint2(t_.x, t_.y); } }
        st = *(const float2*)(WSP(const float, WS_STATS) + (size_t)gw * 2); }
    for (int row = gw; row < M; row += NGW) {
        const int nr = row + NGW;
        if (nr < M) { const f32x4* xr = (const f32x4*)(B.x + (size_t)nr * D) + lane; const uint2* yr = (const uint2*)(Y + (size_t)nr * D) + lane;
#pragma unroll
            for (int j = 0; j < 4; ++j) { nx[j] = __builtin_nontemporal_load(xr + 64 * j); { typedef unsigned v2u_ __attribute__((ext_vector_type(2))); const v2u_ t_ = __builtin_nontemporal_load((const v2u_*)(yr + 64 * j)); ny[j] = make_uint2(t_.x, t_.y); } }
            nst = *(const float2*)(WSP(const float, WS_STATS) + (size_t)nr * 2); }
        float s = 0.f;
#pragma unroll
        for (int j = 0; j < 4; ++j) { const f32x4 yy = {bf2f(yv[j].x & 0xffffu), bf2f(yv[j].x >> 16), bf2f(yv[j].y & 0xffffu), bf2f(yv[j].y >> 16)};
            v[j] = (v[j] - st.x) * st.y * gi[j] + bi[j] + yy; s += (v[j].x + v[j].y) + (v[j].z + v[j].w); }
        const float mean = wave_sum(s) * (1.f / D); float s2 = 0.f;
#pragma unroll
        for (int j = 0; j < 4; ++j) { v[j] = v[j] - mean; s2 += (v[j].x * v[j].x + v[j].y * v[j].y) + (v[j].z * v[j].z + v[j].w * v[j].w); }
        const float rstd = rsqrtf(wave_sum(s2) * (1.f / D) + LN_EPS);
        f32x4* orow = (f32x4*)(B.out + (size_t)row * D) + lane;
#pragma unroll
        for (int j = 0; j < 4; ++j) { const f32x4 g = *((const f32x4*)B.ln_g + lane + 64 * j), b = *((const f32x4*)B.ln_b + lane + 64 * j); __builtin_nontemporal_store(v[j] * rstd * g + b, orow + 64 * j); }
#pragma unroll
        for (int j = 0; j < 4; ++j) { v[j] = nx[j]; yv[j] = ny[j]; }
        st = nst;
    }
}
__device__ __forceinline__ void ln_out_row(const Bufs& B, int row, int lane) {
    f32x4* xr = (f32x4*)(B.out + (size_t)row * D) + lane;
    f32x4 v[4]; float s = 0.f;
#pragma unroll
    for (int j = 0; j < 4; ++j) { v[j] = xr[64 * j]; s += (v[j].x + v[j].y) + (v[j].z + v[j].w); }
    const float mean = wave_sum(s) * (1.f / D); float s2 = 0.f;
#pragma unroll
    for (int j = 0; j < 4; ++j) { v[j] = v[j] - mean; s2 += (v[j].x * v[j].x + v[j].y * v[j].y) + (v[j].z * v[j].z + v[j].w * v[j].w); }
    const float rstd = rsqrtf(wave_sum(s2) * (1.f / D) + LN_EPS);
#pragma unroll
    for (int j = 0; j < 4; ++j) { const f32x4 g = *((const f32x4*)B.ln_g + lane + 64 * j), b = *((const f32x4*)B.ln_b + lane + 64 * j); xr[64 * j] = v[j] * rstd * g + b; }
}
struct Args { Bufs B; int nprog; int prog[11]; };
__global__ void __launch_bounds__(NWAVES * 64, 2) skel_fwd(Args args) {
    extern __shared__ __attribute__((aligned(16))) unsigned char lds[];
    Frame F;
    F.lds = (LAS unsigned char*)lds; F.MISC = (volatile LAS unsigned*)(F.lds + MISC_OFF);
    F.tid = threadIdx.x; F.lane = F.tid & 63; F.wave = __builtin_amdgcn_readfirstlane(F.tid >> 6);
    F.G = gridDim.x; { const int bx = blockIdx.x; F.vcu = (F.G % 8 == 0) ? (bx % 8) * (F.G / 8) + bx / 8 : bx; }
    F.B = args.B; F.ctl = (unsigned*)(args.B.ws + WS_CTL);
    const Bufs& B = F.B;
    for (int u = F.tid; u < (LDS_BYTES - LDSCTL_OFF) / 4; u += NWAVES * 64) ((LAS unsigned*)(F.lds + LDSCTL_OFF))[u] = 0u;
    __syncthreads();
    XcdBarrier bar = xcd_barrier_post(F.ctl + CW_BAR, F.MISC + 8);
    const int en = args.nprog;
#define P_PRO()  do { if (en & 1) p0_prologue(F); } while (0)
#define P_IN()   do { if (en & 2) { SchedIn S; S.T.init(M / 256, NPOS / 256); S.G = F.G; S.c = (int)blockIdx.x; \
            S.XN = (const char*)(B.ws + WS_XN); S.WIN = (const char*)(B.ws + WS_WIN); S.MEMB = (const char*)(B.ws + WS_MEMB); S.WMEM = (const char*)(B.ws + WS_WMEM); \
            EpiIn E{B}; pg8::gemm_phase<EpiIn, SchedIn, true, true>(F.lds + RING_OFF, S, E); } } while (0)
#define P_ATT(qi) do { if (en & 4) att::attn_phase(F, F.ctl + CW_QUEUE + 512 * (qi)); } while (0)
#define P_MRG()  do { if (en & 8) { SchedMerge S; S.T.init(M / 256, 4); S.G = F.G; S.c = (int)blockIdx.x; \
            S.QAB = (const char*)(B.ws + WS_QAB); S.QC = (const char*)(B.ws + WS_QC); S.WAB = (const char*)(B.ws + WS_WAB); S.WC = (const char*)(B.ws + WS_WC); \
            EpiMerge E{WSP(bf16, WS_MERGED), (const unsigned char*)B.ws}; \
            pg8::gemm_phase<EpiMerge, SchedMerge, true, true>(F.lds + RING_OFF, S, E); } } while (0)
#define P_OUT()  do { if (en & 16) { SchedOut S; S.T.init(M / 256, 4); S.G = F.G; S.c = (int)blockIdx.x; S.MG = (const char*)(B.ws + WS_MERGED); S.WO = (const char*)(B.ws + WS_WOUT); \
            EpiOutF E{WSP(bf16, WS_XN)}; pg8::gemm_phase<EpiOutF, SchedOut, true, true>(F.lds + RING_OFF, S, E); } } while (0)
#define P_LN()   do { if (en & 32) ln_out_rows(B, WSP(const bf16, WS_XN), F.vcu * NWAVES + F.wave, F.G * NWAVES, (int)(threadIdx.x & 63u)); } while (0)
#define BAR() xcd_barrier(bar)
#ifndef PROBE_REP
#define PROBE_REP 0
#endif
    P_PRO(); BAR();
#if PROBE_REP == 10
    P_PRO(); BAR();
#endif
    P_IN(); BAR();
#if PROBE_REP == 1
    P_IN(); BAR();
#endif
    P_ATT(0); BAR();
#if PROBE_REP == 12
    P_IN(); BAR(); P_ATT(1); BAR();
#endif
    P_MRG(); BAR();
#if PROBE_REP == 3
    P_MRG(); BAR();
#endif
    P_OUT(); BAR();
    P_LN();
#if PROBE_REP == 45
    BAR(); P_OUT(); BAR(); P_LN();
#endif
#if TIMING_SEL >= 0
    BAR(); if (blockIdx.x == 0 && F.tid == 0) { const unsigned v = __hip_atomic_load(F.ctl + CW_TIME + TIMING_SEL, __ATOMIC_RELAXED, __HIP_MEMORY_SCOPE_AGENT); B.out[0] = (float)v / (float)F.G / 100.f; }
#endif
}
#ifndef FAST_UPTO
#define FAST_UPTO 6
#endif
#ifndef PROG_LIST
#define PROG_LIST 0, 1, 2, 3, 4, 5
#endif
static void launch_skel(const Bufs& B, hipStream_t stream, int grid) {
    static const int prog[] = {PROG_LIST};
    Args a{}; a.B = B; a.nprog = 63; (void)prog;
    hipLaunchKernelGGL(skel_fwd, dim3(grid), dim3(NWAVES * 64), LDS_BYTES, stream, a);
}
extern "C" void kernel_launch(void* const* d_in, const int* in_sizes, int n_in, void* d_out, int out_size, void* d_ws, size_t ws_size, hipStream_t stream) {
    (void)in_sizes; (void)n_in; (void)out_size;
    static int grid = 0;
    if (grid == 0) {
        if (ws_size < WS_END) { fprintf(stderr, "workspace too small: %zu < %zu\n", ws_size, (size_t)WS_END); grid = -1; return; }
        int dev = 0, cus = 0;
        if (hipGetDevice(&dev) != hipSuccess || hipDeviceGetAttribute(&cus, hipDeviceAttributeMultiprocessorCount, dev) != hipSuccess) { grid = -1; return; }
        if (hipFuncSetAttribute((const void*)skel_fwd, hipFuncAttributeMaxDynamicSharedMemorySize, LDS_BYTES) != hipSuccess) { fprintf(stderr, "hipFuncSetAttribute failed\n"); grid = -1; return; }
        int per_cu = 0; (void)hipOccupancyMaxActiveBlocksPerMultiprocessor(&per_cu, (const void*)skel_fwd, NWAVES * 64, LDS_BYTES); (void)hipGetLastError();
        if (per_cu < 1) fprintf(stderr, "note: occupancy query reports %d blocks/CU\n", per_cu);
        grid = cus;
    }
    if (grid < 0) return;
    Bufs B{};
    B.x = (const float*)d_in[0]; B.mem = (const float*)d_in[1]; B.ln_in_g = (const float*)d_in[2]; B.ln_in_b = (const float*)d_in[3]; B.w_in = (const float*)d_in[4];
    B.w_mem_kv = (const float*)d_in[5]; B.diff_lambda = (const float*)d_in[6]; B.diff_norm_g = (const float*)d_in[7]; B.w_proj_a = (const float*)d_in[8];
    B.w_proj_b = (const float*)d_in[9]; B.w_proj_c = (const float*)d_in[10]; B.w_out = (const float*)d_in[11]; B.ln_g = (const float*)d_in[12]; B.ln_b = (const float*)d_in[13];
    B.out = (float*)d_out; B.ws = (unsigned char*)d_ws;
    unsigned char* ws = B.ws;
    (void)hipMemsetAsync(ws + WS_CTL, 0, CTL_ZERO_BYTES, stream);
    launch_skel(B, stream, grid);
}
```

```cpp
#include <hip/hip_runtime.h>
#include <hip/hip_bf16.h>
#include <cstdint>
#include <cstdio>
#include <cmath>

typedef unsigned short bf16;
typedef unsigned v4u __attribute__((ext_vector_type(4)));
typedef float f32x4 __attribute__((ext_vector_type(4)));

constexpr int D = 1024, BATCH = 16, SEQ = 2048, M = BATCH * SEQ;
constexpr int MEM_LEN = 256, MM = BATCH * MEM_LEN;
constexpr int IN_WIDTH = 7592;
constexpr int NPOS = 7680;
constexpr int O_AQ = 0, O_AK = 512, O_AV = 576, O_AG = 640, O_IQ = 1152, O_IK = 1408, O_IW = 1440, O_BQ = 1448, O_BK = 1960, O_BV = 2472,
              O_BG = 2984, O_CQ = 3496, O_CG = 4008, O_MG = 4520;
constexpr float LN_EPS = 1e-5f;
constexpr float LOG2E = 1.4426950408889634f;
constexpr float ALPHA = 1.189207115002721f;
constexpr float LAM_INIT = 0.2f;

constexpr size_t MiB = 1u << 20;
constexpr size_t WS_CTL = 0;
constexpr size_t WS_TAB = 1 * MiB;
constexpr size_t WS_TAB32 = WS_TAB + 128 * 1024;
constexpr size_t WS_LAM = WS_TAB + 256 * 1024;
constexpr size_t WS_STATS = WS_TAB + 512 * 1024;
constexpr size_t WS_WIN = 2 * MiB;
constexpr size_t WS_WMG = 11 * MiB;
constexpr size_t WS_WMEM = 17 * MiB;
constexpr size_t WS_WAB = 19 * MiB;
constexpr size_t WS_WC = 21 * MiB;
constexpr size_t WS_WOUT = 23 * MiB;
constexpr size_t WS_MEMB = 25 * MiB;
constexpr size_t WS_MKV = 2 * MiB;
constexpr size_t WS_XN = 41 * MiB;
constexpr size_t WS_QAB = 105 * MiB;
constexpr size_t WS_QC = 169 * MiB;
constexpr size_t WS_AG = 233 * MiB;
constexpr size_t WS_BK = 265 * MiB;
constexpr size_t WS_BV = 297 * MiB;
constexpr size_t WS_BG = 329 * MiB;
constexpr size_t WS_IQ = 361 * MiB;
constexpr size_t WS_AK = 377 * MiB;
constexpr size_t WS_AV = 381 * MiB;
constexpr size_t WS_IK = 385 * MiB;
constexpr size_t WS_IW = 387 * MiB;
constexpr size_t WS_MASK = 388 * MiB;
constexpr size_t WS_MERGED = WS_BK;
constexpr size_t WS_GTMP = WS_BG;
constexpr size_t WS_GB = 388 * MiB;
constexpr size_t WS_GA = 452 * MiB;
constexpr size_t WS_GC = 484 * MiB;
constexpr size_t WS_GC2 = 33 * MiB;
constexpr int GC_SPLIT = 28672;
constexpr size_t WS_END = 512 * MiB;

__device__ __forceinline__ unsigned f2bf(float f) { unsigned u = __float_as_uint(f); return (u + 0x7fffu + ((u >> 16) & 1u)) >> 16; }
__device__ __forceinline__ float bf2f(unsigned v) { return __uint_as_float(v << 16); }
__device__ __forceinline__ unsigned pk2(float lo, float hi) { typedef float f2_ __attribute__((ext_vector_type(2))); typedef __bf16 b2_ __attribute__((ext_vector_type(2))); f2_ v = {lo, hi}; b2_ b = __builtin_convertvector(v, b2_); return __builtin_bit_cast(unsigned, b); }
__device__ __forceinline__ float silu_f(float x) { return x * __builtin_amdgcn_rcpf(1.f + __builtin_amdgcn_exp2f(-LOG2E * x)); }
__device__ __forceinline__ float sigmoid_f(float x) { return 1.f / (1.f + __expf(-x)); }

__host__ __device__ __forceinline__ int rp64(int j) { return j < 16 ? ((j >> 1) + 8 * (j & 1)) : j; }
__host__ __device__ __forceinline__ int rp32(int j) { return j < 8 ? ((j >> 1) + 4 * (j & 1)) : j; }
__host__ __device__ __forceinline__ int orig_of_pos(int p) {
    const int tile = p >> 8;
    if (tile < 2) { return O_AQ + (p & ~63) + rp64(p & 63); }
    if (tile < 4) { return O_AG + (p - 512); }
    if (tile < 6) { const int c = p - 1024; return O_BQ + (c & ~63) + rp64(c & 63); }
    if (tile < 8) { const int c = p - 1536; return O_BK + (c & ~63) + rp64(c & 63); }
    if (tile < 10) { return O_BV + (p - 2048); }
    if (tile < 12) { return O_BG + (p - 2560); }
    if (tile < 14) { return O_CQ + (p - 3072); }
    if (tile < 16) { return O_CG + (p - 3584); }
    if (tile == 16) { const int c = p - 4096; return O_IQ + (c & ~31) + rp32(c & 31); }
    if (tile >= 18) return O_MG + (p - 4608);
    const int j = p - 4352;
    if (j < 64) return O_AK + rp64(j);
    if (j < 128) return O_AV + (j - 64);
    if (j < 160) return O_IK + rp32(j - 128);
    if (j < 168) return O_IW + (j - 160);
    return -1;
}

struct Bufs {
    const float *x, *mem, *ln_in_g, *ln_in_b, *w_in, *w_mem_kv, *diff_lambda, *diff_norm_g, *w_proj_a, *w_proj_b, *w_proj_c, *w_out, *ln_g, *ln_b;
    float* out; unsigned char* ws;
};
#define WSP(T, off) ((T*)(B.ws + (off)))

__device__ __forceinline__ void rope8_64(float* v, const float* tab, int i0) {
    const f32x4 c = *(const f32x4*)(tab + i0), s = *(const f32x4*)(tab + 8 + i0);
#pragma unroll
    for (int j = 0; j < 4; ++j) { const float x1 = v[2 * j], x2 = v[2 * j + 1]; v[2 * j] = x1 * c[j] - x2 * s[j]; v[2 * j + 1] = x2 * c[j] + x1 * s[j]; }
}
__device__ __forceinline__ void store8c(bf16* dst, const float* v) {
    v4u o; o.x = pk2(v[0], v[1]); o.y = pk2(v[2], v[3]); o.z = pk2(v[4], v[5]); o.w = pk2(v[6], v[7]); *(v4u*)dst = o;
}
__device__ __forceinline__ void store8(bf16* dst, const float* v) {
    v4u o; o.x = pk2(v[0], v[1]); o.y = pk2(v[2], v[3]); o.z = pk2(v[4], v[5]); o.w = pk2(v[6], v[7]); __builtin_nontemporal_store(o, (v4u*)dst);
}
enum { K_AQ = 0, K_AG, K_BQ, K_BK, K_BV, K_BG, K_CQ, K_CG, K_IQ, K_MISC, K_MG };
__host__ __device__ __forceinline__ int kind_of_tile(int tile) { return tile < 16 ? (tile >> 1) : (tile == 16 ? K_IQ : (tile == 17 ? K_MISC : K_MG)); }
__device__ __forceinline__ void rope8_32(float* v, const float* tab32) {
    const f32x4 cs = *(const f32x4*)(tab32), sn = *(const f32x4*)(tab32 + 4);
#pragma unroll
    for (int j = 0; j < 4; ++j) { const float x1 = v[2 * j], x2 = v[2 * j + 1]; v[2 * j] = x1 * cs[j] - x2 * sn[j]; v[2 * j + 1] = x2 * cs[j] + x1 * sn[j]; }
}
template <int KIND> __device__ __forceinline__ void emit8k(const Bufs& B, int t, int c, float* v) {
    const int pos = t & (SEQ - 1);
    const float* tab64 = WSP(const float, WS_TAB) + pos * 16;
    const float* tab32 = WSP(const float, WS_TAB32) + pos * 8;
    const float SQ64 = 0.125f * LOG2E, SQ128 = 0.08838834764831845f * LOG2E;
    if constexpr (KIND == K_AQ || KIND == K_BQ) {
        const int w = c & 63; if (w < 16) rope8_64(v, tab64, w >> 1);
#pragma unroll
        for (int j = 0; j < 8; ++j) v[j] *= SQ64;
        store8(WSP(bf16, WS_QAB) + (size_t)t * 1024 + (KIND == K_BQ ? 512 : 0) + c, v);
    } else if constexpr (KIND == K_AG || KIND == K_BG) {
#pragma unroll
        for (int j = 0; j < 8; ++j) v[j] = silu_f(v[j]);
        store8(WSP(bf16, KIND == K_AG ? WS_AG : WS_BG) + (size_t)t * 512 + c, v);
    } else if constexpr (KIND == K_BK) {
        const int w = c & 63; if (w < 16) rope8_64(v, tab64, w >> 1);
        store8c(WSP(bf16, WS_BK) + (size_t)t * 512 + c, v);
    } else if constexpr (KIND == K_BV) {
        store8c(WSP(bf16, WS_BV) + (size_t)t * 512 + c, v);
    } else if constexpr (KIND == K_CQ) {
#pragma unroll
        for (int j = 0; j < 8; ++j) v[j] *= SQ128;
        store8(WSP(bf16, WS_QC) + (size_t)t * 1024 + c, v);
    } else if constexpr (KIND == K_CG) {
#pragma unroll
        for (int j = 0; j < 8; ++j) v[j] = silu_f(v[j]);
        store8(WSP(bf16, WS_QC) + (size_t)t * 1024 + 512 + c, v);
    } else if constexpr (KIND == K_IQ) {
        if ((c & 31) < 8) rope8_32(v, tab32);
        store8(WSP(bf16, WS_IQ) + (size_t)t * 256 + c, v);
    } else if constexpr (KIND == K_MG) {
#pragma unroll
        for (int j = 0; j < 8; ++j) v[j] = __builtin_amdgcn_rcpf(1.f + __builtin_amdgcn_exp2f(-LOG2E * v[j]));
        const int br = c >> 10, col = c & 1023, pm_ = t >> 8, r_ = t & 255, cc_ = col & 255;
        const int ix_ = (r_ >> 7) * 8 + (cc_ >> 7) * 4 + ((r_ >> 4) & 3), wv_ = ((r_ >> 6) & 1) * 4 + ((cc_ >> 5) & 3), ln_ = ((cc_ >> 3) & 3) * 16 + (r_ & 15);
        const size_t tl_ = (size_t)(pm_ * 4 + (col >> 8)) * 8 + wv_;
        if (br == 1) store8(WSP(bf16, WS_GB) + (tl_ * 16384 + (size_t)(ix_ * 64 + ln_) * 16) / 2, v);
        else { unsigned long long w = 0;
#pragma unroll
            for (int j = 0; j < 8; ++j) w |= (unsigned long long)(unsigned)__builtin_rintf(v[j] * 255.f) << (8 * j);
            const size_t o_ = tl_ * 8192 + (size_t)((ix_ >> 1) * 64 + ln_) * 16 + (ix_ & 1) * 8;
            unsigned char* gp = br == 0 ? WSP(unsigned char, WS_GA) + o_ : (t < GC_SPLIT ? WSP(unsigned char, WS_GC) + o_ : WSP(unsigned char, WS_GC2) + (o_ - (size_t)GC_SPLIT * 1024));
            __builtin_nontemporal_store(w, (unsigned long long*)gp); }
    } else {
        if (c < 64) { if (c < 16) rope8_64(v, tab64, c >> 1); store8c(WSP(bf16, WS_AK) + (size_t)t * 64 + c, v); }
        else if (c < 128) { store8c(WSP(bf16, WS_AV) + (size_t)t * 64 + (c - 64), v); }
        else if (c < 160) { const int w = c - 128; if (w < 8) rope8_32(v, tab32); store8c(WSP(bf16, WS_IK) + (size_t)t * 32 + w, v); }
        else if (c == 160) { float* o = WSP(float, WS_IW) + (size_t)t * 8; *(f32x4*)o = (f32x4){v[0] * 0.0625f, v[1] * 0.0625f, v[2] * 0.0625f, v[3] * 0.0625f}; *(f32x4*)(o + 4) = (f32x4){v[4] * 0.0625f, v[5] * 0.0625f, v[6] * 0.0625f, v[7] * 0.0625f}; }
    }
}
__device__ __forceinline__ void inproj_emit8(const Bufs& B, int t, int p0, float* v) {
    const int tile = p0 >> 8, c = (tile < 16) ? (p0 & 511) : (tile < 18 ? (p0 & 255) : p0 - 4608);
    switch (kind_of_tile(tile)) {
    case K_AQ: emit8k<K_AQ>(B, t, c, v); break;  case K_AG: emit8k<K_AG>(B, t, c, v); break;
    case K_BQ: emit8k<K_BQ>(B, t, c, v); break;  case K_BK: emit8k<K_BK>(B, t, c, v); break;
    case K_BV: emit8k<K_BV>(B, t, c, v); break;  case K_BG: emit8k<K_BG>(B, t, c, v); break;
    case K_CQ: emit8k<K_CQ>(B, t, c, v); break;  case K_CG: emit8k<K_CG>(B, t, c, v); break;
    case K_IQ: emit8k<K_IQ>(B, t, c, v); break;  case K_MG: emit8k<K_MG>(B, t, c, v); break;  default:   emit8k<K_MISC>(B, t, c, v); break;
    }
}
__device__ __forceinline__ float wsrc(const Bufs& B, int kind, int k, int n) {
    switch (kind) {
    case 0: { const int o = orig_of_pos(n); return o < 0 ? 0.f : __builtin_nontemporal_load(B.w_in + (size_t)k * IN_WIDTH + o); }
    case 1: return __builtin_nontemporal_load(B.w_in + (size_t)k * IN_WIDTH + O_MG + n);
    case 2: return __builtin_nontemporal_load(B.w_mem_kv + (size_t)k * 1024 + n);
    case 3: return k < 512 ? __builtin_nontemporal_load(B.w_proj_a + (size_t)k * 1024 + n) : __builtin_nontemporal_load(B.w_proj_b + (size_t)(k - 512) * 1024 + n);
    case 4: return k < 512 ? __builtin_nontemporal_load(B.w_proj_c + (size_t)k * 1024 + n) : 0.f;
    default: return __builtin_nontemporal_load(B.w_out + (size_t)k * 1024 + n);
    }
}

namespace pg8 {
#define PG8_LAS __attribute__((address_space(3)))
typedef unsigned short bf16_t;
typedef short bf16x8 __attribute__((ext_vector_type(8)));
typedef float f32x4 __attribute__((ext_vector_type(4)));
typedef unsigned u32x4 __attribute__((ext_vector_type(4)));
constexpr int BM = 256, BK = 64, HALF = 128, HTB = HALF * BK * 2, STAGE_BYTES = 8 * HTB, NXCD = 8, WGM = 8, KP = 1024;
constexpr size_t TSTEP = (size_t)BM * KP * 2;

__host__ __device__ __forceinline__ int lds_byte(int r, int c) { const int st = (r >> 4) * 2 + (c >> 5), rr = r & 15, cc = c & 31, ob = rr * 64 + cc * 2; return st * 1024 + (ob ^ (((ob >> 9) & 1) << 5)); }
__host__ __device__ __forceinline__ void stage_rc(int b, int& R, int& C) { const int st = b / 1024, sb = b % 1024, swz = sb ^ (((sb >> 9) & 1) << 5); R = (st >> 1) * 16 + swz / 64; C = (st & 1) * 32 + (swz % 64) / 2; }
__host__ __device__ __forceinline__ int perm32(int rho) { const int n = rho >> 4, i = rho & 15; return 8 * (i >> 2) + 4 * n + (i & 3); }

struct Unit { int pm, pn; const char* A; const char* B; int nt; int kind; int keep; int pad; };

struct TileOrder {
    int nM, nN, nwg;
    __host__ __device__ void init(int nM_, int nN_) { nM = nM_; nN = nN_; nwg = nM * nN; }
    __host__ __device__ void tile(int L, int& pm, int& pn) const {
        int wgid = L; { const int q = nwg / NXCD, r = nwg % NXCD, xcd = wgid % NXCD, off = wgid / NXCD; wgid = (xcd < r ? xcd * (q + 1) : r * (q + 1) + (xcd - r) * q) + off; }
        const int nig = WGM * nN, gid = wgid / nig, fm = gid * WGM, gsz = (nM - fm) < WGM ? (nM - fm) : WGM;
        pm = fm + ((wgid % nig) % gsz); pn = (wgid % nig) / gsz;
    }
};
__device__ __forceinline__ unsigned cvt_pk_bf16(float lo, float hi) { unsigned r; asm volatile("v_cvt_pk_bf16_f32 %0, %1, %2" : "=v"(r) : "v"(lo), "v"(hi)); return r; }

template <class Epi, class Sched, bool ALIGN_EPI = false, bool SP2 = false>
__device__ __forceinline__ void gemm_phase(PG8_LAS unsigned char* lds, const Sched& S, const Epi& E) {
    int tid_ = threadIdx.x; asm volatile("" : "+v"(tid_));
    const int tid = tid_, wid = __builtin_amdgcn_readfirstlane(tid >> 6), lane = tid & 63, wr = wid >> 2, wc = wid & 3, fr = lane & 15, fq = lane >> 4;
    constexpr int K = KP; int nt;
    unsigned voffA[2], voffB[2];
#pragma unroll
    for (int i = 0; i < 2; ++i) { int R, C; stage_rc(tid * 16 + i * 8192, R, C); const int Rb = Epi::PERM ? ((R & ~31) + perm32(R & 31)) : R;
        voffA[i] = (unsigned)(R * K + C) * 2u; voffB[i] = (unsigned)(Rb * K + C) * 2u; }
    const size_t kstep = (size_t)(BK * 2);
    const size_t hstep = (size_t)HALF * K * 2;
    const size_t tstep = 2 * hstep;
    const unsigned ldsw = (unsigned)wid * 1024u;
    const int aoff = lds_byte(wr * 64 + fr, fq * 8), boff = lds_byte(wc * 32 + fr, fq * 8);
#define PG8_SA(b, h) (((b) * 2 + (h)) * HTB)
#define PG8_SB(b, h) ((4 + (b) * 2 + (h)) * HTB)
#define PG8_STAGE(bufoff, gbase, voff) do { _Pragma("unroll") for (int _i = 0; _i < 2; ++_i) \
        __builtin_amdgcn_global_load_lds((const unsigned*)((const char*)(gbase) + (voff)[_i]), (PG8_LAS unsigned*)(lds + (bufoff) + ldsw + _i * 8192), 16, 0, 0); } while (0)
#define PG8_LDA(dst, b, h) do { _Pragma("unroll") for (int m = 0; m < 4; ++m) _Pragma("unroll") for (int k = 0; k < 2; ++k) dst[m][k] = *(const PG8_LAS bf16x8*)(lds + PG8_SA(b, h) + aoff + m * 2048 + k * 1024); } while (0)
#define PG8_LDB(dst, b, h) do { _Pragma("unroll") for (int n = 0; n < 2; ++n) _Pragma("unroll") for (int k = 0; k < 2; ++k) dst[n][k] = *(const PG8_LAS bf16x8*)(lds + PG8_SB(b, h) + boff + n * 2048 + k * 1024); } while (0)
#define PG8_MMA(ai, bj, At, Bt) do { __builtin_amdgcn_s_setprio(1); _Pragma("unroll") for (int m = 0; m < 4; ++m) _Pragma("unroll") for (int n = 0; n < 2; ++n) _Pragma("unroll") for (int k = 0; k < 2; ++k) \
        acc[ai][bj][m][n] = __builtin_amdgcn_mfma_f32_16x16x32_bf16(Bt[n][k], At[m][k], acc[ai][bj][m][n], 0, 0, 0); __builtin_amdgcn_s_setprio(0); } while (0)
#define PG8_WAIT_V(n) asm volatile("s_waitcnt vmcnt(" #n ")" ::: "memory")
#define PG8_WAIT_L(n) asm volatile("s_waitcnt lgkmcnt(" #n ")" ::: "memory")
#define PG8_BAR __builtin_amdgcn_s_barrier()
#define PG8_SCHED __builtin_amdgcn_sched_barrier(0)
    Unit cur, nxt; int ui = 0;
    if (!S.next(0, cur)) return;
    f32x4 acc[2][2][4][2];
#pragma unroll
    for (int a = 0; a < 2; ++a)
#pragma unroll
        for (int b = 0; b < 2; ++b)
#pragma unroll
            for (int m = 0; m < 4; ++m)
#pragma unroll
                for (int n = 0; n < 2; ++n) acc[a][b][m][n] = (f32x4){0.f, 0.f, 0.f, 0.f};
    bf16x8 At[4][2], B0[2][2], B1[2][2];
    const char* cA = cur.A; const char* cB = cur.B; nt = cur.nt;
    S.a_ready(cur);
    if constexpr (SP2) {
        PG8_STAGE(PG8_SB(0, 0), cB, voffB); PG8_STAGE(PG8_SB(0, 1), cB + hstep, voffB); PG8_STAGE(PG8_SA(0, 0), cA, voffA); PG8_STAGE(PG8_SA(0, 1), cA + hstep, voffA);
        if (wr == 1) PG8_BAR;
        PG8_WAIT_V(2); PG8_BAR;
        PG8_STAGE(PG8_SB(1, 0), cB + kstep, voffB); PG8_STAGE(PG8_SA(1, 0), cA + kstep, voffA); PG8_STAGE(PG8_SB(1, 1), cB + hstep + kstep, voffB);
        PG8_WAIT_V(6); PG8_BAR;
    } else {
        PG8_STAGE(PG8_SB(0, 0), cB, voffB); PG8_STAGE(PG8_SA(0, 0), cA, voffA); PG8_STAGE(PG8_SB(0, 1), cB + hstep, voffB); PG8_STAGE(PG8_SA(0, 1), cA + hstep, voffA);
        if (wr == 1) PG8_BAR;
        PG8_WAIT_V(4); PG8_BAR;
        PG8_STAGE(PG8_SB(1, 0), cB + kstep, voffB); PG8_STAGE(PG8_SA(1, 0), cA + kstep, voffA); PG8_STAGE(PG8_SB(1, 1), cB + hstep + kstep, voffB);
        PG8_WAIT_V(6); PG8_BAR;
    }
    for (;;) {
        const bool has_next = S.next(ui + 1, nxt);
        const char* nA = has_next ? nxt.A : cA; const char* nB = has_next ? nxt.B : cB;
        for (int t = 0; t < nt; t += 2) {
            const bool last = (t == nt - 2);
            const char* a1 = cA + (size_t)(t + 1) * kstep;
            const char* a2 = last ? nA : cA + (size_t)(t + 2) * kstep; const char* b2 = last ? nB : cB + (size_t)(t + 2) * kstep;
            const char* a3 = a2 + kstep; const char* b3 = b2 + kstep;
            if (last && has_next) S.a_ready(nxt);
            if constexpr (SP2) {
            PG8_LDB(B0, 0, 0); PG8_LDB(B1, 0, 1); PG8_SCHED; PG8_LDA(At, 0, 0); PG8_STAGE(PG8_SA(1, 1), a1 + hstep, voffA);
            PG8_WAIT_V(8); PG8_WAIT_L(0); PG8_BAR; PG8_MMA(0, 0, At, B0); PG8_MMA(0, 1, At, B1); PG8_BAR; PG8_SCHED;
            PG8_LDA(At, 0, 1); PG8_STAGE(PG8_SB(0, 0), b2, voffB); PG8_STAGE(PG8_SB(0, 1), b2 + hstep, voffB); PG8_STAGE(PG8_SA(0, 0), a2, voffA);
            PG8_WAIT_V(8); PG8_WAIT_L(0); PG8_BAR; PG8_MMA(1, 0, At, B0); PG8_MMA(1, 1, At, B1); PG8_BAR; PG8_SCHED;
            PG8_LDB(B0, 1, 0); PG8_LDB(B1, 1, 1); PG8_SCHED; PG8_LDA(At, 1, 0); PG8_STAGE(PG8_SA(0, 1), a2 + hstep, voffA);
            PG8_WAIT_V(8); PG8_WAIT_L(0); PG8_BAR; PG8_MMA(0, 0, At, B0); PG8_MMA(0, 1, At, B1); PG8_BAR; PG8_SCHED;
            PG8_LDA(At, 1, 1); PG8_STAGE(PG8_SB(1, 0), b3, voffB); PG8_STAGE(PG8_SB(1, 1), b3 + hstep, voffB); PG8_STAGE(PG8_SA(1, 0), a3, voffA);
            PG8_WAIT_V(8); PG8_WAIT_L(0); PG8_BAR; PG8_MMA(1, 0, At, B0); PG8_MMA(1, 1, At, B1); PG8_BAR; PG8_SCHED;
            } else {
            PG8_LDB(B0, 0, 0); PG8_SCHED; PG8_LDA(At, 0, 0); PG8_STAGE(PG8_SA(1, 1), a1 + hstep, voffA);
            PG8_WAIT_L(8); PG8_BAR; PG8_WAIT_L(0); PG8_MMA(0, 0, At, B0); PG8_BAR; PG8_SCHED;
            PG8_LDB(B1, 0, 1); PG8_STAGE(PG8_SB(0, 0), b2, voffB);
            PG8_BAR; PG8_WAIT_L(0); PG8_MMA(0, 1, At, B1); PG8_BAR;
            PG8_LDA(At, 0, 1); PG8_STAGE(PG8_SA(0, 0), a2, voffA);
            PG8_BAR; PG8_WAIT_L(0); PG8_MMA(1, 0, At, B0); PG8_BAR; PG8_SCHED;
            PG8_STAGE(PG8_SB(0, 1), b2 + hstep, voffB);
            PG8_WAIT_V(6); PG8_BAR; PG8_MMA(1, 1, At, B1); PG8_BAR;
            PG8_LDB(B0, 1, 0); PG8_SCHED; PG8_LDA(At, 1, 0); PG8_STAGE(PG8_SA(0, 1), a2 + hstep, voffA);
            PG8_WAIT_L(8); PG8_BAR; PG8_WAIT_L(0); PG8_MMA(0, 0, At, B0); PG8_BAR; PG8_SCHED;
            PG8_LDB(B1, 1, 1); PG8_STAGE(PG8_SB(1, 0), b3, voffB);
            PG8_BAR; PG8_WAIT_L(0); PG8_MMA(0, 1, At, B1); PG8_BAR;
            PG8_LDA(At, 1, 1); PG8_STAGE(PG8_SA(1, 0), a3, voffA);
            PG8_BAR; PG8_WAIT_L(0); PG8_MMA(1, 0, At, B0); PG8_BAR; PG8_SCHED;
            PG8_STAGE(PG8_SB(1, 1), b3 + hstep, voffB);
            PG8_WAIT_V(6); PG8_BAR; PG8_MMA(1, 1, At, B1); PG8_BAR;
            }
        }
        if constexpr (ALIGN_EPI) { if (wr == 0) PG8_BAR; }
        if constexpr (!Epi::AFTER_DRAIN) { E(acc, cur, wr, wc, fr, fq); S.done(cur); }
        if (!has_next) break;
        if (!cur.keep) {
#pragma unroll
        for (int a = 0; a < 2; ++a)
#pragma unroll
            for (int b = 0; b < 2; ++b)
#pragma unroll
                for (int m = 0; m < 4; ++m)
#pragma unroll
                    for (int n = 0; n < 2; ++n) acc[a][b][m][n] = (f32x4){0.f, 0.f, 0.f, 0.f};
        }
        cur = nxt; cA = nA; cB = nB; nt = cur.nt; ++ui;
        if constexpr (ALIGN_EPI) { if (wr == 1) PG8_BAR; }
    }
    PG8_WAIT_V(0);
    if constexpr (!ALIGN_EPI) { if (wr == 0) PG8_BAR; }
    PG8_BAR;
    if constexpr (Epi::AFTER_DRAIN) { E.fused(acc, cur, wr, wc, fr, fq, lds, wid, lane); S.done(cur); }
#undef PG8_SA
#undef PG8_SB
#undef PG8_STAGE
#undef PG8_LDA
#undef PG8_LDB
#undef PG8_MMA
#undef PG8_WAIT_V
#undef PG8_WAIT_L
#undef PG8_BAR
#undef PG8_SCHED
}
}

#define GAS __attribute__((address_space(1)))
#define LAS __attribute__((address_space(3)))
typedef GAS unsigned gu32;
#define RLX_AGENT __ATOMIC_RELAXED, __HIP_MEMORY_SCOPE_AGENT
#define LDS_WAIT() asm volatile("s_waitcnt lgkmcnt(0)" ::: "memory")
#define VM_WAIT() asm volatile("s_waitcnt vmcnt(0)" ::: "memory")
#define XB_TMO      128
#define XB_XCNT(j)  (256  + 64 * (j))
#define XB_XSUB(j)  (1280 + 64 * (j))
#define XB_XGEN(j)  (2304 + 64 * (j))
#define XB_TOP      3328
#define XB_TOPGEN   3392
#define XCD_BAR_WORDS 3456
#define XB_SPIN_CAP (1u << 20)
__device__ __forceinline__ unsigned xb_ld(unsigned* p)              { return __hip_atomic_load(p, __ATOMIC_RELAXED, __HIP_MEMORY_SCOPE_AGENT); }
__device__ __forceinline__ unsigned xb_add(unsigned* p, unsigned v) { return __hip_atomic_fetch_add(p, v, __ATOMIC_RELAXED, __HIP_MEMORY_SCOPE_AGENT); }
__device__ __forceinline__ unsigned xb_xcc_id() { return (unsigned)__builtin_amdgcn_s_getreg((3 << 11) | 20) & 0xFu; }
#define XB_SPIN(cond, bar) do { unsigned _sp = 0; while (cond) { __builtin_amdgcn_s_sleep(1); \
    if ((++_sp & 255u) == 0u) { if (xb_ld(&(bar)[XB_TMO])) break; if (_sp > XB_SPIN_CAP) { atomicAdd(&(bar)[XB_TMO], 1u); break; } } } } while (0)
struct XcdBarrier { unsigned* bar; unsigned x; volatile LAS unsigned* st; };
__device__ __forceinline__ XcdBarrier xcd_barrier_post(unsigned* bar, volatile LAS unsigned* st) {
    XcdBarrier b; b.bar = bar; b.x = xb_xcc_id(); b.st = st;
    if (threadIdx.x == 0) (void)xb_add(&bar[XB_XCNT(b.x)], 1u);
    return b;
}
__device__ __forceinline__ void xcd_barrier_complete(unsigned* bar, unsigned x, unsigned& nloc, unsigned& nx) {
    const unsigned G = gridDim.x * gridDim.y * gridDim.z;
    unsigned sum, cnt, mine, sp = 0u;
    for (;;) {
        sum = 0u; cnt = 0u; mine = 0u;
#pragma unroll
        for (unsigned j = 0; j < 16; ++j) { const unsigned c = xb_ld(&bar[XB_XCNT(j)]); sum += c; cnt += (c > 0u) ? 1u : 0u; mine = (j == x) ? c : mine; }
        if (sum == G) break;
        __builtin_amdgcn_s_sleep(1);
        if ((++sp & 255u) == 0u) { if (xb_ld(&bar[XB_TMO])) break; if (sp > XB_SPIN_CAP) { atomicAdd(&bar[XB_TMO], 1u); break; } }
    }
    nloc = mine > 0u ? mine : 1u; nx = cnt > 0u ? cnt : 1u;
}
__device__ __forceinline__ void xcd_barrier(const XcdBarrier& b) {
    asm volatile("s_waitcnt vmcnt(0)" ::: "memory");
    __syncthreads();
    if (threadIdx.x == 0) {
        unsigned* bar = b.bar;
        __builtin_amdgcn_s_waitcnt(0);
        unsigned nloc = b.st[0], nx = b.st[1];
        if (nloc == 0u) { xcd_barrier_complete(bar, b.x, nloc, nx); b.st[0] = nloc; b.st[1] = nx; }
        const unsigned old = xb_add(&bar[XB_XSUB(b.x)], 1u);
        const unsigned gen = old / nloc;
        if (old + 1u == (gen + 1u) * nloc) {
            __builtin_amdgcn_fence(__ATOMIC_RELEASE, "agent");
            asm volatile("s_waitcnt vmcnt(0)" ::: "memory");
            const unsigned og = xb_add(&bar[XB_TOP], 1u);
            const unsigned tg = og / nx;
            if (og + 1u == (tg + 1u) * nx) xb_add(&bar[XB_TOPGEN], 1u);
            else XB_SPIN(xb_ld(&bar[XB_TOPGEN]) == tg, bar);
            __builtin_amdgcn_fence(__ATOMIC_ACQUIRE, "agent");
            xb_add(&bar[XB_XGEN(b.x)], 1u);
            asm volatile("s_waitcnt vmcnt(0)" ::: "memory");
        } else {
            XB_SPIN(xb_ld(&bar[XB_XGEN(b.x)]) == gen, bar);
            __builtin_amdgcn_fence(__ATOMIC_ACQUIRE, "agent");
            asm volatile("s_waitcnt vmcnt(0)" ::: "memory");
        }
    }
    __syncthreads();
}

constexpr int NWAVES = 8;
constexpr int RING_OFF = 0, RING_BYTES = 131072;
constexpr int LDSCTL_OFF = RING_BYTES, MISC_OFF = LDSCTL_OFF + 320;
constexpr int LDS_BYTES = 147456;
constexpr int CW_TMO = 0, CW_CODE = 1, CW_BAR = 4096, CW_QUEUE = 8192, CW_MKV = 10240, CW_TIME = 12288, CW_SEAM = 16384;
constexpr size_t CTL_ZERO_BYTES = 1 * MiB;

struct Frame {
    LAS unsigned char* lds; volatile LAS unsigned* MISC; unsigned* ctl;
    int tid, lane, wave, vcu, G;
    unsigned long long tprev;
    Bufs B;
};

__device__ __forceinline__ void p0_transpose_item(const Bufs& B, int kind, int N, size_t dst_off, LAS float* scr, int item, int lane) {
    const int nblk = N / 32, kb = item / nblk, nb = item % nblk, k0 = 64 * kb, n0 = 32 * nb;
#pragma unroll
    for (int h = 0; h < 2; ++h) { float tv[16];
#pragma unroll
        for (int i = 0; i < 16; ++i) tv[i] = wsrc(B, kind, k0 + 2 * (16 * h + i) + (lane >> 5), n0 + (lane & 31));
#pragma unroll
        for (int i = 0; i < 16; ++i) scr[(2 * (16 * h + i) + (lane >> 5)) * 33 + (lane & 31)] = tv[i]; }
    LDS_WAIT(); asm volatile("" ::: "memory");
    const int c = lane & 7; bf16* WT = WSP(bf16, dst_off);
#pragma unroll
    for (int j = 0; j < 4; ++j) { const int n = (lane >> 3) + 8 * j; const LAS float* s = scr + (8 * c) * 33 + n;
        v4u o; o.x = pk2(s[0 * 33], s[1 * 33]); o.y = pk2(s[2 * 33], s[3 * 33]); o.z = pk2(s[4 * 33], s[5 * 33]); o.w = pk2(s[6 * 33], s[7 * 33]);
        *(v4u*)(WT + (size_t)(n0 + n) * 1024 + k0 + 8 * c) = o; }
    LDS_WAIT(); asm volatile("" ::: "memory");
}
__device__ __forceinline__ float wave_sum(float v) {
#pragma unroll
    for (int o = 1; o < 64; o <<= 1) v += __shfl_xor(v, o);
    return v;
}
__device__ __forceinline__ void ln_in_rows(const Bufs& B, int gw, int NGW, int lane) {
    f32x4 v[4], nx[4];
    if (gw < M) { const f32x4* xr = (const f32x4*)(B.x + (size_t)gw * D) + lane;
#pragma unroll
        for (int j = 0; j < 4; ++j) v[j] = __builtin_nontemporal_load(xr + 64 * j); }
    f32x4 g[4], b[4];
#pragma unroll
    for (int j = 0; j < 4; ++j) { g[j] = *((const f32x4*)B.ln_in_g + lane + 64 * j); b[j] = *((const f32x4*)B.ln_in_b + lane + 64 * j); }
    for (int row = gw; row < M; row += NGW) {
        const int nr = row + NGW;
        if (nr < M) { const f32x4* xr = (const f32x4*)(B.x + (size_t)nr * D) + lane;
#pragma unroll
            for (int j = 0; j < 4; ++j) nx[j] = __builtin_nontemporal_load(xr + 64 * j); }
        float s = 0.f;
#pragma unroll
        for (int j = 0; j < 4; ++j) s += (v[j].x + v[j].y) + (v[j].z + v[j].w);
        const float mean = wave_sum(s) * (1.f / D); float s2 = 0.f;
#pragma unroll
        for (int j = 0; j < 4; ++j) { v[j] = v[j] - mean; s2 += (v[j].x * v[j].x + v[j].y * v[j].y) + (v[j].z * v[j].z + v[j].w * v[j].w); }
        const float rstd = rsqrtf(wave_sum(s2) * (1.f / D) + LN_EPS);
        if (lane == 0) { float* st = WSP(float, WS_STATS) + (size_t)row * 2; st[0] = mean; st[1] = rstd; }
        unsigned long long* o8 = (unsigned long long*)(WSP(bf16, WS_XN) + (size_t)row * D) + lane;
#pragma unroll
        for (int j = 0; j < 4; ++j) { const f32x4 y = v[j] * rstd * g[j] + b[j];
            o8[64 * j] = (unsigned long long)pk2(y.x, y.y) | ((unsigned long long)pk2(y.z, y.w) << 32); }
#pragma unroll
        for (int j = 0; j < 4; ++j) v[j] = nx[j];
    }
}
__device__ __forceinline__ void p0_prologue(Frame& F) {
    const Bufs& B = F.B;
    LAS float* scr = (LAS float*)(F.lds + RING_OFF + F.wave * 16384);
    const int gw = F.vcu * NWAVES + F.wave, NGW = F.G * NWAVES;
    constexpr int I0 = 16 * (NPOS / 32), I2 = 16 * 32;
    constexpr int NITEMS = I0 + 4 * I2;
    for (int it = gw; it < NITEMS; it += NGW) {
        int r = it;
        if (r < I0) { p0_transpose_item(B, 0, NPOS, WS_WIN, scr, r, (int)(threadIdx.x & 63u)); continue; } r -= I0;
        if (r < I2) { p0_transpose_item(B, 2, 1024, WS_WMEM, scr, r, (int)(threadIdx.x & 63u)); continue; } r -= I2;
        if (r < I2) { p0_transpose_item(B, 3, 1024, WS_WAB, scr, r, (int)(threadIdx.x & 63u)); continue; } r -= I2;
        if (r < I2) { p0_transpose_item(B, 4, 1024, WS_WC, scr, r, (int)(threadIdx.x & 63u)); continue; } r -= I2;
        p0_transpose_item(B, 5, 1024, WS_WOUT, scr, r, (int)(threadIdx.x & 63u));
    }
    ln_in_rows(B, gw, NGW, (int)(threadIdx.x & 63u));
    const int gid = gw * 64 + (int)(threadIdx.x & 63u), nth = NGW * 64;
    for (int i = gid; i < MM * D / 4; i += nth) { const f32x4 v = __builtin_nontemporal_load((const f32x4*)B.mem + i); ((unsigned long long*)WSP(bf16, WS_MEMB))[i] = (unsigned long long)pk2(v.x, v.y) | ((unsigned long long)pk2(v.z, v.w) << 32); }
    for (int i = gid; i < SEQ * 8; i += nth) { const int pos = i >> 3, f = i & 7;
        const float inv = powf(500000.0f, -(float)f * 0.125f); const float ang = (float)pos * inv;
        float* t64 = WSP(float, WS_TAB) + pos * 16; t64[f] = cosf(ang); t64[8 + f] = sinf(ang);
        if ((f & 1) == 0) { float* t32 = WSP(float, WS_TAB32) + pos * 8; t32[f >> 1] = cosf(ang); t32[4 + (f >> 1)] = sinf(ang); } }
    if (gid == 0) { float a = 0.f, b = 0.f; for (int i = 0; i < 64; ++i) { a += B.diff_lambda[i] * B.diff_lambda[64 + i]; b += B.diff_lambda[128 + i] * B.diff_lambda[192 + i]; }
        *WSP(float, WS_LAM) = expf(a) - expf(b) + LAM_INIT; }
}

struct SchedOne {
    int pm, pn; const char* MEMB; const char* WMEM;
    __device__ __forceinline__ bool next(int i, pg8::Unit& u) const {
        if (i > 0) return false;
        u.pm = pm; u.pn = pn; u.A = MEMB + (size_t)pm * pg8::TSTEP; u.B = WMEM + (size_t)pn * pg8::TSTEP; u.nt = 16; u.kind = 1; u.keep = 0; return true;
    }
    __device__ __forceinline__ void a_ready(const pg8::Unit&) const {}
    __device__ __forceinline__ void done(const pg8::Unit&) const {}
};
struct SchedIn {
    pg8::TileOrder T; int G, c; const char* XN; const char* WIN; const char* MEMB; const char* WMEM;
    __device__ __forceinline__ bool next(int i, pg8::Unit& u) const {
        const int L = i * G + c;
        if (L < T.nwg) { T.tile(L, u.pm, u.pn); u.A = XN + (size_t)u.pm * pg8::TSTEP; u.B = WIN + (size_t)u.pn * pg8::TSTEP; u.nt = 16; u.kind = 0; u.keep = 0; return true; }
        return false;
    }
    __device__ __forceinline__ void a_ready(const pg8::Unit&) const {}
    __device__ __forceinline__ void done(const pg8::Unit&) const {}
};
template <int KIND> __device__ __forceinline__ void epi_in_loops(const Bufs& B, const pg8::f32x4 (&acc)[2][2][4][2], int row0, int c0) {
#pragma unroll
    for (int ai = 0; ai < 2; ++ai)
#pragma unroll
        for (int m = 0; m < 4; ++m)
#pragma unroll
            for (int bj = 0; bj < 2; ++bj) {
                float v[8] = {acc[ai][bj][m][0][0], acc[ai][bj][m][0][1], acc[ai][bj][m][0][2], acc[ai][bj][m][0][3], acc[ai][bj][m][1][0], acc[ai][bj][m][1][1], acc[ai][bj][m][1][2], acc[ai][bj][m][1][3]};
                const int row = row0 + ai * 128 + m * 16, c = c0 + bj * 128;
                if constexpr (KIND == 100) store8(WSP(bf16, WS_MKV) + (size_t)row * 1024 + c, v);
                else emit8k<KIND>(B, row, c, v);
            }
}
struct EpiIn {
    static constexpr bool PERM = true, AFTER_DRAIN = false; Bufs B;
    __device__ __forceinline__ void operator()(const pg8::f32x4 (&acc)[2][2][4][2], const pg8::Unit& u, int wr, int wc, int fr, int fq) const {
        const int row0 = u.pm * 256 + wr * 64 + fr, cw = wc * 32 + 8 * fq;
        if (u.kind == 1) { epi_in_loops<100>(B, acc, row0, u.pn * 256 + cw); return; }
        const int c0 = (u.pn < 16 ? (u.pn & 1) * 256 : (u.pn < 18 ? 0 : (u.pn - 18) * 256)) + cw;
        switch (kind_of_tile(u.pn)) {
        case K_AQ: epi_in_loops<K_AQ>(B, acc, row0, c0); break;  case K_AG: epi_in_loops<K_AG>(B, acc, row0, c0); break;
        case K_BQ: epi_in_loops<K_BQ>(B, acc, row0, c0); break;  case K_BK: epi_in_loops<K_BK>(B, acc, row0, c0); break;
        case K_BV: epi_in_loops<K_BV>(B, acc, row0, c0); break;  case K_BG: epi_in_loops<K_BG>(B, acc, row0, c0); break;
        case K_CQ: epi_in_loops<K_CQ>(B, acc, row0, c0); break;  case K_CG: epi_in_loops<K_CG>(B, acc, row0, c0); break;
        case K_IQ: epi_in_loops<K_IQ>(B, acc, row0, c0); break;  case K_MG: epi_in_loops<K_MG>(B, acc, row0, c0); break;  default:   epi_in_loops<K_MISC>(B, acc, row0, c0); break;
        }
    }
};

#ifndef PROBE_DRY
#define PROBE_DRY 0
#endif
#ifndef PROBE_DMODE
#define PROBE_DMODE 1
#endif
#ifndef FAST_A
#define FAST_A 1
#endif
#ifndef FAST_B
#define FAST_B 1
#endif
#ifndef FAST_C
#define FAST_C 1
#endif
#ifndef TIMING_SEL
#define TIMING_SEL -1
#endif
#define TIMING (TIMING_SEL >= 0)
#define TST(k) do { if (TIMING && threadIdx.x == 0) { const unsigned now_ = (unsigned)__builtin_amdgcn_s_memrealtime(); F.MISC[16 + (k)] += now_ - F.MISC[14]; F.MISC[14] = now_; } } while (0)
namespace att {
typedef short bf16x8 __attribute__((ext_vector_type(8)));
typedef short v4i16_t __attribute__((ext_vector_type(4)));
typedef float f32x16 __attribute__((ext_vector_type(16)));
constexpr int L_K = 0, L_V = 32768, L_MASK = 131072 + 1024, L_X = 65536, L_NG = 141312;
constexpr float NEG_BIG = -1.0e30f;

__device__ __forceinline__ float hswap_max(float v) { auto rr = __builtin_amdgcn_permlane32_swap(__float_as_uint(v), __float_as_uint(v), false, false); return fmaxf(__uint_as_float(rr[0]), __uint_as_float(rr[1])); }
__device__ __forceinline__ float hswap_sum(float v) { auto rr = __builtin_amdgcn_permlane32_swap(__float_as_uint(v), __float_as_uint(v), false, false); return __uint_as_float(rr[0]) + __uint_as_float(rr[1]); }
__device__ __forceinline__ unsigned cvtpk(float lo, float hi) { typedef float f2 __attribute__((ext_vector_type(2))); typedef __bf16 b2 __attribute__((ext_vector_type(2))); f2 v = {lo, hi}; b2 b = __builtin_convertvector(v, b2); return __builtin_bit_cast(unsigned, b); }

template <int DQK, int DV> struct WState { bf16x8 qf[DQK / 16]; f32x16 o[DV / 32]; float m, l; };

template <int KPB> __device__ __forceinline__ int ksw(int row) { return KPB == 128 ? ((row >> 1) & 7) : (row & 15); }
template <int KPB, int DV> struct Stage {
    static constexpr int NK = KPB / 128, NV = DV / 64;
    v4u kr[NK], vr[NV];
    __device__ __forceinline__ void load(const char* kg, size_t kpitch, const char* vg, size_t vpitch, int key0, int tid) {
#pragma unroll
        for (int i = 0; i < NK; ++i) { const int idx = tid + 512 * i, key = idx / (KPB / 16), ch = idx % (KPB / 16); kr[i] = *(const v4u*)(kg + (size_t)(key0 + key) * kpitch + ch * 16); }
#pragma unroll
        for (int i = 0; i < NV; ++i) { const int idx = tid + 512 * i, key = idx / (DV / 8), ch = idx % (DV / 8); vr[i] = *(const v4u*)(vg + (size_t)(key0 + key) * vpitch + ch * 16); }
    }
    __device__ __forceinline__ void store(LAS unsigned char* lds, int buf, int tid) const {
#pragma unroll
        for (int i = 0; i < NK; ++i) { const int idx = tid + 512 * i, key = idx / (KPB / 16), ch = idx % (KPB / 16); *(LAS v4u*)(lds + L_K + buf * 16384 + key * KPB + ((ch ^ ksw<KPB>(key)) << 4)) = kr[i]; }
#pragma unroll
        for (int i = 0; i < NV; ++i) { const int idx = tid + 512 * i, key = idx / (DV / 8), ch = idx % (DV / 8); *(LAS v4u*)(lds + L_V + buf * 16384 + (ch >> 2) * 4096 + key * 64 + (ch & 3) * 16) = vr[i]; }
    }
};

template <int DQK, int DV, int KPB, bool MASKED>
__device__ __forceinline__ void tile_compute(WState<DQK, DV>& W, LAS unsigned char* lds, int buf, int kc0, int lane, const LAS unsigned* mrow  , int koff = -1, int voff = -1) {
    const int r32 = lane & 31, hi = lane >> 5;
    const LAS unsigned char* kb = lds + (koff >= 0 ? koff : L_K + buf * 16384);
    const LAS unsigned char* vb = lds + (voff >= 0 ? voff : L_V + buf * 16384) + ((lane >> 4) & 1) * 32 + (lane & 3) * 8 + (4 * hi + ((lane & 15) >> 2)) * 64;
#pragma unroll
    for (int kh = 0; kh < 2; ++kh) {
        const int row = 32 * kh + r32;
        f32x16 s = {};
#pragma unroll
        for (int ks = 0; ks < DQK / 16; ++ks) {
            const bf16x8 kf = *(const LAS bf16x8*)(kb + row * KPB + (((kc0 + 2 * ks + hi) ^ ksw<KPB>(row)) << 4));
            s = __builtin_amdgcn_mfma_f32_32x32x16_bf16(kf, W.qf[ks], s, 0, 0, 0);
        }
        if constexpr (MASKED) {
            const unsigned wsh = mrow[kh] >> (4 * hi);
#pragma unroll
            for (int r = 0; r < 16; ++r) { const unsigned mm = (unsigned)__builtin_amdgcn_sbfe((int)wsh, (r & 3) + 8 * (r >> 2), 1); s[r] = __uint_as_float((__float_as_uint(s[r]) & mm) | (0xFF800000u & ~mm)); }
        }
        float mx = s[0];
#pragma unroll
        for (int r = 1; r < 16; ++r) mx = fmaxf(mx, s[r]);
        mx = hswap_max(mx);
        const float mn = fmaxf(W.m, mx), alpha = __builtin_amdgcn_exp2f(W.m - mn);
        W.m = mn;
        float ps = 0.f;
#pragma unroll
        for (int r = 0; r < 16; ++r) { s[r] = __builtin_amdgcn_exp2f(s[r] - mn); ps += s[r]; }
        W.l = W.l * alpha + ps;
        if (__any(alpha != 1.0f)) {
#pragma unroll
            for (int dt = 0; dt < DV / 32; ++dt)
#pragma unroll
                for (int r = 0; r < 16; ++r) W.o[dt][r] *= alpha;
        }
        v4u pw0, pw1;
        pw0.x = cvtpk(s[0], s[1]); pw0.y = cvtpk(s[2], s[3]); pw0.z = cvtpk(s[4], s[5]); pw0.w = cvtpk(s[6], s[7]);
        pw1.x = cvtpk(s[8], s[9]); pw1.y = cvtpk(s[10], s[11]); pw1.z = cvtpk(s[12], s[13]); pw1.w = cvtpk(s[14], s[15]);
        const bf16x8 pf0 = __builtin_bit_cast(bf16x8, pw0), pf1 = __builtin_bit_cast(bf16x8, pw1);
#pragma unroll
        for (int dt = 0; dt < DV / 32; ++dt) {
#pragma unroll
            for (int sidx = 0; sidx < 2; ++sidx) {
                const LAS unsigned char* p = vb + dt * 4096 + (32 * kh + 16 * sidx) * 64;
                const v4i16_t lo = __builtin_amdgcn_ds_read_tr16_b64_v4i16((LAS v4i16_t*)p);
                const v4i16_t hh = __builtin_amdgcn_ds_read_tr16_b64_v4i16((LAS v4i16_t*)(p + 512));
                const bf16x8 vf = (bf16x8){lo[0], lo[1], lo[2], lo[3], hh[0], hh[1], hh[2], hh[3]};
                W.o[dt] = __builtin_amdgcn_mfma_f32_32x32x16_bf16(vf, sidx == 0 ? pf0 : pf1, W.o[dt], 0, 0, 0);
            }
        }
    }
}

template <int DQK, int DV, int KPB, bool MASKED>
__device__ __forceinline__ void tile_loop_simple(WState<DQK, DV>& W, LAS unsigned char* lds, const char* kg, size_t kpitch, const char* vg, size_t vpitch, int nT, int my_nt, int kc0, int tid, int lane, const LAS unsigned* mq) {
    Stage<KPB, DV> st;
    st.load(kg, kpitch, vg, vpitch, 0, tid); st.store(lds, 0, tid);
    __syncthreads();
    for (int t = 0; t < nT; ++t) {
        if (t + 1 < nT) st.load(kg, kpitch, vg, vpitch, 64 * (t + 1), tid);
        if (t < my_nt) tile_compute<DQK, DV, KPB, MASKED>(W, lds, t & 1, kc0, lane, MASKED ? mq + 2 * t : mq);
        if (t + 1 < nT) st.store(lds, (t + 1) & 1, tid);
        __syncthreads();
    }
}
template <int KPB> struct StageK {
    static constexpr int NK = KPB / 128; v4u kr[NK];
    __device__ __forceinline__ void load(const char* kg, size_t kpitch, int key0, int tid) {
#pragma unroll
        for (int i = 0; i < NK; ++i) { const int idx = tid + 512 * i, key = idx / (KPB / 16), ch = idx % (KPB / 16); kr[i] = *(const v4u*)(kg + (size_t)(key0 + key) * kpitch + ch * 16); }
    }
    __device__ __forceinline__ void store(LAS unsigned char* lds, int slot, int tid) const {
#pragma unroll
        for (int i = 0; i < NK; ++i) { const int idx = tid + 512 * i, key = idx / (KPB / 16), ch = idx % (KPB / 16); *(LAS v4u*)(lds + L_K + slot * 16384 + key * KPB + ((ch ^ ksw<KPB>(key)) << 4)) = kr[i]; }
    }
};
template <int DV> struct StageV {
    static constexpr int NV = DV / 64; v4u vr[NV];
    __device__ __forceinline__ void load(const char* vg, size_t vpitch, int key0, int tid) {
#pragma unroll
        for (int i = 0; i < NV; ++i) { const int idx = tid + 512 * i, key = idx / (DV / 8), ch = idx % (DV / 8); vr[i] = *(const v4u*)(vg + (size_t)(key0 + key) * vpitch + ch * 16); }
    }
    __device__ __forceinline__ void store(LAS unsigned char* lds, int slot, int tid) const { store_off(lds, slot * 16384, tid); }
    __device__ __forceinline__ void store_off(LAS unsigned char* lds, int off, int tid) const {
#pragma unroll
        for (int i = 0; i < NV; ++i) { const int idx = tid + 512 * i, key = idx / (DV / 8), ch = idx % (DV / 8); *(LAS v4u*)(lds + L_V + off + (ch >> 2) * 4096 + key * 64 + (ch & 3) * 16) = vr[i]; }
    }
};
#define SBAR() __builtin_amdgcn_sched_barrier(0)
template <int DQK, int KPB> __device__ __forceinline__ void k_frags(bf16x8 (&kf)[DQK / 16], const LAS unsigned char* kb, int kc0, int r32, int hi, int kh) {
    const int row = 32 * kh + r32;
#pragma unroll
    for (int ks = 0; ks < DQK / 16; ++ks) kf[ks] = *(const LAS bf16x8*)(kb + row * KPB + (((kc0 + 2 * ks + hi) ^ ksw<KPB>(row)) << 4));
}
template <int DQK, int KPB> __device__ __forceinline__ void qk_tile(f32x16 (&s)[2], const bf16x8* qf, const LAS unsigned char* kb, int kc0, int r32, int hi) {
    bf16x8 kf0[DQK / 16], kf1[DQK / 16]; k_frags<DQK, KPB>(kf0, kb, kc0, r32, hi, 0); k_frags<DQK, KPB>(kf1, kb, kc0, r32, hi, 1);
    f32x16 a = {}, b = {};
#pragma unroll
    for (int ks = 0; ks < DQK / 16; ++ks) a = __builtin_amdgcn_mfma_f32_32x32x16_bf16(kf0[ks], qf[ks], a, 0, 0, 0);
#pragma unroll
    for (int ks = 0; ks < DQK / 16; ++ks) b = __builtin_amdgcn_mfma_f32_32x32x16_bf16(kf1[ks], qf[ks], b, 0, 0, 0);
    s[0] = a; s[1] = b;
}
template <int DQK, int DV, int KPB, bool MASKED> __device__ __forceinline__ void step_sm(WState<DQK, DV>& W, f32x16 (&sc)[2], f32x16 (&sn)[2], bf16x8 (&pf)[4], const LAS unsigned char* kb_next, int kc0, int lane, const LAS unsigned* mrow) {
    const int r32 = lane & 31, hi = lane >> 5;
    bf16x8 kf0[DQK / 16]; k_frags<DQK, KPB>(kf0, kb_next, kc0, r32, hi, 0);
    if constexpr (MASKED) {
#pragma unroll
        for (int kh = 0; kh < 2; ++kh) { const unsigned wsh = mrow[kh] >> (4 * hi);
#pragma unroll
            for (int r = 0; r < 16; ++r) { const unsigned mm = (unsigned)__builtin_amdgcn_sbfe((int)wsh, (r & 3) + 8 * (r >> 2), 1); sc[kh][r] = __uint_as_float((__float_as_uint(sc[kh][r]) & mm) | (0xFF800000u & ~mm)); } }
    }
    float mx = fmaxf(sc[0][0], sc[1][0]);
#pragma unroll
    for (int r = 1; r < 16; ++r) mx = fmaxf(fmaxf(mx, sc[0][r]), sc[1][r]);
    mx = hswap_max(mx);
    const float mn = (mx > W.m + 8.0f) ? mx : W.m, alpha = __builtin_amdgcn_exp2f(W.m - mn);
    W.m = mn;
    if (__any(alpha != 1.0f)) {
#pragma unroll
        for (int dt = 0; dt < DV / 32; ++dt)
#pragma unroll
            for (int r = 0; r < 16; ++r) W.o[dt][r] *= alpha;
    }
    SBAR();
    float mn_ = mn; asm volatile("" : "+v"(kf0[0]), "+v"(mn_));
    float ps0 = 0.f, ps1 = 0.f;
    { f32x16 a = {}, b = {};
#pragma unroll
      for (int ks = 0; ks < DQK / 16; ++ks) a = __builtin_amdgcn_mfma_f32_32x32x16_bf16(kf0[ks], W.qf[ks], a, 0, 0, 0);
      k_frags<DQK, KPB>(kf0, kb_next, kc0, r32, hi, 1);
#pragma unroll
      for (int ks = 0; ks < DQK / 16; ++ks) b = __builtin_amdgcn_mfma_f32_32x32x16_bf16(kf0[ks], W.qf[ks], b, 0, 0, 0);
      sn[0] = a; sn[1] = b; }
#pragma unroll
    for (int r = 0; r < 16; ++r) { sc[0][r] = __builtin_amdgcn_exp2f(sc[0][r] - mn_); ps0 += sc[0][r]; sc[1][r] = __builtin_amdgcn_exp2f(sc[1][r] - mn_); ps1 += sc[1][r]; }
#pragma unroll
    for (int i = 0; i < 2 * (DQK / 16); ++i) { __builtin_amdgcn_sched_group_barrier(0x008, 1, 0); __builtin_amdgcn_sched_group_barrier(0x002, (96 + 2 * (DQK / 16) - 1) / (2 * (DQK / 16)), 0); }
    SBAR();
    W.l = W.l * alpha + (ps0 + ps1);
#pragma unroll
    for (int kh = 0; kh < 2; ++kh) { v4u a, b;
        a.x = cvtpk(sc[kh][0], sc[kh][1]); a.y = cvtpk(sc[kh][2], sc[kh][3]); a.z = cvtpk(sc[kh][4], sc[kh][5]); a.w = cvtpk(sc[kh][6], sc[kh][7]);
        b.x = cvtpk(sc[kh][8], sc[kh][9]); b.y = cvtpk(sc[kh][10], sc[kh][11]); b.z = cvtpk(sc[kh][12], sc[kh][13]); b.w = cvtpk(sc[kh][14], sc[kh][15]);
        pf[2 * kh] = __builtin_bit_cast(bf16x8, a); pf[2 * kh + 1] = __builtin_bit_cast(bf16x8, b); }
}
template <int DQK, int DV> __device__ __forceinline__ void step_pv(WState<DQK, DV>& W, const bf16x8 (&pf)[4], const LAS unsigned char* vbase, int lane) {
    const int hi = lane >> 5;
    const LAS unsigned char* vb = vbase + ((lane >> 4) & 1) * 32 + (lane & 3) * 8 + (4 * hi + ((lane & 15) >> 2)) * 64;
    if constexpr (DV <= 64) {
        v4i16_t vl[2][4], vh[2][4];
#pragma unroll
        for (int k4 = 0; k4 < 4; ++k4) { vl[0][k4] = __builtin_amdgcn_ds_read_tr16_b64_v4i16((LAS v4i16_t*)(vb + (16 * k4) * 64)); vh[0][k4] = __builtin_amdgcn_ds_read_tr16_b64_v4i16((LAS v4i16_t*)(vb + (16 * k4) * 64 + 512)); }
#pragma unroll
        for (int dt = 0; dt < DV / 32; ++dt) {
            if (dt + 1 < DV / 32) {
#pragma unroll
                for (int k4 = 0; k4 < 4; ++k4) { vl[(dt + 1) & 1][k4] = __builtin_amdgcn_ds_read_tr16_b64_v4i16((LAS v4i16_t*)(vb + (dt + 1) * 4096 + (16 * k4) * 64)); vh[(dt + 1) & 1][k4] = __builtin_amdgcn_ds_read_tr16_b64_v4i16((LAS v4i16_t*)(vb + (dt + 1) * 4096 + (16 * k4) * 64 + 512)); }
            }
            SBAR();
#pragma unroll
            for (int k4 = 0; k4 < 4; ++k4) { const v4i16_t lo = vl[dt & 1][k4], hh = vh[dt & 1][k4];
                const bf16x8 vf = (bf16x8){lo[0], lo[1], lo[2], lo[3], hh[0], hh[1], hh[2], hh[3]};
                W.o[dt] = __builtin_amdgcn_mfma_f32_32x32x16_bf16(vf, pf[k4], W.o[dt], 0, 0, 0); }
            SBAR();
        }
    } else {
#pragma unroll
        for (int dt = 0; dt < DV / 32; ++dt) {
            v4i16_t vl[4], vh[4];
#pragma unroll
            for (int k4 = 0; k4 < 4; ++k4) { vl[k4] = __builtin_amdgcn_ds_read_tr16_b64_v4i16((LAS v4i16_t*)(vb + dt * 4096 + (16 * k4) * 64)); vh[k4] = __builtin_amdgcn_ds_read_tr16_b64_v4i16((LAS v4i16_t*)(vb + dt * 4096 + (16 * k4) * 64 + 512)); }
            SBAR();
#pragma unroll
            for (int k4 = 0; k4 < 4; ++k4) { const v4i16_t lo = vl[k4], hh = vh[k4];
                const bf16x8 vf = (bf16x8){lo[0], lo[1], lo[2], lo[3], hh[0], hh[1], hh[2], hh[3]};
                W.o[dt] = __builtin_amdgcn_mfma_f32_32x32x16_bf16(vf, pf[k4], W.o[dt], 0, 0, 0); }
            SBAR();
        }
    }
}
template <int DQK, int DV, int KPB, bool MASKED>
__device__ __forceinline__ void tile_loop(WState<DQK, DV>& W, LAS unsigned char* lds, const char* kg, size_t kpitch, const char* vg, size_t vpitch, int nT, int my_nt, int kc0, int tid, int lane, const LAS unsigned* mq, int mode = 0) {
    const int r32 = lane & 31, hi = lane >> 5;
    const bool lag = __builtin_amdgcn_readfirstlane(tid) >= 256;
    StageK<KPB> sk; StageV<DV> sv;
    sk.load(kg, kpitch, 0, tid); sv.load(vg, vpitch, 0, tid); sk.store(lds, 0, tid); sv.store(lds, 0, tid);
    if (nT > 1) { sk.load(kg, kpitch, 64, tid); sk.store(lds, 1, tid); }
    __syncthreads();
    f32x16 sc[2], sn[2]; bf16x8 pf[4];
    qk_tile<DQK, KPB>(sc, W.qf, lds + L_K, kc0, r32, hi);
    __syncthreads();
    volatile LAS unsigned* mstat = (volatile LAS unsigned*)(lds + MISC_OFF + 64);
    const bool tw = TIMING && (tid == 0);
    int vs_prev = 0, vs_cur = 0, vs_next = 16384;
    for (int t = 0; t < nT; ++t) {
        if (t + 2 < nT && mode != 3) sk.load(kg, kpitch, 64 * (t + 2), tid);
        if (t + 1 < nT && mode != 3) sv.load(vg, vpitch, 64 * (t + 1), tid);
        if (mode != 2 && t < my_nt) {
            if (lag && t > 0) step_pv<DQK, DV>(W, pf, lds + L_V + vs_prev, lane);
            step_sm<DQK, DV, KPB, MASKED>(W, sc, sn, pf, lds + L_K + ((t + 1) & 1) * 16384, kc0, lane, MASKED ? mq + 2 * t : mq);
            if (!lag) step_pv<DQK, DV>(W, pf, lds + L_V + vs_cur, lane);
#pragma unroll
            for (int r = 0; r < 16; ++r) { sc[0][r] = sn[0][r]; sc[1][r] = sn[1][r]; }
        }
        if (t + 2 < nT && mode != 3) sk.store(lds, t & 1, tid);
        if (t + 1 < nT && mode != 3) sv.store_off(lds, vs_next, tid);
        asm volatile("s_waitcnt vmcnt(0) lgkmcnt(0)" ::: "memory");
        __syncthreads();
        vs_prev = vs_cur; vs_cur = vs_next; vs_next = (vs_next == 32768) ? 0 : vs_next + 16384;
    }
    if (lag && mode != 2 && my_nt > 0) step_pv<DQK, DV>(W, pf, lds + L_V + vs_prev, lane);
    __syncthreads();
}
template <int DQK, int DV> __device__ __forceinline__ void wstate_init(WState<DQK, DV>& W, const bf16* qrow  , int hi) {
#pragma unroll
    for (int ks = 0; ks < DQK / 16; ++ks) W.qf[ks] = *(const bf16x8*)(qrow + 16 * ks + 8 * hi);
#pragma unroll
    for (int dt = 0; dt < DV / 32; ++dt) W.o[dt] = (f32x16){};
    W.m = NEG_BIG; W.l = 0.f;
}

__device__ __forceinline__ unsigned skey(float score, int idx) {
    const unsigned b = __float_as_uint(score); const unsigned k = b ^ ((unsigned)((int)b >> 31) | 0x80000000u);
    return ((k >> 1) & 0x7FFFF800u) | (unsigned)(2047 - idx);
}
__device__ __forceinline__ unsigned dpp_u(unsigned v, int ctrl_sel) {
    switch (ctrl_sel) {
    case 0: return (unsigned)__builtin_amdgcn_update_dpp(0, (int)v, 0xB1, 0xF, 0xF, true);
    case 1: return (unsigned)__builtin_amdgcn_update_dpp(0, (int)v, 0x4E, 0xF, 0xF, true);
    case 2: return (unsigned)__builtin_amdgcn_update_dpp(0, (int)v, 0x141, 0xF, 0xF, true);
    default: return (unsigned)__builtin_amdgcn_update_dpp(0, (int)v, 0x140, 0xF, 0xF, true);
    }
}
__device__ __forceinline__ unsigned half_sum(unsigned v, int hi) {
#pragma unroll
    for (int s = 0; s < 4; ++s) v += dpp_u(v, s);
    const unsigned s0 = (unsigned)__builtin_amdgcn_readlane((int)v, 0) + (unsigned)__builtin_amdgcn_readlane((int)v, 16), s1 = (unsigned)__builtin_amdgcn_readlane((int)v, 32) + (unsigned)__builtin_amdgcn_readlane((int)v, 48);
    return hi ? s1 : s0;
}
__device__ __forceinline__ float half_sumf(float v, int hi) {
#pragma unroll
    for (int s = 0; s < 4; ++s) v += __uint_as_float(dpp_u(__float_as_uint(v), s));
    const float s0 = __uint_as_float((unsigned)__builtin_amdgcn_readlane((int)__float_as_uint(v), 0)) + __uint_as_float((unsigned)__builtin_amdgcn_readlane((int)__float_as_uint(v), 16));
    const float s1 = __uint_as_float((unsigned)__builtin_amdgcn_readlane((int)__float_as_uint(v), 32)) + __uint_as_float((unsigned)__builtin_amdgcn_readlane((int)__float_as_uint(v), 48));
    return hi ? s1 : s0;
}
__device__ __forceinline__ unsigned half_max(unsigned v, int hi) {
#pragma unroll
    for (int s = 0; s < 4; ++s) { const unsigned o = dpp_u(v, s); v = v > o ? v : o; }
    const unsigned a0 = (unsigned)__builtin_amdgcn_readlane((int)v, 0), a1 = (unsigned)__builtin_amdgcn_readlane((int)v, 16), b0 = (unsigned)__builtin_amdgcn_readlane((int)v, 32), b1 = (unsigned)__builtin_amdgcn_readlane((int)v, 48);
    const unsigned s0 = a0 > a1 ? a0 : a1, s1 = b0 > b1 ? b0 : b1;
    return hi ? s1 : s0;
}
__device__ __forceinline__ float unskey(unsigned k31) { const unsigned k = k31 << 1; const unsigned b = (k & 0x80000000u) ? (k ^ 0x80000000u) : ~k; return __uint_as_float(b); }
__device__ __forceinline__ unsigned skey_f(float f) { const unsigned b = __float_as_uint(f); return ((b ^ ((unsigned)((int)b >> 31) | 0x80000000u)) >> 1) & 0x7FFFF800u; }
__device__ __forceinline__ void indexer_pass(const Bufs& B, const int S, const LAS unsigned char* ikl, LAS unsigned* masks, size_t rowb, int t0, int w, int lane, int ntl, int limit, bf16x8 a0, bf16x8 a1) {
    const int r32 = lane & 31, hi = lane >> 5;
    volatile LAS unsigned* mstat = (volatile LAS unsigned*)(ikl + MISC_OFF + 64);
    unsigned long long tstart_ = 0; if (TIMING && w == 0) tstart_ = __builtin_amdgcn_s_memrealtime();
    float wt[8];
    { const float* iwp = WSP(const float, WS_IW) + (rowb + t0 + 4 * w + 2 * hi + S) * 8;
      const f32x4 v0 = *(const f32x4*)iwp, v1 = *(const f32x4*)(iwp + 4); wt[0] = v0.x; wt[1] = v0.y; wt[2] = v0.z; wt[3] = v0.w; wt[4] = v1.x; wt[5] = v1.y; wt[6] = v1.z; wt[7] = v1.w; }
    const int sw = (r32 >> 2) & 3;
    const LAS unsigned char* p0 = ikl + r32 * 64 + ((hi ^ sw) << 4);
    const LAS unsigned char* p1 = ikl + r32 * 64 + (((2 + hi) ^ sw) << 4);
    unsigned key[64]; unsigned kmax = 0u, kmin = 0xFFFFFFFFu; float sm1 = 0.f, sm2 = 0.f;
#pragma unroll
    for (int tb = 0; tb < 16; ++tb) {
        if (4 * tb < ntl) {
#pragma unroll
            for (int tt = 0; tt < 4; ++tt) { const int t = 4 * tb + tt;
                const bf16x8 b0 = *(const LAS bf16x8*)(p0 + t * 2048), b1 = *(const LAS bf16x8*)(p1 + t * 2048);
                f32x16 acc = {};
                acc = __builtin_amdgcn_mfma_f32_32x32x16_bf16(a0, b0, acc, 0, 0, 0);
                acc = __builtin_amdgcn_mfma_f32_32x32x16_bf16(a1, b1, acc, 0, 0, 0);
                float s0 = 0.f;
#pragma unroll
                for (int h = 0; h < 8; ++h) { const int ai = __float_as_int(acc[h]); s0 += wt[h] * __int_as_float(ai > 0 ? ai : 0); }
                const unsigned k = skey(s0, 32 * t + r32);
                if (tt < 2) { key[t] = k; kmax = kmax > k ? kmax : k; kmin = kmin < k ? kmin : k; sm1 += s0; sm2 = fmaf(s0, s0, sm2); }
                else { const bool valid = t < ntl; const float sv_ = valid ? s0 : 0.f; sm1 += sv_; sm2 = fmaf(sv_, sv_, sm2); key[t] = valid ? k : 0u; const unsigned kx = valid ? k : 0u, kn = valid ? k : 0xFFFFFFFFu; kmax = kmax > kx ? kmax : kx; kmin = kmin < kn ? kmin : kn; }
            }
        } else {
#pragma unroll
            for (int tt = 0; tt < 4; ++tt) key[4 * tb + tt] = 0u;
        }
    }
    unsigned long long ti0_ = 0; if (TIMING && w == 0) { ti0_ = __builtin_amdgcn_s_memrealtime(); if (lane == 0) mstat[8] += (unsigned)(ti0_ - tstart_); }
    unsigned tau = 1u;
    if (limit > 256) {
        kmax = half_max(kmax, hi); kmin = ~half_max(~kmin, hi);
        unsigned lo = kmin & ~0x7FFu, hb = kmax + 1u; float lof = unskey(lo), hbf = unskey(kmax); bool dn = false;
        float flo = (float)limit - 256.5f, fhb = -256.5f; int lastside = 0;
        const float invn = __builtin_amdgcn_rcpf((float)limit), mu = half_sumf(sm1, hi) * invn, var = fmaxf(half_sumf(sm2, hi) * invn - mu * mu, 1e-30f), sg = __builtin_amdgcn_sqrtf(var);
        const float pq = 256.5f * invn, zq = __builtin_amdgcn_logf((1.f - pq) * __builtin_amdgcn_rcpf(pq)) * 0.40726f;
        const float tau0 = fmaf(zq, sg, mu), idens = sg * __builtin_amdgcn_rcpf((float)limit * 1.702f * pq * (1.f - pq));
        float tprev = tau0;
        for (int it = 0; it < 64; ++it) {
            if (!dn && hb - lo <= 1u) { tau = lo; dn = true; }
            if (__all(dn)) break;
            if (TIMING && w == 0 && lane == 0) mstat[11] += 100u;
            unsigned mid = skey_f((lof * fhb - hbf * flo) * __builtin_amdgcn_rcpf(fhb - flo));
            if (it < 2) { const float tg = it == 0 ? tau0 : fmaf(lastside == 1 ? flo : fhb, idens, tprev); tprev = tg; const unsigned mg = skey_f(tg); mid = ((mg > lo) & (mg < hb)) ? mg : mid; }
            { const unsigned m2 = skey_f(0.5f * (lof + hbf)); const bool bad = (mid <= lo) | (mid >= hb); mid = bad ? m2 : mid; const bool bad2 = (mid <= lo) | (mid >= hb); mid = bad2 ? lo + ((hb - lo) >> 1) : mid; }
            const unsigned mm1 = mid - 1u;
            unsigned c0 = 0, c1 = 0, c2 = 0, c3 = 0;
#pragma unroll
            for (int tb = 0; tb < 4; ++tb) {
                if (16 * tb < ntl) {
                    unsigned a0_ = 0, a1_ = 0;
#pragma unroll
                    for (int tt = 0; tt < 16; tt += 2) { a0_ = __builtin_amdgcn_alignbit(a0_, mm1 - key[16 * tb + tt], 31); a1_ = __builtin_amdgcn_alignbit(a1_, mm1 - key[16 * tb + tt + 1], 31); }
                    if (tb & 1) { c1 += __builtin_popcount(a0_); c3 += __builtin_popcount(a1_); } else { c0 += __builtin_popcount(a0_); c2 += __builtin_popcount(a1_); }
                }
            }
            const unsigned c = half_sum((c0 + c1) + (c2 + c3), hi);
            if (!dn) {
                if (c == 256u) { tau = mid; dn = true; }
                else if (c > 256u) { lo = mid; lof = unskey(mid); flo = (float)c - 256.5f; if (lastside == 1) fhb *= 0.5f; lastside = 1; }
                else { hb = mid; hbf = unskey(mid); fhb = (float)c - 256.5f; if (lastside == 2) flo *= 0.5f; lastside = 2; }
            }
        }
    }
    unsigned long long ti1_ = 0; if (TIMING && w == 0) { ti1_ = __builtin_amdgcn_s_memrealtime(); if (lane == 0) mstat[9] += (unsigned)(ti1_ - ti0_); }
    LAS unsigned* mb = (r32 == 0) ? masks + (4 * w + 2 * hi + S) * 64 : masks + 2048 + lane;
#pragma unroll
    for (int t = 0; t < 64; ++t) {
        const unsigned long long m0 = __ballot(key[t] >= tau);
        mb[t] = hi ? (unsigned)(m0 >> 32) : (unsigned)m0;
    }
    if (TIMING && w == 0) { const unsigned long long ti2_ = __builtin_amdgcn_s_memrealtime(); if (lane == 0) mstat[10] += (unsigned)(ti2_ - ti1_); }
}
__device__ __forceinline__ void gather8(float (&v)[8], const f32x16& o, int gp) {
#pragma unroll
    for (int i = 0; i < 4; ++i) { auto rr = __builtin_amdgcn_permlane32_swap(__float_as_uint(o[8 * gp + i]), __float_as_uint(o[8 * gp + 4 + i]), false, false); v[i] = __uint_as_float(rr[0]); v[4 + i] = __uint_as_float(rr[1]); }
}
__device__ __forceinline__ v4u pack8(const float (&v)[8]) { v4u o; o.x = cvtpk(v[0], v[1]); o.y = cvtpk(v[2], v[3]); o.z = cvtpk(v[4], v[5]); o.w = cvtpk(v[6], v[7]); return o; }
__device__ __forceinline__ void unpack8(float (&g)[8], v4u w) { g[0] = bf2f(w.x & 0xffffu); g[1] = bf2f(w.x >> 16); g[2] = bf2f(w.y & 0xffffu); g[3] = bf2f(w.y >> 16); g[4] = bf2f(w.z & 0xffffu); g[5] = bf2f(w.z >> 16); g[6] = bf2f(w.w & 0xffffu); g[7] = bf2f(w.w >> 16); }
__device__ __forceinline__ void unit_A(Frame& F, int b, int qb32, int dmode) {
    const bool dry = dmode != 0;
    const Bufs& B = F.B; int tid_ = F.tid; asm volatile("" : "+v"(tid_)); const int tid = tid_, lane = tid & 63, w = F.wave, r32 = lane & 31, hi = lane >> 5;
    const int t0 = qb32 * 32, limit = ((t0 >> 6) + 1) << 6, ntl = limit >> 5;
    const size_t rowb = (size_t)b * SEQ;
    LAS unsigned* masks = (LAS unsigned*)(F.lds + L_MASK);
    {
        { const char* src = (const char*)(WSP(const bf16, WS_IK) + rowb * 32);
          const int P0 = w * 1024 + lane * 16, key0 = P0 >> 6, slot = (P0 >> 4) & 3;
#pragma unroll 1
          for (int s0 = 0; s0 < limit * 64; s0 += 8192) {
              const int key = key0 + (s0 >> 6);
              __builtin_amdgcn_global_load_lds((const unsigned*)(src + (size_t)key * 64 + ((slot ^ ((key >> 2) & 3)) << 4)), (LAS unsigned*)(F.lds + s0 + w * 1024), 16, 0, 0);
          } }
        asm volatile("s_waitcnt vmcnt(0)" ::: "memory");
        __syncthreads();
        TST(1);
        if (dmode != 3) {
#pragma unroll 1
        for (int sl = 0; sl < 2; ++sl) {
            const int rho = r32, qa = 2 * ((rho >> 2) & 1) + ((rho >> 4) ^ sl), ha = 4 * ((rho >> 3) & 1) + (rho & 3);
            const bf16* iqp = WSP(const bf16, WS_IQ) + (rowb + t0 + 4 * w + qa) * 256 + ha * 32 + 8 * hi;
            const bf16x8 a0 = *(const bf16x8*)iqp, a1 = *(const bf16x8*)(iqp + 16);
            indexer_pass(B, sl, F.lds, masks, rowb, t0, w, lane, ntl, limit, a0, a1);
        }
        }
    }
    __syncthreads();
    TST(2);
    {
        const int ql = 4 * w + (r32 >> 3), head = r32 & 7; const size_t row = rowb + t0 + ql;
        bf16* qrow = WSP(bf16, WS_QAB) + row * 1024 + head * 64;
        WState<64, 64> W; wstate_init<64, 64>(W, qrow, hi);
        const int nT = limit >> 6;
        __builtin_amdgcn_global_load_lds((const unsigned*)(WSP(const bf16, WS_AG) + row * 512 + head * 64), (LAS unsigned*)(F.lds + 98304 + w * 256), 4, 0, 0);
        tile_loop<64, 64, 128, true>(W, F.lds, (const char*)(WSP(const bf16, WS_AK) + rowb * 64), 128, (const char*)(WSP(const bf16, WS_AV) + rowb * 64), 128, dmode == 2 ? 1 : nT, dmode == 2 ? 1 : nT, 0, tid, lane, masks + ql * 64);
        TST(3);
        const float inv = 1.f / hswap_sum(W.l);
        const bf16* grow = WSP(const bf16, WS_AG) + row * 512 + head * 64;
        v4u gw[4];
#pragma unroll
        for (int q = 0; q < 4; ++q) gw[q] = *(const v4u*)(grow + 16 * q + 8 * hi);
#pragma unroll
        for (int dt = 0; dt < 2; ++dt)
#pragma unroll
            for (int gp = 0; gp < 2; ++gp) { const int d0 = 32 * dt + 16 * gp + 8 * hi;
                float v[8], g[8]; gather8(v, W.o[dt], gp); unpack8(g, gw[2 * dt + gp]);
#pragma unroll
                for (int i = 0; i < 8; ++i) v[i] = v[i] * inv * g[i];
                if (!dry) *(v4u*)(qrow + d0) = pack8(v); }
    }
    __syncthreads();
    TST(4);
}

__device__ __forceinline__ void unit_B(Frame& F, int b, int h, int qb128, int dmode) {
    const bool dry = dmode != 0;
    const Bufs& B = F.B; int tid_ = F.tid; asm volatile("" : "+v"(tid_)); const int tid = tid_, lane = tid & 63, w = F.wave, r32 = lane & 31, hi = lane >> 5;
    const int qb = w >> 1, c = w & 1, t0 = qb128 * 128 + qb * 32;
    const size_t rowb = (size_t)b * SEQ, row = rowb + t0 + r32;
    const int nT = 2 * qb128 + 2, my_nt = ((t0 >> 6) + 1);
    bf16* qrow = WSP(bf16, WS_QAB) + row * 1024 + 512 + h * 128;
    WState<64, 128> W; wstate_init<64, 128>(W, qrow + c * 64, hi);
    tile_loop<64, 128, 256, false>(W, F.lds, (const char*)(WSP(const bf16, WS_BK) + rowb * 512 + h * 128), 1024, (const char*)(WSP(const bf16, WS_BV) + rowb * 512 + h * 128), 1024, nT, my_nt, c * 8, tid, lane, nullptr, dmode);
    TST(5);
    const float inv = 1.f / hswap_sum(W.l);
    LAS float* X = (LAS float*)(F.lds + L_X) + qb * 4096 + lane;
    const bf16* grow = WSP(const bf16, WS_BG) + row * 512 + h * 128;
    v4u gpre[8];
    if (c == 0) {
#pragma unroll
        for (int q = 0; q < 8; ++q) gpre[q] = *(const v4u*)(grow + 16 * q + 8 * hi);
    }
    if (c == 1) {
#pragma unroll
        for (int dt = 0; dt < 4; ++dt)
#pragma unroll
            for (int r = 0; r < 16; ++r) X[(dt * 16 + r) * 64] = W.o[dt][r] * inv;
    }
    __syncthreads();
    if (c == 0) {
        const float lam = *(const LAS float*)(F.lds + L_NG + 512);
        float ss = 0.f;
#pragma unroll
        for (int dt = 0; dt < 4; ++dt)
#pragma unroll
            for (int r = 0; r < 16; ++r) { const float v = W.o[dt][r] * inv - lam * X[(dt * 16 + r) * 64]; W.o[dt][r] = v; ss += v * v; }
        ss = hswap_sum(ss);
        const float rn = rsqrtf(ss * (1.f / 128.f) + LN_EPS) * (1.f - LAM_INIT);
#pragma unroll
        for (int dt = 0; dt < 4; ++dt)
#pragma unroll
            for (int gp = 0; gp < 2; ++gp) { const int d0 = 32 * dt + 16 * gp + 8 * hi;
                float v[8], g[8]; gather8(v, W.o[dt], gp); unpack8(g, gpre[2 * dt + gp]);
                const f32x4 n0 = *(const LAS f32x4*)(F.lds + L_NG + d0 * 4), n1 = *(const LAS f32x4*)(F.lds + L_NG + d0 * 4 + 16);
#pragma unroll
                for (int i = 0; i < 8; ++i) v[i] = v[i] * rn * (i < 4 ? n0[i] : n1[i - 4]) * g[i];
                if (!dry) *(v4u*)(qrow + d0) = pack8(v); }
    }
    __syncthreads();
    TST(6);
}

__device__ __forceinline__ void unit_C(Frame& F, int b, int h, int qb256, bool dry) {
    const Bufs& B = F.B; int tid_ = F.tid; asm volatile("" : "+v"(tid_)); const int tid = tid_, lane = tid & 63, w = F.wave, r32 = lane & 31, hi = lane >> 5;
    const size_t row = (size_t)b * SEQ + qb256 * 256 + w * 32 + r32;
    bf16* qrow = WSP(bf16, WS_QC) + row * 1024 + h * 128;
    WState<128, 128> W; wstate_init<128, 128>(W, qrow, hi);
    const char* kv = (const char*)(WSP(const bf16, WS_MKV) + (size_t)b * MEM_LEN * 1024 + h * 128);
    __builtin_amdgcn_global_load_lds((const unsigned*)(qrow + 512 + hi * 64), (LAS unsigned*)(F.lds + L_MASK + w * 256), 4, 0, 0);
    { v4u kr[8], vr[8];
#pragma unroll
      for (int i = 0; i < 8; ++i) { const int idx = tid + 512 * i, key = idx >> 4, ch = idx & 15; kr[i] = *(const v4u*)(kv + (size_t)key * 2048 + ch * 16); vr[i] = *(const v4u*)(kv + 1024 + (size_t)key * 2048 + ch * 16); }
#pragma unroll
      for (int i = 0; i < 8; ++i) { const int idx = tid + 512 * i, key = idx >> 4, ch = idx & 15, t = key >> 6, k64 = key & 63;
          *(LAS v4u*)(F.lds + t * 16384 + k64 * 256 + ((ch ^ ksw<256>(k64)) << 4)) = kr[i];
          *(LAS v4u*)(F.lds + 65536 + t * 16384 + (ch >> 2) * 4096 + k64 * 64 + (ch & 3) * 16) = vr[i]; } }
    __syncthreads();
    { f32x16 sc[2], sn[2]; bf16x8 pf[4];
      qk_tile<128, 256>(sc, W.qf, F.lds, 0, r32, hi);
#pragma unroll 1
      for (int t = 0; t < 4; ++t) {
          step_sm<128, 128, 256, false>(W, sc, sn, pf, F.lds + ((t + 1) & 3) * 16384, 0, lane, nullptr);
          step_pv<128, 128>(W, pf, F.lds + 65536 + t * 16384, lane);
#pragma unroll
          for (int r = 0; r < 16; ++r) { sc[0][r] = sn[0][r]; sc[1][r] = sn[1][r]; }
      } }
    const float inv = 1.f / hswap_sum(W.l);
    const bf16* grow = qrow + 512;
    v4u gwc[8];
#pragma unroll
    for (int q = 0; q < 8; ++q) gwc[q] = *(const v4u*)(grow + 16 * q + 8 * hi);
#pragma unroll
    for (int dt = 0; dt < 4; ++dt)
#pragma unroll
        for (int gp = 0; gp < 2; ++gp) { const int d0 = 32 * dt + 16 * gp + 8 * hi;
            float v[8], g[8]; gather8(v, W.o[dt], gp); unpack8(g, gwc[2 * dt + gp]);
#pragma unroll
            for (int i = 0; i < 8; ++i) v[i] = v[i] * inv * g[i];
            if (!dry) *(v4u*)(qrow + d0) = pack8(v); }
    __syncthreads();
    TST(7);
}

__device__ __forceinline__ void unit_MKV(Frame& F, int b, int pn) {
    const Bufs& B = F.B;
    SchedOne S; S.pm = b; S.pn = pn; S.MEMB = (const char*)(B.ws + WS_MEMB); S.WMEM = (const char*)(B.ws + WS_WMEM);
    EpiIn E{B};
    pg8::gemm_phase<EpiIn, SchedOne, true, true>(F.lds + RING_OFF, S, E);
    asm volatile("s_waitcnt vmcnt(0)" ::: "memory");
    __syncthreads();
    if (F.tid == 0) { __builtin_amdgcn_fence(__ATOMIC_RELEASE, "agent"); asm volatile("s_waitcnt vmcnt(0)" ::: "memory"); __hip_atomic_fetch_add(F.ctl + CW_MKV + 64 * b, 1u, __ATOMIC_RELAXED, __HIP_MEMORY_SCOPE_AGENT); }
    __syncthreads();
}
__device__ __forceinline__ void wait_MKV(Frame& F, int b) {
    if (F.tid == 0) {
        unsigned sp = 0;
        while (__hip_atomic_load(F.ctl + CW_MKV + 64 * b, __ATOMIC_RELAXED, __HIP_MEMORY_SCOPE_AGENT) < 4u) { __builtin_amdgcn_s_sleep(2); if (++sp > (1u << 22)) break; }
        __builtin_amdgcn_fence(__ATOMIC_ACQUIRE, "agent"); asm volatile("s_waitcnt vmcnt(0)" ::: "memory");
    }
    __syncthreads();
}
constexpr int QUNITS = 328;
__device__ __forceinline__ void attn_phase(Frame& F, unsigned* qctr) {
    const int q0 = (int)(xb_xcc_id() & 7u);
    if (F.tid < 128) ((LAS float*)(F.lds + L_NG))[F.tid] = F.B.diff_norm_g[F.tid];
    if (F.tid == 128) ((LAS float*)(F.lds + L_NG))[128] = *(const float*)(F.B.ws + WS_LAM);
    if (TIMING && threadIdx.x == 0) F.MISC[14] = (unsigned)__builtin_amdgcn_s_memrealtime();
    for (int k = 0; k < 8; ++k) {
        const int q = (q0 + k) & 7;
        for (;;) {
            __syncthreads();
            if (F.tid == 0) F.MISC[0] = atomicAdd(qctr + 64 * q, 1u);
            __syncthreads();
            int pos = (int)F.MISC[0]; int dmode = 0;
            TST(0);
#if PROBE_DRY
            if (pos < 128) { dmode = PROBE_DMODE; pos = ((pos >> 2) << 3) + (pos & 3) + (PROBE_DRY == 1 ? 0 : 4); } else pos -= 128;
#endif
            if (pos >= QUNITS) break;
            if (pos < 8) { unit_MKV(F, q + 8 * (pos >> 2), pos & 3); continue; }
            pos -= 8;
            if (pos < 256) {
                const int b = q + 8 * (pos >> 7), p = pos & 127, L = 15 - (p >> 3), r = p & 7;
                if (r < 4) unit_A(F, b, 4 * L + 3 - r, dmode);
                else unit_B(F, b, r - 4, L, dmode);
            } else { const int c = pos - 256, b = q + 8 * (c >> 5), cc = c & 31; wait_MKV(F, b); unit_C(F, b, cc & 3, cc >> 2, false); }
        }
    }
    if (TIMING) { __syncthreads(); if (F.tid < 16) atomicAdd(F.ctl + CW_TIME + F.tid, F.MISC[16 + F.tid]); }
}
}
constexpr size_t WS_SCR = WS_XN;
struct SchedMerge {
    pg8::TileOrder T; int G, c; const char *QAB, *QC, *WAB, *WC;
    __device__ __forceinline__ bool next(int i, pg8::Unit& u) const {
        const int ti = i / 3, br = i - ti * 3, L = ti * G + c;
        if (L >= T.nwg) return false;
        T.tile(L, u.pm, u.pn); u.kind = br; u.nt = 8; u.keep = br < 2 ? 1 : 0;
        if (br == 0) { u.A = QAB + (size_t)u.pm * pg8::TSTEP; u.B = WAB + (size_t)u.pn * pg8::TSTEP; }
        else if (br == 1) { u.A = QAB + (size_t)u.pm * pg8::TSTEP + 1024; u.B = WAB + (size_t)u.pn * pg8::TSTEP + 1024; }
        else { u.A = QC + (size_t)u.pm * pg8::TSTEP; u.B = WC + (size_t)u.pn * pg8::TSTEP; }
        return true;
    }
    __device__ __forceinline__ void a_ready(const pg8::Unit&) const {}
    __device__ __forceinline__ void done(const pg8::Unit&) const {}
};
struct EpiMerge {
    static constexpr bool PERM = true, AFTER_DRAIN = false; bf16* merged; const unsigned char* ws_;
    __device__ __forceinline__ static void ld_u8(pg8::f32x4& a, pg8::f32x4& b, const unsigned char* p) {
        const uint2 gw = *(const uint2*)p; const float s = 1.f / 255.f;
        a = (pg8::f32x4){fmaxf((float)(gw.x & 255u), 1.f), fmaxf((float)((gw.x >> 8) & 255u), 1.f), fmaxf((float)((gw.x >> 16) & 255u), 1.f), fmaxf((float)(gw.x >> 24), 1.f)} * s;
        b = (pg8::f32x4){fmaxf((float)(gw.y & 255u), 1.f), fmaxf((float)((gw.y >> 8) & 255u), 1.f), fmaxf((float)((gw.y >> 16) & 255u), 1.f), fmaxf((float)(gw.y >> 24), 1.f)} * s;
    }
    __device__ __forceinline__ static void ld_bf(pg8::f32x4& a, pg8::f32x4& b, const bf16* p) {
        const v4u gw = *(const v4u*)p;
        a = (pg8::f32x4){bf2f(gw.x & 0xffffu), bf2f(gw.x >> 16), bf2f(gw.y & 0xffffu), bf2f(gw.y >> 16)}; b = (pg8::f32x4){bf2f(gw.z & 0xffffu), bf2f(gw.z >> 16), bf2f(gw.w & 0xffffu), bf2f(gw.w >> 16)};
    }
    __device__ __forceinline__ static pg8::f32x4 rcp4(pg8::f32x4 v) { return (pg8::f32x4){__builtin_amdgcn_rcpf(v[0]), __builtin_amdgcn_rcpf(v[1]), __builtin_amdgcn_rcpf(v[2]), __builtin_amdgcn_rcpf(v[3])}; }
    __device__ __forceinline__ static void cv_u8(pg8::f32x4& a, pg8::f32x4& b, uint2 gw) {
        const float s = 1.f / 255.f;
        a = (pg8::f32x4){fmaxf((float)(gw.x & 255u), 1.f), fmaxf((float)((gw.x >> 8) & 255u), 1.f), fmaxf((float)((gw.x >> 16) & 255u), 1.f), fmaxf((float)(gw.x >> 24), 1.f)} * s;
        b = (pg8::f32x4){fmaxf((float)(gw.y & 255u), 1.f), fmaxf((float)((gw.y >> 8) & 255u), 1.f), fmaxf((float)((gw.y >> 16) & 255u), 1.f), fmaxf((float)(gw.y >> 24), 1.f)} * s;
    }
    __device__ __forceinline__ static void cv_bf(pg8::f32x4& a, pg8::f32x4& b, v4u gw) {
        a = (pg8::f32x4){bf2f(gw.x & 0xffffu), bf2f(gw.x >> 16), bf2f(gw.y & 0xffffu), bf2f(gw.y >> 16)}; b = (pg8::f32x4){bf2f(gw.z & 0xffffu), bf2f(gw.z >> 16), bf2f(gw.w & 0xffffu), bf2f(gw.w >> 16)};
    }
    __device__ __forceinline__ void operator()(pg8::f32x4 (&acc)[2][2][4][2], const pg8::Unit& u, int wr, int wc, int fr, int fq) const {
        const int row0 = u.pm * 256 + wr * 64 + fr, col0 = u.pn * 256 + wc * 32 + 8 * fq;
        const size_t rt = (size_t)u.pm * 256, lo = (size_t)(wr * 64 + fr) * 1024 + col0;
        const int wv = wr * 4 + wc, ln = fq * 16 + fr;
        const size_t tA = ((size_t)(u.pm * 4 + u.pn) * 8 + wv) * 8192, tB = ((size_t)(u.pm * 4 + u.pn) * 8 + wv) * 16384;
        const __amdgpu_buffer_rsrc_t rA = __builtin_amdgcn_make_buffer_rsrc((void*)(ws_ + WS_GA + tA), 0, 8192, 0x00020000);
        const __amdgpu_buffer_rsrc_t rC = __builtin_amdgcn_make_buffer_rsrc((void*)(rt < GC_SPLIT ? ws_ + WS_GC + tA : ws_ + WS_GC2 + (tA - (size_t)GC_SPLIT * 1024)), 0, 8192, 0x00020000);
        const __amdgpu_buffer_rsrc_t rB = __builtin_amdgcn_make_buffer_rsrc((void*)(ws_ + WS_GB + tB), 0, 16384, 0x00020000);
        const int vl = ln * 16;
#define LD8P(r, p) __builtin_amdgcn_raw_buffer_load_b128(r, vl, (p) * 1024, 2)
#define LD16(ix) __builtin_amdgcn_raw_buffer_load_b128(rB, vl, (ix) * 1024, 2)
#define OFS(ix) ((((((ix) >> 3) & 1) * 128 + ((ix) & 3) * 16) * 1024) + (((ix) >> 2) & 1) * 128)
#pragma unroll
        for (int h = 0; h < 2; ++h) {
            uint2 q8[8]; v4u q16[8];
            if (u.kind == 0) {
#pragma unroll
                for (int j = 0; j < 4; ++j) { const v4u t_ = LD8P(rA, h * 4 + j); q8[2 * j] = make_uint2(t_.x, t_.y); q8[2 * j + 1] = make_uint2(t_.z, t_.w); }
#pragma unroll
                for (int j = 0; j < 8; ++j) q16[j] = LD16(h * 8 + j);
#pragma unroll
                for (int j = 0; j < 8; ++j) { const int ix = h * 8 + j; pg8::f32x4 na, nb, da, db; cv_u8(na, nb, q8[j]); cv_bf(da, db, q16[j]);
                    acc[ix >> 3][(ix >> 2) & 1][ix & 3][0] *= na * rcp4(da); acc[ix >> 3][(ix >> 2) & 1][ix & 3][1] *= nb * rcp4(db); }
            } else if (u.kind == 1) {
#pragma unroll
                for (int j = 0; j < 4; ++j) { const v4u t_ = LD8P(rC, h * 4 + j); q8[2 * j] = make_uint2(t_.x, t_.y); q8[2 * j + 1] = make_uint2(t_.z, t_.w); }
#pragma unroll
                for (int j = 0; j < 8; ++j) q16[j] = LD16(h * 8 + j);
#pragma unroll
                for (int j = 0; j < 8; ++j) { const int ix = h * 8 + j; pg8::f32x4 na, nb, da, db; cv_bf(na, nb, q16[j]); cv_u8(da, db, q8[j]);
                    acc[ix >> 3][(ix >> 2) & 1][ix & 3][0] *= na * rcp4(da); acc[ix >> 3][(ix >> 2) & 1][ix & 3][1] *= nb * rcp4(db); }
            } else {
#pragma unroll
                for (int j = 0; j < 4; ++j) { const v4u t_ = LD8P(rC, h * 4 + j); q8[2 * j] = make_uint2(t_.x, t_.y); q8[2 * j + 1] = make_uint2(t_.z, t_.w); }
#pragma unroll
                for (int j = 0; j < 8; ++j) { const int ix = h * 8 + j; pg8::f32x4 na, nb; cv_u8(na, nb, q8[j]); const int ai = ix >> 3, bj = (ix >> 2) & 1, m = ix & 3;
                    const pg8::f32x4 t0 = acc[ai][bj][m][0] * na, t1 = acc[ai][bj][m][1] * nb; float v[8] = {t0[0], t0[1], t0[2], t0[3], t1[0], t1[1], t1[2], t1[3]};
                    store8c(merged + (size_t)(row0 + ai * 128 + m * 16) * 1024 + col0 + bj * 128, v); }
            }
            asm volatile("" ::: "memory");
        }
#undef LD8P
#undef LD16
#undef OFS
    }
};
struct SchedOut {
    pg8::TileOrder T; int G, c; const char *MG, *WO;
    __device__ __forceinline__ bool next(int i, pg8::Unit& u) const {
        const int L = i * G + c; if (L >= T.nwg) return false;
        T.tile(L, u.pm, u.pn); u.A = MG + (size_t)u.pm * pg8::TSTEP; u.B = WO + (size_t)u.pn * pg8::TSTEP; u.nt = 16; u.kind = 0; u.keep = 0; return true;
    }
    __device__ __forceinline__ void a_ready(const pg8::Unit&) const {}
    __device__ __forceinline__ void done(const pg8::Unit&) const {}
};
struct EpiOutF {
    static constexpr bool PERM = true, AFTER_DRAIN = false; bf16* Y;
    __device__ __forceinline__ void operator()(const pg8::f32x4 (&acc)[2][2][4][2], const pg8::Unit& u, int wr, int wc, int fr, int fq) const {
        const int row0 = u.pm * 256 + wr * 64 + fr, col0 = u.pn * 256 + wc * 32 + 8 * fq;
#pragma unroll
        for (int ai = 0; ai < 2; ++ai)
#pragma unroll
            for (int m = 0; m < 4; ++m)
#pragma unroll
                for (int bj = 0; bj < 2; ++bj) { const pg8::f32x4 t0 = acc[ai][bj][m][0], t1 = acc[ai][bj][m][1];
                    float v[8] = {t0[0], t0[1], t0[2], t0[3], t1[0], t1[1], t1[2], t1[3]};
                    store8c(Y + (size_t)(row0 + ai * 128 + m * 16) * 1024 + col0 + bj * 128, v); }
    }
};
__device__ __forceinline__ void ln_out_rows(const Bufs& B, const bf16* Y, int gw, int NGW, int lane) {
    f32x4 gi[4], bi[4];
#pragma unroll
    for (int j = 0; j < 4; ++j) { gi[j] = *((const f32x4*)B.ln_in_g + lane + 64 * j) * ALPHA; bi[j] = *((const f32x4*)B.ln_in_b + lane + 64 * j) * ALPHA; }
    f32x4 v[4], nx[4]; uint2 yv[4], ny[4]; float2 st = {0.f, 0.f}, nst = {0.f, 0.f};
    if (gw < M) { const f32x4* xr = (const f32x4*)(B.x + (size_t)gw * D) + lane; const uint2* yr = (const uint2*)(Y + (size_t)gw * D) + lane;
#pragma unroll
        for (int j = 0; j < 4; ++j) { v[j] = __builtin_nontemporal_load(xr + 64 * j); { typedef unsigned v2u_ __attribute__((ext_vector_type(2))); const v2u_ t_ = __builtin_nontemporal_load((const v2u_*)(yr + 64 * j)); yv[j] = make_uint2(t_.x, t_.y); } }
        st = *(const float2*)(WSP(const float, WS_STATS) + (size_t)gw * 2); }
    for (int row = gw; row < M; row += NGW) {
        const int nr = row + NGW;
        if (nr < M) { const f32x4* xr = (const f32x4*)(B.x + (size_t)nr * D) + lane; const uint2* yr = (const uint2*)(Y + (size_t)nr * D) + lane;
#pragma unroll
            for (int j = 0; j < 4; ++j) { nx[j] = __builtin_nontemporal_load(xr + 64 * j); { typedef unsigned v2u_ __attribute__((ext_vector_type(2))); const v2u_ t_ = __builtin_nontemporal_load((const v2u_*)(yr + 64 * j)); ny[j] = make_uint2(t_.x, t_.y); } }
            nst = *(const float2*)(WSP(const float, WS_STATS) + (size_t)nr * 2); }
        float s = 0.f;
#pragma unroll
        for (int j = 0; j < 4; ++j) { const f32x4 yy = {bf2f(yv[j].x & 0xffffu), bf2f(yv[j].x >> 16), bf2f(yv[j].y & 0xffffu), bf2f(yv[j].y >> 16)};
            v[j] = (v[j] - st.x) * st.y * gi[j] + bi[j] + yy; s += (v[j].x + v[j].y) + (v[j].z + v[j].w); }
        const float mean = wave_sum(s) * (1.f / D); float s2 = 0.f;
#pragma unroll
        for (int j = 0; j < 4; ++j) { v[j] = v[j] - mean; s2 += (v[j].x * v[j].x + v[j].y * v[j].y) + (v[j].z * v[j].z + v[j].w * v[j].w); }
        const float rstd = rsqrtf(wave_sum(s2) * (1.f / D) + LN_EPS);
        f32x4* orow = (f32x4*)(B.out + (size_t)row * D) + lane;
#pragma unroll
        for (int j = 0; j < 4; ++j) { const f32x4 g = *((const f32x4*)B.ln_g + lane + 64 * j), b = *((const f32x4*)B.ln_b + lane + 64 * j); __builtin_nontemporal_store(v[j] * rstd * g + b, orow + 64 * j); }
#pragma unroll
        for (int j = 0; j < 4; ++j) { v[j] = nx[j]; yv[j] = ny[j]; }
        st = nst;
    }
}
__device__ __forceinline__ void ln_out_row(const Bufs& B, int row, int lane) {
    f32x4* xr = (f32x4*)(B.out + (size_t)row * D) + lane;
    f32x4 v[4]; float s = 0.f;
#pragma unroll
    for (int j = 0; j < 4; ++j) { v[j] = xr[64 * j]; s += (v[j].x + v[j].y) + (v[j].z + v[j].w); }
    const float mean = wave_sum(s) * (1.f / D); float s2 = 0.f;
#pragma unroll
    for (int j = 0; j < 4; ++j) { v[j] = v[j] - mean; s2 += (v[j].x * v[j].x + v[j].y * v[j].y) + (v[j].z * v[j].z + v[j].w * v[j].w); }
    const float rstd = rsqrtf(wave_sum(s2) * (1.f / D) + LN_EPS);
#pragma unroll
    for (int j = 0; j < 4; ++j) { const f32x4 g = *((const f32x4*)B.ln_g + lane + 64 * j), b = *((const f32x4*)B.ln_b + lane + 64 * j); xr[64 * j] = v[j] * rstd * g + b; }
}
struct Args { Bufs B; int nprog; int prog[11]; };
__global__ void __launch_bounds__(NWAVES * 64, 2) skel_fwd(Args args) {
    extern __shared__ __attribute__((aligned(16))) unsigned char lds[];
    Frame F;
    F.lds = (LAS unsigned char*)lds; F.MISC = (volatile LAS unsigned*)(F.lds + MISC_OFF);
    F.tid = threadIdx.x; F.lane = F.tid & 63; F.wave = __builtin_amdgcn_readfirstlane(F.tid >> 6);
    F.G = gridDim.x; { const int bx = blockIdx.x; F.vcu = (F.G % 8 == 0) ? (bx % 8) * (F.G / 8) + bx / 8 : bx; }
    F.B = args.B; F.ctl = (unsigned*)(args.B.ws + WS_CTL);
    const Bufs& B = F.B;
    for (int u = F.tid; u < (LDS_BYTES - LDSCTL_OFF) / 4; u += NWAVES * 64) ((LAS unsigned*)(F.lds + LDSCTL_OFF))[u] = 0u;
    __syncthreads();
    XcdBarrier bar = xcd_barrier_post(F.ctl + CW_BAR, F.MISC + 8);
    const int en = args.nprog;
#define P_PRO()  do { if (en & 1) p0_prologue(F); } while (0)
#define P_IN()   do { if (en & 2) { SchedIn S; S.T.init(M / 256, NPOS / 256); S.G = F.G; S.c = (int)blockIdx.x; \
            S.XN = (const char*)(B.ws + WS_XN); S.WIN = (const char*)(B.ws + WS_WIN); S.MEMB = (const char*)(B.ws + WS_MEMB); S.WMEM = (const char*)(B.ws + WS_WMEM); \
            EpiIn E{B}; pg8::gemm_phase<EpiIn, SchedIn, true, true>(F.lds + RING_OFF, S, E); } } while (0)
#define P_ATT(qi) do { if (en & 4) att::attn_phase(F, F.ctl + CW_QUEUE + 512 * (qi)); } while (0)
#define P_MRG()  do { if (en & 8) { SchedMerge S; S.T.init(M / 256, 4); S.G = F.G; S.c = (int)blockIdx.x; \
            S.QAB = (const char*)(B.ws + WS_QAB); S.QC = (const char*)(B.ws + WS_QC); S.WAB = (const char*)(B.ws + WS_WAB); S.WC = (const char*)(B.ws + WS_WC); \
            EpiMerge E{WSP(bf16, WS_MERGED), (const unsigned char*)B.ws}; \
            pg8::gemm_phase<EpiMerge, SchedMerge, true, true>(F.lds + RING_OFF, S, E); } } while (0)
#define P_OUT()  do { if (en & 16) { SchedOut S; S.T.init(M / 256, 4); S.G = F.G; S.c = (int)blockIdx.x; S.MG = (const char*)(B.ws + WS_MERGED); S.WO = (const char*)(B.ws + WS_WOUT); \
            EpiOutF E{WSP(bf16, WS_XN)}; pg8::gemm_phase<EpiOutF, SchedOut, true, true>(F.lds + RING_OFF, S, E); } } while (0)
#define P_LN()   do { if (en & 32) ln_out_rows(B, WSP(const bf16, WS_XN), F.vcu * NWAVES + F.wave, F.G * NWAVES, (int)(threadIdx.x & 63u)); } while (0)
#define BAR() xcd_barrier(bar)
#ifndef PROBE_REP
#define PROBE_REP 0
#endif
    P_PRO(); BAR();
#if PROBE_REP == 10
    P_PRO(); BAR();
#endif
    P_IN(); BAR();
#if PROBE_REP == 1
    P_IN(); BAR();
#endif
    P_ATT(0); BAR();
#if PROBE_REP == 12
    P_IN(); BAR(); P_ATT(1); BAR();
#endif
    P_MRG(); BAR();
#if PROBE_REP == 3
    P_MRG(); BAR();
#endif
    P_OUT(); BAR();
    P_LN();
#if PROBE_REP == 45
    BAR(); P_OUT(); BAR(); P_LN();
#endif
#if TIMING_SEL >= 0
    BAR(); if (blockIdx.x == 0 && F.tid == 0) { const unsigned v = __hip_atomic_load(F.ctl + CW_TIME + TIMING_SEL, __ATOMIC_RELAXED, __HIP_MEMORY_SCOPE_AGENT); B.out[0] = (float)v / (float)F.G / 100.f; }
#endif
}
#ifndef FAST_UPTO
#define FAST_UPTO 6
#endif
#ifndef PROG_LIST
#define PROG_LIST 0, 1, 2, 3, 4, 5
#endif
static void launch_skel(const Bufs& B, hipStream_t stream, int grid) {
    static const int prog[] = {PROG_LIST};
    Args a{}; a.B = B; a.nprog = 63; (void)prog;
    hipLaunchKernelGGL(skel_fwd, dim3(grid), dim3(NWAVES * 64), LDS_BYTES, stream, a);
}
extern "C" void kernel_launch(void* const* d_in, const int* in_sizes, int n_in, void* d_out, int out_size, void* d_ws, size_t ws_size, hipStream_t stream) {
    (void)in_sizes; (void)n_in; (void)out_size;
    static int grid = 0;
    if (grid == 0) {
        if (ws_size < WS_END) { fprintf(stderr, "workspace too small: %zu < %zu\n", ws_size, (size_t)WS_END); grid = -1; return; }
        int dev = 0, cus = 0;
        if (hipGetDevice(&dev) != hipSuccess || hipDeviceGetAttribute(&cus, hipDeviceAttributeMultiprocessorCount, dev) != hipSuccess) { grid = -1; return; }
        if (hipFuncSetAttribute((const void*)skel_fwd, hipFuncAttributeMaxDynamicSharedMemorySize, LDS_BYTES) != hipSuccess) { fprintf(stderr, "hipFuncSetAttribute failed\n"); grid = -1; return; }
        int per_cu = 0; (void)hipOccupancyMaxActiveBlocksPerMultiprocessor(&per_cu, (const void*)skel_fwd, NWAVES * 64, LDS_BYTES); (void)hipGetLastError();
        if (per_cu < 1) fprintf(stderr, "note: occupancy query reports %d blocks/CU\n", per_cu);
        grid = cus;
    }
    if (grid < 0) return;
    Bufs B{};
    B.x = (const float*)d_in[0]; B.mem = (const float*)d_in[1]; B.ln_in_g = (const float*)d_in[2]; B.ln_in_b = (const float*)d_in[3]; B.w_in = (const float*)d_in[4];
    B.w_mem_kv = (const float*)d_in[5]; B.diff_lambda = (const float*)d_in[6]; B.diff_norm_g = (const float*)d_in[7]; B.w_proj_a = (const float*)d_in[8];
    B.w_proj_b = (const float*)d_in[9]; B.w_proj_c = (const float*)d_in[10]; B.w_out = (const float*)d_in[11]; B.ln_g = (const float*)d_in[12]; B.ln_b = (const float*)d_in[13];
    B.out = (float*)d_out; B.ws = (unsigned char*)d_ws;
    unsigned char* ws = B.ws;
    (void)hipMemsetAsync(ws + WS_CTL, 0, CTL_ZERO_BYTES, stream);
    launch_skel(B, stream, grid);
}
```

```cpp
#include <hip/hip_runtime.h>
#include <hip/hip_bf16.h>
#include <cstdint>
#include <cstdio>
#include <cmath>

typedef unsigned short bf16;
typedef unsigned v4u __attribute__((ext_vector_type(4)));
typedef float f32x4 __attribute__((ext_vector_type(4)));

constexpr int D = 1024, BATCH = 16, SEQ = 2048, M = BATCH * SEQ;
constexpr int MEM_LEN = 256, MM = BATCH * MEM_LEN;
constexpr int IN_WIDTH = 7592;
constexpr int NPOS = 7680;
constexpr int O_AQ = 0, O_AK = 512, O_AV = 576, O_AG = 640, O_IQ = 1152, O_IK = 1408, O_IW = 1440, O_BQ = 1448, O_BK = 1960, O_BV = 2472,
              O_BG = 2984, O_CQ = 3496, O_CG = 4008, O_MG = 4520;
constexpr float LN_EPS = 1e-5f;
constexpr float LOG2E = 1.4426950408889634f;
constexpr float ALPHA = 1.189207115002721f;
constexpr float LAM_INIT = 0.2f;

constexpr size_t MiB = 1u << 20;
constexpr size_t WS_CTL = 0;
constexpr size_t WS_TAB = 1 * MiB;
constexpr size_t WS_TAB32 = WS_TAB + 128 * 1024;
constexpr size_t WS_LAM = WS_TAB + 256 * 1024;
constexpr size_t WS_STATS = WS_TAB + 512 * 1024;
constexpr size_t WS_WIN = 2 * MiB;
constexpr size_t WS_WMG = 11 * MiB;
constexpr size_t WS_WMEM = 17 * MiB;
constexpr size_t WS_WAB = 19 * MiB;
constexpr size_t WS_WC = 21 * MiB;
constexpr size_t WS_WOUT = 23 * MiB;
constexpr size_t WS_MEMB = 25 * MiB;
constexpr size_t WS_MKV = 2 * MiB;
constexpr size_t WS_XN = 41 * MiB;
constexpr size_t WS_QAB = 105 * MiB;
constexpr size_t WS_QC = 169 * MiB;
constexpr size_t WS_AG = 233 * MiB;
constexpr size_t WS_BK = 265 * MiB;
constexpr size_t WS_BV = 297 * MiB;
constexpr size_t WS_BG = 329 * MiB;
constexpr size_t WS_IQ = 361 * MiB;
constexpr size_t WS_AK = 377 * MiB;
constexpr size_t WS_AV = 381 * MiB;
constexpr size_t WS_IK = 385 * MiB;
constexpr size_t WS_IW = 387 * MiB;
constexpr size_t WS_MASK = 388 * MiB;
constexpr size_t WS_MERGED = WS_BK;
constexpr size_t WS_GTMP = WS_BG;
constexpr size_t WS_GB = 388 * MiB;
constexpr size_t WS_GA = 452 * MiB;
constexpr size_t WS_GC = 484 * MiB;
constexpr size_t WS_GC2 = 33 * MiB;
constexpr int GC_SPLIT = 28672;
constexpr size_t WS_END = 512 * MiB;

__device__ __forceinline__ unsigned f2bf(float f) { unsigned u = __float_as_uint(f); return (u + 0x7fffu + ((u >> 16) & 1u)) >> 16; }
__device__ __forceinline__ float bf2f(unsigned v) { return __uint_as_float(v << 16); }
__device__ __forceinline__ unsigned pk2(float lo, float hi) { typedef float f2_ __attribute__((ext_vector_type(2))); typedef __bf16 b2_ __attribute__((ext_vector_type(2))); f2_ v = {lo, hi}; b2_ b = __builtin_convertvector(v, b2_); return __builtin_bit_cast(unsigned, b); }
__device__ __forceinline__ float silu_f(float x) { return x * __builtin_amdgcn_rcpf(1.f + __builtin_amdgcn_exp2f(-LOG2E * x)); }
__device__ __forceinline__ float sigmoid_f(float x) { return 1.f / (1.f + __expf(-x)); }

__host__ __device__ __forceinline__ int rp64(int j) { return j < 16 ? ((j >> 1) + 8 * (j & 1)) : j; }
__host__ __device__ __forceinline__ int rp32(int j) { return j < 8 ? ((j >> 1) + 4 * (j & 1)) : j; }
__host__ __device__ __forceinline__ int orig_of_pos(int p) {
    const int tile = p >> 8;
    if (tile < 2) { return O_AQ + (p & ~63) + rp64(p & 63); }
    if (tile < 4) { return O_AG + (p - 512); }
    if (tile < 6) { const int c = p - 1024; return O_BQ + (c & ~63) + rp64(c & 63); }
    if (tile < 8) { const int c = p - 1536; return O_BK + (c & ~63) + rp64(c & 63); }
    if (tile < 10) { return O_BV + (p - 2048); }
    if (tile < 12) { return O_BG + (p - 2560); }
    if (tile < 14) { return O_CQ + (p - 3072); }
    if (tile < 16) { return O_CG + (p - 3584); }
    if (tile == 16) { const int c = p - 4096; return O_IQ + (c & ~31) + rp32(c & 31); }
    if (tile >= 18) return O_MG + (p - 4608);
    const int j = p - 4352;
    if (j < 64) return O_AK + rp64(j);
    if (j < 128) return O_AV + (j - 64);
    if (j < 160) return O_IK + rp32(j - 128);
    if (j < 168) return O_IW + (j - 160);
    return -1;
}

struct Bufs {
    const float *x, *mem, *ln_in_g, *ln_in_b, *w_in, *w_mem_kv, *diff_lambda, *diff_norm_g, *w_proj_a, *w_proj_b, *w_proj_c, *w_out, *ln_g, *ln_b;
    float* out; unsigned char* ws;
};
#define WSP(T, off) ((T*)(B.ws + (off)))

__device__ __forceinline__ void rope8_64(float* v, const float* tab, int i0) {
    const f32x4 c = *(const f32x4*)(tab + i0), s = *(const f32x4*)(tab + 8 + i0);
#pragma unroll
    for (int j = 0; j < 4; ++j) { const float x1 = v[2 * j], x2 = v[2 * j + 1]; v[2 * j] = x1 * c[j] - x2 * s[j]; v[2 * j + 1] = x2 * c[j] + x1 * s[j]; }
}
__device__ __forceinline__ void store8c(bf16* dst, const float* v) {
    v4u o; o.x = pk2(v[0], v[1]); o.y = pk2(v[2], v[3]); o.z = pk2(v[4], v[5]); o.w = pk2(v[6], v[7]); *(v4u*)dst = o;
}
__device__ __forceinline__ void store8(bf16* dst, const float* v) {
    v4u o; o.x = pk2(v[0], v[1]); o.y = pk2(v[2], v[3]); o.z = pk2(v[4], v[5]); o.w = pk2(v[6], v[7]); __builtin_nontemporal_store(o, (v4u*)dst);
}
enum { K_AQ = 0, K_AG, K_BQ, K_BK, K_BV, K_BG, K_CQ, K_CG, K_IQ, K_MISC, K_MG };
__host__ __device__ __forceinline__ int kind_of_tile(int tile) { return tile < 16 ? (tile >> 1) : (tile == 16 ? K_IQ : (tile == 17 ? K_MISC : K_MG)); }
__device__ __forceinline__ void rope8_32(float* v, const float* tab32) {
    const f32x4 cs = *(const f32x4*)(tab32), sn = *(const f32x4*)(tab32 + 4);
#pragma unroll
    for (int j = 0; j < 4; ++j) { const float x1 = v[2 * j], x2 = v[2 * j + 1]; v[2 * j] = x1 * cs[j] - x2 * sn[j]; v[2 * j + 1] = x2 * cs[j] + x1 * sn[j]; }
}
template <int KIND> __device__ __forceinline__ void emit8k(const Bufs& B, int t, int c, float* v) {
    const int pos = t & (SEQ - 1);
    const float* tab64 = WSP(const float, WS_TAB) + pos * 16;
    const float* tab32 = WSP(const float, WS_TAB32) + pos * 8;
    const float SQ64 = 0.125f * LOG2E, SQ128 = 0.08838834764831845f * LOG2E;
    if constexpr (KIND == K_AQ || KIND == K_BQ) {
        const int w = c & 63; if (w < 16) rope8_64(v, tab64, w >> 1);
#pragma unroll
        for (int j = 0; j < 8; ++j) v[j] *= SQ64;
        store8(WSP(bf16, WS_QAB) + (size_t)t * 1024 + (KIND == K_BQ ? 512 : 0) + c, v);
    } else if constexpr (KIND == K_AG || KIND == K_BG) {
#pragma unroll
        for (int j = 0; j < 8; ++j) v[j] = silu_f(v[j]);
        store8(WSP(bf16, KIND == K_AG ? WS_AG : WS_BG) + (size_t)t * 512 + c, v);
    } else if constexpr (KIND == K_BK) {
        const int w = c & 63; if (w < 16) rope8_64(v, tab64, w >> 1);
        store8c(WSP(bf16, WS_BK) + (size_t)t * 512 + c, v);
    } else if constexpr (KIND == K_BV) {
        store8c(WSP(bf16, WS_BV) + (size_t)t * 512 + c, v);
    } else if constexpr (KIND == K_CQ) {
#pragma unroll
        for (int j = 0; j < 8; ++j) v[j] *= SQ128;
        store8(WSP(bf16, WS_QC) + (size_t)t * 1024 + c, v);
    } else if constexpr (KIND == K_CG) {
#pragma unroll
        for (int j = 0; j < 8; ++j) v[j] = silu_f(v[j]);
        store8(WSP(bf16, WS_QC) + (size_t)t * 1024 + 512 + c, v);
    } else if constexpr (KIND == K_IQ) {
        if ((c & 31) < 8) rope8_32(v, tab32);
        store8(WSP(bf16, WS_IQ) + (size_t)t * 256 + c, v);
    } else if constexpr (KIND == K_MG) {
#pragma unroll
        for (int j = 0; j < 8; ++j) v[j] = __builtin_amdgcn_rcpf(1.f + __builtin_amdgcn_exp2f(-LOG2E * v[j]));
        const int br = c >> 10, col = c & 1023, pm_ = t >> 8, r_ = t & 255, cc_ = col & 255;
        const int ix_ = (r_ >> 7) * 8 + (cc_ >> 7) * 4 + ((r_ >> 4) & 3), wv_ = ((r_ >> 6) & 1) * 4 + ((cc_ >> 5) & 3), ln_ = ((cc_ >> 3) & 3) * 16 + (r_ & 15);
        const size_t tl_ = (size_t)(pm_ * 4 + (col >> 8)) * 8 + wv_;
        if (br == 1) store8(WSP(bf16, WS_GB) + (tl_ * 16384 + (size_t)(ix_ * 64 + ln_) * 16) / 2, v);
        else { unsigned long long w = 0;
#pragma unroll
            for (int j = 0; j < 8; ++j) w |= (unsigned long long)(unsigned)__builtin_rintf(v[j] * 255.f) << (8 * j);
            const size_t o_ = tl_ * 8192 + (size_t)((ix_ >> 1) * 64 + ln_) * 16 + (ix_ & 1) * 8;
            unsigned char* gp = br == 0 ? WSP(unsigned char, WS_GA) + o_ : (t < GC_SPLIT ? WSP(unsigned char, WS_GC) + o_ : WSP(unsigned char, WS_GC2) + (o_ - (size_t)GC_SPLIT * 1024));
            __builtin_nontemporal_store(w, (unsigned long long*)gp); }
    } else {
        if (c < 64) { if (c < 16) rope8_64(v, tab64, c >> 1); store8c(WSP(bf16, WS_AK) + (size_t)t * 64 + c, v); }
        else if (c < 128) { store8c(WSP(bf16, WS_AV) + (size_t)t * 64 + (c - 64), v); }
        else if (c < 160) { const int w = c - 128; if (w < 8) rope8_32(v, tab32); store8c(WSP(bf16, WS_IK) + (size_t)t * 32 + w, v); }
        else if (c == 160) { float* o = WSP(float, WS_IW) + (size_t)t * 8; *(f32x4*)o = (f32x4){v[0] * 0.0625f, v[1] * 0.0625f, v[2] * 0.0625f, v[3] * 0.0625f}; *(f32x4*)(o + 4) = (f32x4){v[4] * 0.0625f, v[5] * 0.0625f, v[6] * 0.0625f, v[7] * 0.0625f}; }
    }
}
__device__ __forceinline__ void inproj_emit8(const Bufs& B, int t, int p0, float* v) {
    const int tile = p0 >> 8, c = (tile < 16) ? (p0 & 511) : (tile < 18 ? (p0 & 255) : p0 - 4608);
    switch (kind_of_tile(tile)) {
    case K_AQ: emit8k<K_AQ>(B, t, c, v); break;  case K_AG: emit8k<K_AG>(B, t, c, v); break;
    case K_BQ: emit8k<K_BQ>(B, t, c, v); break;  case K_BK: emit8k<K_BK>(B, t, c, v); break;
    case K_BV: emit8k<K_BV>(B, t, c, v); break;  case K_BG: emit8k<K_BG>(B, t, c, v); break;
    case K_CQ: emit8k<K_CQ>(B, t, c, v); break;  case K_CG: emit8k<K_CG>(B, t, c, v); break;
    case K_IQ: emit8k<K_IQ>(B, t, c, v); break;  case K_MG: emit8k<K_MG>(B, t, c, v); break;  default:   emit8k<K_MISC>(B, t, c, v); break;
    }
}
__device__ __forceinline__ float wsrc(const Bufs& B, int kind, int k, int n) {
    switch (kind) {
    case 0: { const int o = orig_of_pos(n); return o < 0 ? 0.f : __builtin_nontemporal_load(B.w_in + (size_t)k * IN_WIDTH + o); }
    case 1: return __builtin_nontemporal_load(B.w_in + (size_t)k * IN_WIDTH + O_MG + n);
    case 2: return __builtin_nontemporal_load(B.w_mem_kv + (size_t)k * 1024 + n);
    case 3: return k < 512 ? __builtin_nontemporal_load(B.w_proj_a + (size_t)k * 1024 + n) : __builtin_nontemporal_load(B.w_proj_b + (size_t)(k - 512) * 1024 + n);
    case 4: return k < 512 ? __builtin_nontemporal_load(B.w_proj_c + (size_t)k * 1024 + n) : 0.f;
    default: return __builtin_nontemporal_load(B.w_out + (size_t)k * 1024 + n);
    }
}

namespace pg8 {
#define PG8_LAS __attribute__((address_space(3)))
typedef unsigned short bf16_t;
typedef short bf16x8 __attribute__((ext_vector_type(8)));
typedef float f32x4 __attribute__((ext_vector_type(4)));
typedef unsigned u32x4 __attribute__((ext_vector_type(4)));
constexpr int BM = 256, BK = 64, HALF = 128, HTB = HALF * BK * 2, STAGE_BYTES = 8 * HTB, NXCD = 8, WGM = 8, KP = 1024;
constexpr size_t TSTEP = (size_t)BM * KP * 2;

__host__ __device__ __forceinline__ int lds_byte(int r, int c) { const int st = (r >> 4) * 2 + (c >> 5), rr = r & 15, cc = c & 31, ob = rr * 64 + cc * 2; return st * 1024 + (ob ^ (((ob >> 9) & 1) << 5)); }
__host__ __device__ __forceinline__ void stage_rc(int b, int& R, int& C) { const int st = b / 1024, sb = b % 1024, swz = sb ^ (((sb >> 9) & 1) << 5); R = (st >> 1) * 16 + swz / 64; C = (st & 1) * 32 + (swz % 64) / 2; }
__host__ __device__ __forceinline__ int perm32(int rho) { const int n = rho >> 4, i = rho & 15; return 8 * (i >> 2) + 4 * n + (i & 3); }

struct Unit { int pm, pn; const char* A; const char* B; int nt; int kind; int keep; int pad; };

struct TileOrder {
    int nM, nN, nwg;
    __host__ __device__ void init(int nM_, int nN_) { nM = nM_; nN = nN_; nwg = nM * nN; }
    __host__ __device__ void tile(int L, int& pm, int& pn) const {
        int wgid = L; { const int q = nwg / NXCD, r = nwg % NXCD, xcd = wgid % NXCD, off = wgid / NXCD; wgid = (xcd < r ? xcd * (q + 1) : r * (q + 1) + (xcd - r) * q) + off; }
        const int nig = WGM * nN, gid = wgid / nig, fm = gid * WGM, gsz = (nM - fm) < WGM ? (nM - fm) : WGM;
        pm = fm + ((wgid % nig) % gsz); pn = (wgid % nig) / gsz;
    }
};
__device__ __forceinline__ unsigned cvt_pk_bf16(float lo, float hi) { unsigned r; asm volatile("v_cvt_pk_bf16_f32 %0, %1, %2" : "=v"(r) : "v"(lo), "v"(hi)); return r; }

template <class Epi, class Sched, bool ALIGN_EPI = false, bool SP2 = false>
__device__ __forceinline__ void gemm_phase(PG8_LAS unsigned char* lds, const Sched& S, const Epi& E) {
    int tid_ = threadIdx.x; asm volatile("" : "+v"(tid_));
    const int tid = tid_, wid = __builtin_amdgcn_readfirstlane(tid >> 6), lane = tid & 63, wr = wid >> 2, wc = wid & 3, fr = lane & 15, fq = lane >> 4;
    constexpr int K = KP; int nt;
    unsigned voffA[2], voffB[2];
#pragma unroll
    for (int i = 0; i < 2; ++i) { int R, C; stage_rc(tid * 16 + i * 8192, R, C); const int Rb = Epi::PERM ? ((R & ~31) + perm32(R & 31)) : R;
        voffA[i] = (unsigned)(R * K + C) * 2u; voffB[i] = (unsigned)(Rb * K + C) * 2u; }
    const size_t kstep = (size_t)(BK * 2);
    const size_t hstep = (size_t)HALF * K * 2;
    const size_t tstep = 2 * hstep;
    const unsigned ldsw = (unsigned)wid * 1024u;
    const int aoff = lds_byte(wr * 64 + fr, fq * 8), boff = lds_byte(wc * 32 + fr, fq * 8);
#define PG8_SA(b, h) (((b) * 2 + (h)) * HTB)
#define PG8_SB(b, h) ((4 + (b) * 2 + (h)) * HTB)
#define PG8_STAGE(bufoff, gbase, voff) do { _Pragma("unroll") for (int _i = 0; _i < 2; ++_i) \
        __builtin_amdgcn_global_load_lds((const unsigned*)((const char*)(gbase) + (voff)[_i]), (PG8_LAS unsigned*)(lds + (bufoff) + ldsw + _i * 8192), 16, 0, 0); } while (0)
#define PG8_LDA(dst, b, h) do { _Pragma("unroll") for (int m = 0; m < 4; ++m) _Pragma("unroll") for (int k = 0; k < 2; ++k) dst[m][k] = *(const PG8_LAS bf16x8*)(lds + PG8_SA(b, h) + aoff + m * 2048 + k * 1024); } while (0)
#define PG8_LDB(dst, b, h) do { _Pragma("unroll") for (int n = 0; n < 2; ++n) _Pragma("unroll") for (int k = 0; k < 2; ++k) dst[n][k] = *(const PG8_LAS bf16x8*)(lds + PG8_SB(b, h) + boff + n * 2048 + k * 1024); } while (0)
#define PG8_MMA(ai, bj, At, Bt) do { __builtin_amdgcn_s_setprio(1); _Pragma("unroll") for (int m = 0; m < 4; ++m) _Pragma("unroll") for (int n = 0; n < 2; ++n) _Pragma("unroll") for (int k = 0; k < 2; ++k) \
        acc[ai][bj][m][n] = __builtin_amdgcn_mfma_f32_16x16x32_bf16(Bt[n][k], At[m][k], acc[ai][bj][m][n], 0, 0, 0); __builtin_amdgcn_s_setprio(0); } while (0)
#define PG8_WAIT_V(n) asm volatile("s_waitcnt vmcnt(" #n ")" ::: "memory")
#define PG8_WAIT_L(n) asm volatile("s_waitcnt lgkmcnt(" #n ")" ::: "memory")
#define PG8_BAR __builtin_amdgcn_s_barrier()
#define PG8_SCHED __builtin_amdgcn_sched_barrier(0)
    Unit cur, nxt; int ui = 0;
    if (!S.next(0, cur)) return;
    f32x4 acc[2][2][4][2];
#pragma unroll
    for (int a = 0; a < 2; ++a)
#pragma unroll
        for (int b = 0; b < 2; ++b)
#pragma unroll
            for (int m = 0; m < 4; ++m)
#pragma unroll
                for (int n = 0; n < 2; ++n) acc[a][b][m][n] = (f32x4){0.f, 0.f, 0.f, 0.f};
    bf16x8 At[4][2], B0[2][2], B1[2][2];
    const char* cA = cur.A; const char* cB = cur.B; nt = cur.nt;
    S.a_ready(cur);
    if constexpr (SP2) {
        PG8_STAGE(PG8_SB(0, 0), cB, voffB); PG8_STAGE(PG8_SB(0, 1), cB + hstep, voffB); PG8_STAGE(PG8_SA(0, 0), cA, voffA); PG8_STAGE(PG8_SA(0, 1), cA + hstep, voffA);
        if (wr == 1) PG8_BAR;
        PG8_WAIT_V(2); PG8_BAR;
        PG8_STAGE(PG8_SB(1, 0), cB + kstep, voffB); PG8_STAGE(PG8_SA(1, 0), cA + kstep, voffA); PG8_STAGE(PG8_SB(1, 1), cB + hstep + kstep, voffB);
        PG8_WAIT_V(6); PG8_BAR;
    } else {
        PG8_STAGE(PG8_SB(0, 0), cB, voffB); PG8_STAGE(PG8_SA(0, 0), cA, voffA); PG8_STAGE(PG8_SB(0, 1), cB + hstep, voffB); PG8_STAGE(PG8_SA(0, 1), cA + hstep, voffA);
        if (wr == 1) PG8_BAR;
        PG8_WAIT_V(4); PG8_BAR;
        PG8_STAGE(PG8_SB(1, 0), cB + kstep, voffB); PG8_STAGE(PG8_SA(1, 0), cA + kstep, voffA); PG8_STAGE(PG8_SB(1, 1), cB + hstep + kstep, voffB);
        PG8_WAIT_V(6); PG8_BAR;
    }
    for (;;) {
        const bool has_next = S.next(ui + 1, nxt);
        const char* nA = has_next ? nxt.A : cA; const char* nB = has_next ? nxt.B : cB;
        for (int t = 0; t < nt; t += 2) {
            const bool last = (t == nt - 2);
            const char* a1 = cA + (size_t)(t + 1) * kstep;
            const char* a2 = last ? nA : cA + (size_t)(t + 2) * kstep; const char* b2 = last ? nB : cB + (size_t)(t + 2) * kstep;
            const char* a3 = a2 + kstep; const char* b3 = b2 + kstep;
            if (last && has_next) S.a_ready(nxt);
            if constexpr (SP2) {
            PG8_LDB(B0, 0, 0); PG8_LDB(B1, 0, 1); PG8_SCHED; PG8_LDA(At, 0, 0); PG8_STAGE(PG8_SA(1, 1), a1 + hstep, voffA);
            PG8_WAIT_V(8); PG8_WAIT_L(0); PG8_BAR; PG8_MMA(0, 0, At, B0); PG8_MMA(0, 1, At, B1); PG8_BAR; PG8_SCHED;
            PG8_LDA(At, 0, 1); PG8_STAGE(PG8_SB(0, 0), b2, voffB); PG8_STAGE(PG8_SB(0, 1), b2 + hstep, voffB); PG8_STAGE(PG8_SA(0, 0), a2, voffA);
            PG8_WAIT_V(8); PG8_WAIT_L(0); PG8_BAR; PG8_MMA(1, 0, At, B0); PG8_MMA(1, 1, At, B1); PG8_BAR; PG8_SCHED;
            PG8_LDB(B0, 1, 0); PG8_LDB(B1, 1, 1); PG8_SCHED; PG8_LDA(At, 1, 0); PG8_STAGE(PG8_SA(0, 1), a2 + hstep, voffA);
            PG8_WAIT_V(8); PG8_WAIT_L(0); PG8_BAR; PG8_MMA(0, 0, At, B0); PG8_MMA(0, 1, At, B1); PG8_BAR; PG8_SCHED;
            PG8_LDA(At, 1, 1); PG8_STAGE(PG8_SB(1, 0), b3, voffB); PG8_STAGE(PG8_SB(1, 1), b3 + hstep, voffB); PG8_STAGE(PG8_SA(1, 0), a3, voffA);
            PG8_WAIT_V(8); PG8_WAIT_L(0); PG8_BAR; PG8_MMA(1, 0, At, B0); PG8_MMA(1, 1, At, B1); PG8_BAR; PG8_SCHED;
            } else {
            PG8_LDB(B0, 0, 0); PG8_SCHED; PG8_LDA(At, 0, 0); PG8_STAGE(PG8_SA(1, 1), a1 + hstep, voffA);
            PG8_WAIT_L(8); PG8_BAR; PG8_WAIT_L(0); PG8_MMA(0, 0, At, B0); PG8_BAR; PG8_SCHED;
            PG8_LDB(B1, 0, 1); PG8_STAGE(PG8_SB(0, 0), b2, voffB);
            PG8_BAR; PG8_WAIT_L(0); PG8_MMA(0, 1, At, B1); PG8_BAR;
            PG8_LDA(At, 0, 1); PG8_STAGE(PG8_SA(0, 0), a2, voffA);
            PG8_BAR; PG8_WAIT_L(0); PG8_MMA(1, 0, At, B0); PG8_BAR; PG8_SCHED;
            PG8_STAGE(PG8_SB(0, 1), b2 + hstep, voffB);
            PG8_WAIT_V(6); PG8_BAR; PG8_MMA(1, 1, At, B1); PG8_BAR;
            PG8_LDB(B0, 1, 0); PG8_SCHED; PG8_LDA(At, 1, 0); PG8_STAGE(PG8_SA(0, 1), a2 + hstep, voffA);
            PG8_WAIT_L(8); PG8_BAR; PG8_WAIT_L(0); PG8_MMA(0, 0, At, B0); PG8_BAR; PG8_SCHED;
            PG8_LDB(B1, 1, 1); PG8_STAGE(PG8_SB(1, 0), b3, voffB);
            PG8_BAR; PG8_WAIT_L(0); PG8_MMA(0, 1, At, B1); PG8_BAR;
            PG8_LDA(At, 1, 1); PG8_STAGE(PG8_SA(1, 0), a3, voffA);
            PG8_BAR; PG8_WAIT_L(0); PG8_MMA(1, 0, At, B0); PG8_BAR; PG8_SCHED;
            PG8_STAGE(PG8_SB(1, 1), b3 + hstep, voffB);
            PG8_WAIT_V(6); PG8_BAR; PG8_MMA(1, 1, At, B1); PG8_BAR;
            }
        }
        if constexpr (ALIGN_EPI) { if (wr == 0) PG8_BAR; }
        if constexpr (!Epi::AFTER_DRAIN) { E(acc, cur, wr, wc, fr, fq); S.done(cur); }
        if (!has_next) break;
        if (!cur.keep) {
#pragma unroll
        for (int a = 0; a < 2; ++a)
#pragma unroll
            for (int b = 0; b < 2; ++b)
#pragma unroll
                for (int m = 0; m < 4; ++m)
#pragma unroll
                    for (int n = 0; n < 2; ++n) acc[a][b][m][n] = (f32x4){0.f, 0.f, 0.f, 0.f};
        }
        cur = nxt; cA = nA; cB = nB; nt = cur.nt; ++ui;
        if constexpr (ALIGN_EPI) { if (wr == 1) PG8_BAR; }
    }
    PG8_WAIT_V(0);
    if constexpr (!ALIGN_EPI) { if (wr == 0) PG8_BAR; }
    PG8_BAR;
    if constexpr (Epi::AFTER_DRAIN) { E.fused(acc, cur, wr, wc, fr, fq, lds, wid, lane); S.done(cur); }
#undef PG8_SA
#undef PG8_SB
#undef PG8_STAGE
#undef PG8_LDA
#undef PG8_LDB
#undef PG8_MMA
#undef PG8_WAIT_V
#undef PG8_WAIT_L
#undef PG8_BAR
#undef PG8_SCHED
}
}

#define GAS __attribute__((address_space(1)))
#define LAS __attribute__((address_space(3)))
typedef GAS unsigned gu32;
#define RLX_AGENT __ATOMIC_RELAXED, __HIP_MEMORY_SCOPE_AGENT
#define LDS_WAIT() asm volatile("s_waitcnt lgkmcnt(0)" ::: "memory")
#define VM_WAIT() asm volatile("s_waitcnt vmcnt(0)" ::: "memory")
#define XB_TMO      128
#define XB_XCNT(j)  (256  + 64 * (j))
#define XB_XSUB(j)  (1280 + 64 * (j))
#define XB_XGEN(j)  (2304 + 64 * (j))
#define XB_TOP      3328
#define XB_TOPGEN   3392
#define XCD_BAR_WORDS 3456
#define XB_SPIN_CAP (1u << 20)
__device__ __forceinline__ unsigned xb_ld(unsigned* p)              { return __hip_atomic_load(p, __ATOMIC_RELAXED, __HIP_MEMORY_SCOPE_AGENT); }
__device__ __forceinline__ unsigned xb_add(unsigned* p, unsigned v) { return __hip_atomic_fetch_add(p, v, __ATOMIC_RELAXED, __HIP_MEMORY_SCOPE_AGENT); }
__device__ __forceinline__ unsigned xb_xcc_id() { return (unsigned)__builtin_amdgcn_s_getreg((3 << 11) | 20) & 0xFu; }
#define XB_SPIN(cond, bar) do { unsigned _sp = 0; while (cond) { __builtin_amdgcn_s_sleep(1); \
    if ((++_sp & 255u) == 0u) { if (xb_ld(&(bar)[XB_TMO])) break; if (_sp > XB_SPIN_CAP) { atomicAdd(&(bar)[XB_TMO], 1u); break; } } } } while (0)
struct XcdBarrier { unsigned* bar; unsigned x; volatile LAS unsigned* st; };
__device__ __forceinline__ XcdBarrier xcd_barrier_post(unsigned* bar, volatile LAS unsigned* st) {
    XcdBarrier b; b.bar = bar; b.x = xb_xcc_id(); b.st = st;
    if (threadIdx.x == 0) (void)xb_add(&bar[XB_XCNT(b.x)], 1u);
    return b;
}
__device__ __forceinline__ void xcd_barrier_complete(unsigned* bar, unsigned x, unsigned& nloc, unsigned& nx) {
    const unsigned G = gridDim.x * gridDim.y * gridDim.z;
    unsigned sum, cnt, mine, sp = 0u;
    for (;;) {
        sum = 0u; cnt = 0u; mine = 0u;
#pragma unroll
        for (unsigned j = 0; j < 16; ++j) { const unsigned c = xb_ld(&bar[XB_XCNT(j)]); sum += c; cnt += (c > 0u) ? 1u : 0u; mine = (j == x) ? c : mine; }
        if (sum == G) break;
        __builtin_amdgcn_s_sleep(1);
        if ((++sp & 255u) == 0u) { if (xb_ld(&bar[XB_TMO])) break; if (sp > XB_SPIN_CAP) { atomicAdd(&bar[XB_TMO], 1u); break; } }
    }
    nloc = mine > 0u ? mine : 1u; nx = cnt > 0u ? cnt : 1u;
}
__device__ __forceinline__ void xcd_barrier(const XcdBarrier& b) {
    asm volatile("s_waitcnt vmcnt(0)" ::: "memory");
    __syncthreads();
    if (threadIdx.x == 0) {
        unsigned* bar = b.bar;
        __builtin_amdgcn_s_waitcnt(0);
        unsigned nloc = b.st[0], nx = b.st[1];
        if (nloc == 0u) { xcd_barrier_complete(bar, b.x, nloc, nx); b.st[0] = nloc; b.st[1] = nx; }
        const unsigned old = xb_add(&bar[XB_XSUB(b.x)], 1u);
        const unsigned gen = old / nloc;
        if (old + 1u == (gen + 1u) * nloc) {
            __builtin_amdgcn_fence(__ATOMIC_RELEASE, "agent");
            asm volatile("s_waitcnt vmcnt(0)" ::: "memory");
            const unsigned og = xb_add(&bar[XB_TOP], 1u);
            const unsigned tg = og / nx;
            if (og + 1u == (tg + 1u) * nx) xb_add(&bar[XB_TOPGEN], 1u);
            else XB_SPIN(xb_ld(&bar[XB_TOPGEN]) == tg, bar);
            __builtin_amdgcn_fence(__ATOMIC_ACQUIRE, "agent");
            xb_add(&bar[XB_XGEN(b.x)], 1u);
            asm volatile("s_waitcnt vmcnt(0)" ::: "memory");
        } else {
            XB_SPIN(xb_ld(&bar[XB_XGEN(b.x)]) == gen, bar);
            __builtin_amdgcn_fence(__ATOMIC_ACQUIRE, "agent");
            asm volatile("s_waitcnt vmcnt(0)" ::: "memory");
        }
    }
    __syncthreads();
}

constexpr int NWAVES = 8;
constexpr int RING_OFF = 0, RING_BYTES = 131072;
constexpr int LDSCTL_OFF = RING_BYTES, MISC_OFF = LDSCTL_OFF + 320;
constexpr int LDS_BYTES = 147456;
constexpr int CW_TMO = 0, CW_CODE = 1, CW_BAR = 4096, CW_QUEUE = 8192, CW_MKV = 10240, CW_TIME = 12288, CW_SEAM = 16384;
constexpr size_t CTL_ZERO_BYTES = 1 * MiB;

struct Frame {
    LAS unsigned char* lds; volatile LAS unsigned* MISC; unsigned* ctl;
    int tid, lane, wave, vcu, G;
    unsigned long long tprev;
    Bufs B;
};

__device__ __forceinline__ void p0_transpose_item(const Bufs& B, int kind, int N, size_t dst_off, LAS float* scr, int item, int lane) {
    const int nblk = N / 32, kb = item / nblk, nb = item % nblk, k0 = 64 * kb, n0 = 32 * nb;
#pragma unroll
    for (int h = 0; h < 2; ++h) { float tv[16];
#pragma unroll
        for (int i = 0; i < 16; ++i) tv[i] = wsrc(B, kind, k0 + 2 * (16 * h + i) + (lane >> 5), n0 + (lane & 31));
#pragma unroll
        for (int i = 0; i < 16; ++i) scr[(2 * (16 * h + i) + (lane >> 5)) * 33 + (lane & 31)] = tv[i]; }
    LDS_WAIT(); asm volatile("" ::: "memory");
    const int c = lane & 7; bf16* WT = WSP(bf16, dst_off);
#pragma unroll
    for (int j = 0; j < 4; ++j) { const int n = (lane >> 3) + 8 * j; const LAS float* s = scr + (8 * c) * 33 + n;
        v4u o; o.x = pk2(s[0 * 33], s[1 * 33]); o.y = pk2(s[2 * 33], s[3 * 33]); o.z = pk2(s[4 * 33], s[5 * 33]); o.w = pk2(s[6 * 33], s[7 * 33]);
        *(v4u*)(WT + (size_t)(n0 + n) * 1024 + k0 + 8 * c) = o; }
    LDS_WAIT(); asm volatile("" ::: "memory");
}
__device__ __forceinline__ float wave_sum(float v) {
#pragma unroll
    for (int o = 1; o < 64; o <<= 1) v += __shfl_xor(v, o);
    return v;
}
__device__ __forceinline__ void ln_in_rows(const Bufs& B, int gw, int NGW, int lane) {
    f32x4 v[4], nx[4];
    if (gw < M) { const f32x4* xr = (const f32x4*)(B.x + (size_t)gw * D) + lane;
#pragma unroll
        for (int j = 0; j < 4; ++j) v[j] = __builtin_nontemporal_load(xr + 64 * j); }
    f32x4 g[4], b[4];
#pragma unroll
    for (int j = 0; j < 4; ++j) { g[j] = *((const f32x4*)B.ln_in_g + lane + 64 * j); b[j] = *((const f32x4*)B.ln_in_b + lane + 64 * j); }
    for (int row = gw; row < M; row += NGW) {
        const int nr = row + NGW;
        if (nr < M) { const f32x4* xr = (const f32x4*)(B.x + (size_t)nr * D) + lane;
#pragma unroll
            for (int j = 0; j < 4; ++j) nx[j] = __builtin_nontemporal_load(xr + 64 * j); }
        float s = 0.f;
#pragma unroll
        for (int j = 0; j < 4; ++j) s += (v[j].x + v[j].y) + (v[j].z + v[j].w);
        const float mean = wave_sum(s) * (1.f / D); float s2 = 0.f;
#pragma unroll
        for (int j = 0; j < 4; ++j) { v[j] = v[j] - mean; s2 += (v[j].x * v[j].x + v[j].y * v[j].y) + (v[j].z * v[j].z + v[j].w * v[j].w); }
        const float rstd = rsqrtf(wave_sum(s2) * (1.f / D) + LN_EPS);
        if (lane == 0) { float* st = WSP(float, WS_STATS) + (size_t)row * 2; st[0] = mean; st[1] = rstd; }
        unsigned long long* o8 = (unsigned long long*)(WSP(bf16, WS_XN) + (size_t)row * D) + lane;
#pragma unroll
        for (int j = 0; j < 4; ++j) { const f32x4 y = v[j] * rstd * g[j] + b[j];
            o8[64 * j] = (unsigned long long)pk2(y.x, y.y) | ((unsigned long long)pk2(y.z, y.w) << 32); }
#pragma unroll
        for (int j = 0; j < 4; ++j) v[j] = nx[j];
    }
}
__device__ __forceinline__ void p0_prologue(Frame& F) {
    const Bufs& B = F.B;
    LAS float* scr = (LAS float*)(F.lds + RING_OFF + F.wave * 16384);
    const int gw = F.vcu * NWAVES + F.wave, NGW = F.G * NWAVES;
    constexpr int I0 = 16 * (NPOS / 32), I2 = 16 * 32;
    constexpr int NITEMS = I0 + 4 * I2;
    for (int it = gw; it < NITEMS; it += NGW) {
        int r = it;
        if (r < I0) { p0_transpose_item(B, 0, NPOS, WS_WIN, scr, r, (int)(threadIdx.x & 63u)); continue; } r -= I0;
        if (r < I2) { p0_transpose_item(B, 2, 1024, WS_WMEM, scr, r, (int)(threadIdx.x & 63u)); continue; } r -= I2;
        if (r < I2) { p0_transpose_item(B, 3, 1024, WS_WAB, scr, r, (int)(threadIdx.x & 63u)); continue; } r -= I2;
        if (r < I2) { p0_transpose_item(B, 4, 1024, WS_WC, scr, r, (int)(threadIdx.x & 63u)); continue; } r -= I2;
        p0_transpose_item(B, 5, 1024, WS_WOUT, scr, r, (int)(threadIdx.x & 63u));
    }
    ln_in_rows(B, gw, NGW, (int)(threadIdx.x & 63u));
    const int gid = gw * 64 + (int)(threadIdx.x & 63u), nth = NGW * 64;
    for (int i = gid; i < MM * D / 4; i += nth) { const f32x4 v = __builtin_nontemporal_load((const f32x4*)B.mem + i); ((unsigned long long*)WSP(bf16, WS_MEMB))[i] = (unsigned long long)pk2(v.x, v.y) | ((unsigned long long)pk2(v.z, v.w) << 32); }
    for (int i = gid; i < SEQ * 8; i += nth) { const int pos = i >> 3, f = i & 7;
        const float inv = powf(500000.0f, -(float)f * 0.125f); const float ang = (float)pos * inv;
        float* t64 = WSP(float, WS_TAB) + pos * 16; t64[f] = cosf(ang); t64[8 + f] = sinf(ang);
        if ((f & 1) == 0) { float* t32 = WSP(float, WS_TAB32) + pos * 8; t32[f >> 1] = cosf(ang); t32[4 + (f >> 1)] = sinf(ang); } }
    if (gid == 0) { float a = 0.f, b = 0.f; for (int i = 0; i < 64; ++i) { a += B.diff_lambda[i] * B.diff_lambda[64 + i]; b += B.diff_lambda[128 + i] * B.diff_lambda[192 + i]; }
        *WSP(float, WS_LAM) = expf(a) - expf(b) + LAM_INIT; }
}

struct SchedOne {
    int pm, pn; const char* MEMB; const char* WMEM;
    __device__ __forceinline__ bool next(int i, pg8::Unit& u) const {
        if (i > 0) return false;
        u.pm = pm; u.pn = pn; u.A = MEMB + (size_t)pm * pg8::TSTEP; u.B = WMEM + (size_t)pn * pg8::TSTEP; u.nt = 16; u.kind = 1; u.keep = 0; return true;
    }
    __device__ __forceinline__ void a_ready(const pg8::Unit&) const {}
    __device__ __forceinline__ void done(const pg8::Unit&) const {}
};
struct SchedIn {
    pg8::TileOrder T; int G, c; const char* XN; const char* WIN; const char* MEMB; const char* WMEM;
    __device__ __forceinline__ bool next(int i, pg8::Unit& u) const {
        const int L = i * G + c;
        if (L < T.nwg) { T.tile(L, u.pm, u.pn); u.A = XN + (size_t)u.pm * pg8::TSTEP; u.B = WIN + (size_t)u.pn * pg8::TSTEP; u.nt = 16; u.kind = 0; u.keep = 0; return true; }
        return false;
    }
    __device__ __forceinline__ void a_ready(const pg8::Unit&) const {}
    __device__ __forceinline__ void done(const pg8::Unit&) const {}
};
template <int KIND> __device__ __forceinline__ void epi_in_loops(const Bufs& B, const pg8::f32x4 (&acc)[2][2][4][2], int row0, int c0) {
#pragma unroll
    for (int ai = 0; ai < 2; ++ai)
#pragma unroll
        for (int m = 0; m < 4; ++m)
#pragma unroll
            for (int bj = 0; bj < 2; ++bj) {
                float v[8] = {acc[ai][bj][m][0][0], acc[ai][bj][m][0][1], acc[ai][bj][m][0][2], acc[ai][bj][m][0][3], acc[ai][bj][m][1][0], acc[ai][bj][m][1][1], acc[ai][bj][m][1][2], acc[ai][bj][m][1][3]};
                const int row = row0 + ai * 128 + m * 16, c = c0 + bj * 128;
                if constexpr (KIND == 100) store8(WSP(bf16, WS_MKV) + (size_t)row * 1024 + c, v);
                else emit8k<KIND>(B, row, c, v);
            }
}
struct EpiIn {
    static constexpr bool PERM = true, AFTER_DRAIN = false; Bufs B;
    __device__ __forceinline__ void operator()(const pg8::f32x4 (&acc)[2][2][4][2], const pg8::Unit& u, int wr, int wc, int fr, int fq) const {
        const int row0 = u.pm * 256 + wr * 64 + fr, cw = wc * 32 + 8 * fq;
        if (u.kind == 1) { epi_in_loops<100>(B, acc, row0, u.pn * 256 + cw); return; }
        const int c0 = (u.pn < 16 ? (u.pn & 1) * 256 : (u.pn < 18 ? 0 : (u.pn - 18) * 256)) + cw;
        switch (kind_of_tile(u.pn)) {
        case K_AQ: epi_in_loops<K_AQ>(B, acc, row0, c0); break;  case K_AG: epi_in_loops<K_AG>(B, acc, row0, c0); break;
        case K_BQ: epi_in_loops<K_BQ>(B, acc, row0, c0); break;  case K_BK: epi_in_loops<K_BK>(B, acc, row0, c0); break;
        case K_BV: epi_in_loops<K_BV>(B, acc, row0, c0); break;  case K_BG: epi_in_loops<K_BG>(B, acc, row0, c0); break;
        case K_CQ: epi_in_loops<K_CQ>(B, acc, row0, c0); break;  case K_CG: epi_in_loops<K_CG>(B, acc, row0, c0); break;
        case K_IQ: epi_in_loops<K_IQ>(B, acc, row0, c0); break;  case K_MG: epi_in_loops<K_MG>(B, acc, row0, c0); break;  default:   epi_in_loops<K_MISC>(B, acc, row0, c0); break;
        }
    }
};

#ifndef PROBE_DRY
#define PROBE_DRY 0
#endif
#ifndef PROBE_DMODE
#define PROBE_DMODE 1
#endif
#ifndef FAST_A
#define FAST_A 1
#endif
#ifndef FAST_B
#define FAST_B 1
#endif
#ifndef FAST_C
#define FAST_C 1
#endif
#ifndef TIMING_SEL
#define TIMING_SEL -1
#endif
#define TIMING (TIMING_SEL >= 0)
#define TST(k) do { if (TIMING && threadIdx.x == 0) { const unsigned now_ = (unsigned)__builtin_amdgcn_s_memrealtime(); F.MISC[16 + (k)] += now_ - F.MISC[14]; F.MISC[14] = now_; } } while (0)
namespace att {
typedef short bf16x8 __attribute__((ext_vector_type(8)));
typedef short v4i16_t __attribute__((ext_vector_type(4)));
typedef float f32x16 __attribute__((ext_vector_type(16)));
constexpr int L_K = 0, L_V = 32768, L_MASK = 131072 + 1024, L_X = 65536, L_NG = 141312;
constexpr float NEG_BIG = -1.0e30f;

__device__ __forceinline__ float hswap_max(float v) { auto rr = __builtin_amdgcn_permlane32_swap(__float_as_uint(v), __float_as_uint(v), false, false); return fmaxf(__uint_as_float(rr[0]), __uint_as_float(rr[1])); }
__device__ __forceinline__ float hswap_sum(float v) { auto rr = __builtin_amdgcn_permlane32_swap(__float_as_uint(v), __float_as_uint(v), false, false); return __uint_as_float(rr[0]) + __uint_as_float(rr[1]); }
__device__ __forceinline__ unsigned cvtpk(float lo, float hi) { typedef float f2 __attribute__((ext_vector_type(2))); typedef __bf16 b2 __attribute__((ext_vector_type(2))); f2 v = {lo, hi}; b2 b = __builtin_convertvector(v, b2); return __builtin_bit_cast(unsigned, b); }

template <int DQK, int DV> struct WState { bf16x8 qf[DQK / 16]; f32x16 o[DV / 32]; float m, l; };

template <int KPB> __device__ __forceinline__ int ksw(int row) { return KPB == 128 ? ((row >> 1) & 7) : (row & 15); }
template <int KPB, int DV> struct Stage {
    static constexpr int NK = KPB / 128, NV = DV / 64;
    v4u kr[NK], vr[NV];
    __device__ __forceinline__ void load(const char* kg, size_t kpitch, const char* vg, size_t vpitch, int key0, int tid) {
#pragma unroll
        for (int i = 0; i < NK; ++i) { const int idx = tid + 512 * i, key = idx / (KPB / 16), ch = idx % (KPB / 16); kr[i] = *(const v4u*)(kg + (size_t)(key0 + key) * kpitch + ch * 16); }
#pragma unroll
        for (int i = 0; i < NV; ++i) { const int idx = tid + 512 * i, key = idx / (DV / 8), ch = idx % (DV / 8); vr[i] = *(const v4u*)(vg + (size_t)(key0 + key) * vpitch + ch * 16); }
    }
    __device__ __forceinline__ void store(LAS unsigned char* lds, int buf, int tid) const {
#pragma unroll
        for (int i = 0; i < NK; ++i) { const int idx = tid + 512 * i, key = idx / (KPB / 16), ch = idx % (KPB / 16); *(LAS v4u*)(lds + L_K + buf * 16384 + key * KPB + ((ch ^ ksw<KPB>(key)) << 4)) = kr[i]; }
#pragma unroll
        for (int i = 0; i < NV; ++i) { const int idx = tid + 512 * i, key = idx / (DV / 8), ch = idx % (DV / 8); *(LAS v4u*)(lds + L_V + buf * 16384 + (ch >> 2) * 4096 + key * 64 + (ch & 3) * 16) = vr[i]; }
    }
};

template <int DQK, int DV, int KPB, bool MASKED>
__device__ __forceinline__ void tile_compute(WState<DQK, DV>& W, LAS unsigned char* lds, int buf, int kc0, int lane, const LAS unsigned* mrow  , int koff = -1, int voff = -1) {
    const int r32 = lane & 31, hi = lane >> 5;
    const LAS unsigned char* kb = lds + (koff >= 0 ? koff : L_K + buf * 16384);
    const LAS unsigned char* vb = lds + (voff >= 0 ? voff : L_V + buf * 16384) + ((lane >> 4) & 1) * 32 + (lane & 3) * 8 + (4 * hi + ((lane & 15) >> 2)) * 64;
#pragma unroll
    for (int kh = 0; kh < 2; ++kh) {
        const int row = 32 * kh + r32;
        f32x16 s = {};
#pragma unroll
        for (int ks = 0; ks < DQK / 16; ++ks) {
            const bf16x8 kf = *(const LAS bf16x8*)(kb + row * KPB + (((kc0 + 2 * ks + hi) ^ ksw<KPB>(row)) << 4));
            s = __builtin_amdgcn_mfma_f32_32x32x16_bf16(kf, W.qf[ks], s, 0, 0, 0);
        }
        if constexpr (MASKED) {
            const unsigned wsh = mrow[kh] >> (4 * hi);
#pragma unroll
            for (int r = 0; r < 16; ++r) { const unsigned mm = (unsigned)__builtin_amdgcn_sbfe((int)wsh, (r & 3) + 8 * (r >> 2), 1); s[r] = __uint_as_float((__float_as_uint(s[r]) & mm) | (0xFF800000u & ~mm)); }
        }
        float mx = s[0];
#pragma unroll
        for (int r = 1; r < 16; ++r) mx = fmaxf(mx, s[r]);
        mx = hswap_max(mx);
        const float mn = fmaxf(W.m, mx), alpha = __builtin_amdgcn_exp2f(W.m - mn);
        W.m = mn;
        float ps = 0.f;
#pragma unroll
        for (int r = 0; r < 16; ++r) { s[r] = __builtin_amdgcn_exp2f(s[r] - mn); ps += s[r]; }
        W.l = W.l * alpha + ps;
        if (__any(alpha != 1.0f)) {
#pragma unroll
            for (int dt = 0; dt < DV / 32; ++dt)
#pragma unroll
                for (int r = 0; r < 16; ++r) W.o[dt][r] *= alpha;
        }
        v4u pw0, pw1;
        pw0.x = cvtpk(s[0], s[1]); pw0.y = cvtpk(s[2], s[3]); pw0.z = cvtpk(s[4], s[5]); pw0.w = cvtpk(s[6], s[7]);
        pw1.x = cvtpk(s[8], s[9]); pw1.y = cvtpk(s[10], s[11]); pw1.z = cvtpk(s[12], s[13]); pw1.w = cvtpk(s[14], s[15]);
        const bf16x8 pf0 = __builtin_bit_cast(bf16x8, pw0), pf1 = __builtin_bit_cast(bf16x8, pw1);
#pragma unroll
        for (int dt = 0; dt < DV / 32; ++dt) {
#pragma unroll
            for (int sidx = 0; sidx < 2; ++sidx) {
                const LAS unsigned char* p = vb + dt * 4096 + (32 * kh + 16 * sidx) * 64;
                const v4i16_t lo = __builtin_amdgcn_ds_read_tr16_b64_v4i16((LAS v4i16_t*)p);
                const v4i16_t hh = __builtin_amdgcn_ds_read_tr16_b64_v4i16((LAS v4i16_t*)(p + 512));
                const bf16x8 vf = (bf16x8){lo[0], lo[1], lo[2], lo[3], hh[0], hh[1], hh[2], hh[3]};
                W.o[dt] = __builtin_amdgcn_mfma_f32_32x32x16_bf16(vf, sidx == 0 ? pf0 : pf1, W.o[dt], 0, 0, 0);
            }
        }
    }
}

template <int DQK, int DV, int KPB, bool MASKED>
__device__ __forceinline__ void tile_loop_simple(WState<DQK, DV>& W, LAS unsigned char* lds, const char* kg, size_t kpitch, const char* vg, size_t vpitch, int nT, int my_nt, int kc0, int tid, int lane, const LAS unsigned* mq) {
    Stage<KPB, DV> st;
    st.load(kg, kpitch, vg, vpitch, 0, tid); st.store(lds, 0, tid);
    __syncthreads();
    for (int t = 0; t < nT; ++t) {
        if (t + 1 < nT) st.load(kg, kpitch, vg, vpitch, 64 * (t + 1), tid);
        if (t < my_nt) tile_compute<DQK, DV, KPB, MASKED>(W, lds, t & 1, kc0, lane, MASKED ? mq + 2 * t : mq);
        if (t + 1 < nT) st.store(lds, (t + 1) & 1, tid);
        __syncthreads();
    }
}
template <int KPB> struct StageK {
    static constexpr int NK = KPB / 128; v4u kr[NK];
    __device__ __forceinline__ void load(const char* kg, size_t kpitch, int key0, int tid) {
#pragma unroll
        for (int i = 0; i < NK; ++i) { const int idx = tid + 512 * i, key = idx / (KPB / 16), ch = idx % (KPB / 16); kr[i] = *(const v4u*)(kg + (size_t)(key0 + key) * kpitch + ch * 16); }
    }
    __device__ __forceinline__ void store(LAS unsigned char* lds, int slot, int tid) const {
#pragma unroll
        for (int i = 0; i < NK; ++i) { const int idx = tid + 512 * i, key = idx / (KPB / 16), ch = idx % (KPB / 16); *(LAS v4u*)(lds + L_K + slot * 16384 + key * KPB + ((ch ^ ksw<KPB>(key)) << 4)) = kr[i]; }
    }
};
template <int DV> struct StageV {
    static constexpr int NV = DV / 64; v4u vr[NV];
    __device__ __forceinline__ void load(const char* vg, size_t vpitch, int key0, int tid) {
#pragma unroll
        for (int i = 0; i < NV; ++i) { const int idx = tid + 512 * i, key = idx / (DV / 8), ch = idx % (DV / 8); vr[i] = *(const v4u*)(vg + (size_t)(key0 + key) * vpitch + ch * 16); }
    }
    __device__ __forceinline__ void store(LAS unsigned char* lds, int slot, int tid) const { store_off(lds, slot * 16384, tid); }
    __device__ __forceinline__ void store_off(LAS unsigned char* lds, int off, int tid) const {
#pragma unroll
        for (int i = 0; i < NV; ++i) { const int idx = tid + 512 * i, key = idx / (DV / 8), ch = idx % (DV / 8); *(LAS v4u*)(lds + L_V + off + (ch >> 2) * 4096 + key * 64 + (ch & 3) * 16) = vr[i]; }
    }
};
#define SBAR() __builtin_amdgcn_sched_barrier(0)
template <int DQK, int KPB> __device__ __forceinline__ void k_frags(bf16x8 (&kf)[DQK / 16], const LAS unsigned char* kb, int kc0, int r32, int hi, int kh) {
    const int row = 32 * kh + r32;
#pragma unroll
    for (int ks = 0; ks < DQK / 16; ++ks) kf[ks] = *(const LAS bf16x8*)(kb + row * KPB + (((kc0 + 2 * ks + hi) ^ ksw<KPB>(row)) << 4));
}
template <int DQK, int KPB> __device__ __forceinline__ void qk_tile(f32x16 (&s)[2], const bf16x8* qf, const LAS unsigned char* kb, int kc0, int r32, int hi) {
    bf16x8 kf0[DQK / 16], kf1[DQK / 16]; k_frags<DQK, KPB>(kf0, kb, kc0, r32, hi, 0); k_frags<DQK, KPB>(kf1, kb, kc0, r32, hi, 1);
    f32x16 a = {}, b = {};
#pragma unroll
    for (int ks = 0; ks < DQK / 16; ++ks) a = __builtin_amdgcn_mfma_f32_32x32x16_bf16(kf0[ks], qf[ks], a, 0, 0, 0);
#pragma unroll
    for (int ks = 0; ks < DQK / 16; ++ks) b = __builtin_amdgcn_mfma_f32_32x32x16_bf16(kf1[ks], qf[ks], b, 0, 0, 0);
    s[0] = a; s[1] = b;
}
template <int DQK, int DV, int KPB, bool MASKED> __device__ __forceinline__ void step_sm(WState<DQK, DV>& W, f32x16 (&sc)[2], f32x16 (&sn)[2], bf16x8 (&pf)[4], const LAS unsigned char* kb_next, int kc0, int lane, const LAS unsigned* mrow) {
    const int r32 = lane & 31, hi = lane >> 5;
    bf16x8 kf0[DQK / 16]; k_frags<DQK, KPB>(kf0, kb_next, kc0, r32, hi, 0);
    if constexpr (MASKED) {
#pragma unroll
        for (int kh = 0; kh < 2; ++kh) { const unsigned wsh = mrow[kh] >> (4 * hi);
#pragma unroll
            for (int r = 0; r < 16; ++r) { const unsigned mm = (unsigned)__builtin_amdgcn_sbfe((int)wsh, (r & 3) + 8 * (r >> 2), 1); sc[kh][r] = __uint_as_float((__float_as_uint(sc[kh][r]) & mm) | (0xFF800000u & ~mm)); } }
    }
    float mx = fmaxf(sc[0][0], sc[1][0]);
#pragma unroll
    for (int r = 1; r < 16; ++r) mx = fmaxf(fmaxf(mx, sc[0][r]), sc[1][r]);
    mx = hswap_max(mx);
    const float mn = (mx > W.m + 8.0f) ? mx : W.m, alpha = __builtin_amdgcn_exp2f(W.m - mn);
    W.m = mn;
    if (__any(alpha != 1.0f)) {
#pragma unroll
        for (int dt = 0; dt < DV / 32; ++dt)
#pragma unroll
            for (int r = 0; r < 16; ++r) W.o[dt][r] *= alpha;
    }
    SBAR();
    float mn_ = mn; asm volatile("" : "+v"(kf0[0]), "+v"(mn_));
    float ps0 = 0.f, ps1 = 0.f;
    { f32x16 a = {}, b = {};
#pragma unroll
      for (int ks = 0; ks < DQK / 16; ++ks) a = __builtin_amdgcn_mfma_f32_32x32x16_bf16(kf0[ks], W.qf[ks], a, 0, 0, 0);
      k_frags<DQK, KPB>(kf0, kb_next, kc0, r32, hi, 1);
#pragma unroll
      for (int ks = 0; ks < DQK / 16; ++ks) b = __builtin_amdgcn_mfma_f32_32x32x16_bf16(kf0[ks], W.qf[ks], b, 0, 0, 0);
      sn[0] = a; sn[1] = b; }
#pragma unroll
    for (int r = 0; r < 16; ++r) { sc[0][r] = __builtin_amdgcn_exp2f(sc[0][r] - mn_); ps0 += sc[0][r]; sc[1][r] = __builtin_amdgcn_exp2f(sc[1][r] - mn_); ps1 += sc[1][r]; }
#pragma unroll
    for (int i = 0; i < 2 * (DQK / 16); ++i) { __builtin_amdgcn_sched_group_barrier(0x008, 1, 0); __builtin_amdgcn_sched_group_barrier(0x002, (96 + 2 * (DQK / 16) - 1) / (2 * (DQK / 16)), 0); }
    SBAR();
    W.l = W.l * alpha + (ps0 + ps1);
#pragma unroll
    for (int kh = 0; kh < 2; ++kh) { v4u a, b;
        a.x = cvtpk(sc[kh][0], sc[kh][1]); a.y = cvtpk(sc[kh][2], sc[kh][3]); a.z = cvtpk(sc[kh][4], sc[kh][5]); a.w = cvtpk(sc[kh][6], sc[kh][7]);
        b.x = cvtpk(sc[kh][8], sc[kh][9]); b.y = cvtpk(sc[kh][10], sc[kh][11]); b.z = cvtpk(sc[kh][12], sc[kh][13]); b.w = cvtpk(sc[kh][14], sc[kh][15]);
        pf[2 * kh] = __builtin_bit_cast(bf16x8, a); pf[2 * kh + 1] = __builtin_bit_cast(bf16x8, b); }
}
template <int DQK, int DV> __device__ __forceinline__ void step_pv(WState<DQK, DV>& W, const bf16x8 (&pf)[4], const LAS unsigned char* vbase, int lane) {
    const int hi = lane >> 5;
    const LAS unsigned char* vb = vbase + ((lane >> 4) & 1) * 32 + (lane & 3) * 8 + (4 * hi + ((lane & 15) >> 2)) * 64;
    if constexpr (DV <= 64) {
        v4i16_t vl[2][4], vh[2][4];
#pragma unroll
        for (int k4 = 0; k4 < 4; ++k4) { vl[0][k4] = __builtin_amdgcn_ds_read_tr16_b64_v4i16((LAS v4i16_t*)(vb + (16 * k4) * 64)); vh[0][k4] = __builtin_amdgcn_ds_read_tr16_b64_v4i16((LAS v4i16_t*)(vb + (16 * k4) * 64 + 512)); }
#pragma unroll
        for (int dt = 0; dt < DV / 32; ++dt) {
            if (dt + 1 < DV / 32) {
#pragma unroll
                for (int k4 = 0; k4 < 4; ++k4) { vl[(dt + 1) & 1][k4] = __builtin_amdgcn_ds_read_tr16_b64_v4i16((LAS v4i16_t*)(vb + (dt + 1) * 4096 + (16 * k4) * 64)); vh[(dt + 1) & 1][k4] = __builtin_amdgcn_ds_read_tr16_b64_v4i16((LAS v4i16_t*)(vb + (dt + 1) * 4096 + (16 * k4) * 64 + 512)); }
            }
            SBAR();
#pragma unroll
            for (int k4 = 0; k4 < 4; ++k4) { const v4i16_t lo = vl[dt & 1][k4], hh = vh[dt & 1][k4];
                const bf16x8 vf = (bf16x8){lo[0], lo[1], lo[2], lo[3], hh[0], hh[1], hh[2], hh[3]};
                W.o[dt] = __builtin_amdgcn_mfma_f32_32x32x16_bf16(vf, pf[k4], W.o[dt], 0, 0, 0); }
            SBAR();
        }
    } else {
#pragma unroll
        for (int dt = 0; dt < DV / 32; ++dt) {
            v4i16_t vl[4], vh[4];
#pragma unroll
            for (int k4 = 0; k4 < 4; ++k4) { vl[k4] = __builtin_amdgcn_ds_read_tr16_b64_v4i16((LAS v4i16_t*)(vb + dt * 4096 + (16 * k4) * 64)); vh[k4] = __builtin_amdgcn_ds_read_tr16_b64_v4i16((LAS v4i16_t*)(vb + dt * 4096 + (16 * k4) * 64 + 512)); }
            SBAR();
#pragma unroll
            for (int k4 = 0; k4 < 4; ++k4) { const v4i16_t lo = vl[k4], hh = vh[k4];
                const bf16x8 vf = (bf16x8){lo[0], lo[1], lo[2], lo[3], hh[0], hh[1], hh[2], hh[3]};
                W.o[dt] = __builtin_amdgcn_mfma_f32_32x32x16_bf16(vf, pf[k4], W.o[dt], 0, 0, 0); }
            SBAR();
        }
    }
}
template <int DQK, int DV, int KPB, bool MASKED>
__device__ __forceinline__ void tile_loop(WState<DQK, DV>& W, LAS unsigned char* lds, const char* kg, size_t kpitch, const char* vg, size_t vpitch, int nT, int my_nt, int kc0, int tid, int lane, const LAS unsigned* mq, int mode = 0) {
    const int r32 = lane & 31, hi = lane >> 5;
    const bool lag = __builtin_amdgcn_readfirstlane(tid) >= 256;
    StageK<KPB> sk; StageV<DV> sv;
    sk.load(kg, kpitch, 0, tid); sv.load(vg, vpitch, 0, tid); sk.store(lds, 0, tid); sv.store(lds, 0, tid);
    if (nT > 1) { sk.load(kg, kpitch, 64, tid); sk.store(lds, 1, tid); }
    __syncthreads();
    f32x16 sc[2], sn[2]; bf16x8 pf[4];
    qk_tile<DQK, KPB>(sc, W.qf, lds + L_K, kc0, r32, hi);
    __syncthreads();
    volatile LAS unsigned* mstat = (volatile LAS unsigned*)(lds + MISC_OFF + 64);
    const bool tw = TIMING && (tid == 0);
    int vs_prev = 0, vs_cur = 0, vs_next = 16384;
    for (int t = 0; t < nT; ++t) {
        if (t + 2 < nT && mode != 3) sk.load(kg, kpitch, 64 * (t + 2), tid);
        if (t + 1 < nT && mode != 3) sv.load(vg, vpitch, 64 * (t + 1), tid);
        if (mode != 2 && t < my_nt) {
            if (lag && t > 0) step_pv<DQK, DV>(W, pf, lds + L_V + vs_prev, lane);
            step_sm<DQK, DV, KPB, MASKED>(W, sc, sn, pf, lds + L_K + ((t + 1) & 1) * 16384, kc0, lane, MASKED ? mq + 2 * t : mq);
            if (!lag) step_pv<DQK, DV>(W, pf, lds + L_V + vs_cur, lane);
#pragma unroll
            for (int r = 0; r < 16; ++r) { sc[0][r] = sn[0][r]; sc[1][r] = sn[1][r]; }
        }
        if (t + 2 < nT && mode != 3) sk.store(lds, t & 1, tid);
        if (t + 1 < nT && mode != 3) sv.store_off(lds, vs_next, tid);
        asm volatile("s_waitcnt vmcnt(0) lgkmcnt(0)" ::: "memory");
        __syncthreads();
        vs_prev = vs_cur; vs_cur = vs_next; vs_next = (vs_next == 32768) ? 0 : vs_next + 16384;
    }
    if (lag && mode != 2 && my_nt > 0) step_pv<DQK, DV>(W, pf, lds + L_V + vs_prev, lane);
    __syncthreads();
}
template <int DQK, int DV> __device__ __forceinline__ void wstate_init(WState<DQK, DV>& W, const bf16* qrow  , int hi) {
#pragma unroll
    for (int ks = 0; ks < DQK / 16; ++ks) W.qf[ks] = *(const bf16x8*)(qrow + 16 * ks + 8 * hi);
#pragma unroll
    for (int dt = 0; dt < DV / 32; ++dt) W.o[dt] = (f32x16){};
    W.m = NEG_BIG; W.l = 0.f;
}

__device__ __forceinline__ unsigned skey(float score, int idx) {
    const unsigned b = __float_as_uint(score); const unsigned k = b ^ ((unsigned)((int)b >> 31) | 0x80000000u);
    return ((k >> 1) & 0x7FFFF800u) | (unsigned)(2047 - idx);
}
__device__ __forceinline__ unsigned dpp_u(unsigned v, int ctrl_sel) {
    switch (ctrl_sel) {
    case 0: return (unsigned)__builtin_amdgcn_update_dpp(0, (int)v, 0xB1, 0xF, 0xF, true);
    case 1: return (unsigned)__builtin_amdgcn_update_dpp(0, (int)v, 0x4E, 0xF, 0xF, true);
    case 2: return (unsigned)__builtin_amdgcn_update_dpp(0, (int)v, 0x141, 0xF, 0xF, true);
    default: return (unsigned)__builtin_amdgcn_update_dpp(0, (int)v, 0x140, 0xF, 0xF, true);
    }
}
__device__ __forceinline__ unsigned half_sum(unsigned v, int hi) {
#pragma unroll
    for (int s = 0; s < 4; ++s) v += dpp_u(v, s);
    const unsigned s0 = (unsigned)__builtin_amdgcn_readlane((int)v, 0) + (unsigned)__builtin_amdgcn_readlane((int)v, 16), s1 = (unsigned)__builtin_amdgcn_readlane((int)v, 32) + (unsigned)__builtin_amdgcn_readlane((int)v, 48);
    return hi ? s1 : s0;
}
__device__ __forceinline__ float half_sumf(float v, int hi) {
#pragma unroll
    for (int s = 0; s < 4; ++s) v += __uint_as_float(dpp_u(__float_as_uint(v), s));
    const float s0 = __uint_as_float((unsigned)__builtin_amdgcn_readlane((int)__float_as_uint(v), 0)) + __uint_as_float((unsigned)__builtin_amdgcn_readlane((int)__float_as_uint(v), 16));
    const float s1 = __uint_as_float((unsigned)__builtin_amdgcn_readlane((int)__float_as_uint(v), 32)) + __uint_as_float((unsigned)__builtin_amdgcn_readlane((int)__float_as_uint(v), 48));
    return hi ? s1 : s0;
}
__device__ __forceinline__ unsigned half_max(unsigned v, int hi) {
#pragma unroll
    for (int s = 0; s < 4; ++s) { const unsigned o = dpp_u(v, s); v = v > o ? v : o; }
    const unsigned a0 = (unsigned)__builtin_amdgcn_readlane((int)v, 0), a1 = (unsigned)__builtin_amdgcn_readlane((int)v, 16), b0 = (unsigned)__builtin_amdgcn_readlane((int)v, 32), b1 = (unsigned)__builtin_amdgcn_readlane((int)v, 48);
    const unsigned s0 = a0 > a1 ? a0 : a1, s1 = b0 > b1 ? b0 : b1;
    return hi ? s1 : s0;
}
__device__ __forceinline__ float unskey(unsigned k31) { const unsigned k = k31 << 1; const unsigned b = (k & 0x80000000u) ? (k ^ 0x80000000u) : ~k; return __uint_as_float(b); }
__device__ __forceinline__ unsigned skey_f(float f) { const unsigned b = __float_as_uint(f); return ((b ^ ((unsigned)((int)b >> 31) | 0x80000000u)) >> 1) & 0x7FFFF800u; }
__device__ __forceinline__ void indexer_pass(const Bufs& B, const int S, const LAS unsigned char* ikl, LAS unsigned* masks, size_t rowb, int t0, int w, int lane, int ntl, int limit, bf16x8 a0, bf16x8 a1) {
    const int r32 = lane & 31, hi = lane >> 5;
    volatile LAS unsigned* mstat = (volatile LAS unsigned*)(ikl + MISC_OFF + 64);
    unsigned long long tstart_ = 0; if (TIMING && w == 0) tstart_ = __builtin_amdgcn_s_memrealtime();
    float wt[8];
    { const float* iwp = WSP(const float, WS_IW) + (rowb + t0 + 4 * w + 2 * hi + S) * 8;
      const f32x4 v0 = *(const f32x4*)iwp, v1 = *(const f32x4*)(iwp + 4); wt[0] = v0.x; wt[1] = v0.y; wt[2] = v0.z; wt[3] = v0.w; wt[4] = v1.x; wt[5] = v1.y; wt[6] = v1.z; wt[7] = v1.w; }
    const int sw = (r32 >> 2) & 3;
    const LAS unsigned char* p0 = ikl + r32 * 64 + ((hi ^ sw) << 4);
    const LAS unsigned char* p1 = ikl + r32 * 64 + (((2 + hi) ^ sw) << 4);
    unsigned key[64]; unsigned kmax = 0u, kmin = 0xFFFFFFFFu; float sm1 = 0.f, sm2 = 0.f;
#pragma unroll
    for (int tb = 0; tb < 16; ++tb) {
        if (4 * tb < ntl) {
#pragma unroll
            for (int tt = 0; tt < 4; ++tt) { const int t = 4 * tb + tt;
                const bf16x8 b0 = *(const LAS bf16x8*)(p0 + t * 2048), b1 = *(const LAS bf16x8*)(p1 + t * 2048);
                f32x16 acc = {};
                acc = __builtin_amdgcn_mfma_f32_32x32x16_bf16(a0, b0, acc, 0, 0, 0);
                acc = __builtin_amdgcn_mfma_f32_32x32x16_bf16(a1, b1, acc, 0, 0, 0);
                float s0 = 0.f;
#pragma unroll
                for (int h = 0; h < 8; ++h) { const int ai = __float_as_int(acc[h]); s0 += wt[h] * __int_as_float(ai > 0 ? ai : 0); }
                const unsigned k = skey(s0, 32 * t + r32);
                if (tt < 2) { key[t] = k; kmax = kmax > k ? kmax : k; kmin = kmin < k ? kmin : k; sm1 += s0; sm2 = fmaf(s0, s0, sm2); }
                else { const bool valid = t < ntl; const float sv_ = valid ? s0 : 0.f; sm1 += sv_; sm2 = fmaf(sv_, sv_, sm2); key[t] = valid ? k : 0u; const unsigned kx = valid ? k : 0u, kn = valid ? k : 0xFFFFFFFFu; kmax = kmax > kx ? kmax : kx; kmin = kmin < kn ? kmin : kn; }
            }
        } else {
#pragma unroll
            for (int tt = 0; tt < 4; ++tt) key[4 * tb + tt] = 0u;
        }
    }
    unsigned long long ti0_ = 0; if (TIMING && w == 0) { ti0_ = __builtin_amdgcn_s_memrealtime(); if (lane == 0) mstat[8] += (unsigned)(ti0_ - tstart_); }
    unsigned tau = 1u;
    if (limit > 256) {
        kmax = half_max(kmax, hi); kmin = ~half_max(~kmin, hi);
        unsigned lo = kmin & ~0x7FFu, hb = kmax + 1u; float lof = unskey(lo), hbf = unskey(kmax); bool dn = false;
        float flo = (float)limit - 256.5f, fhb = -256.5f; int lastside = 0;
        const float invn = __builtin_amdgcn_rcpf((float)limit), mu = half_sumf(sm1, hi) * invn, var = fmaxf(half_sumf(sm2, hi) * invn - mu * mu, 1e-30f), sg = __builtin_amdgcn_sqrtf(var);
        const float pq = 256.5f * invn, zq = __builtin_amdgcn_logf((1.f - pq) * __builtin_amdgcn_rcpf(pq)) * 0.40726f;
        const float tau0 = fmaf(zq, sg, mu), idens = sg * __builtin_amdgcn_rcpf((float)limit * 1.702f * pq * (1.f - pq));
        float tprev = tau0;
        for (int it = 0; it < 64; ++it) {
            if (!dn && hb - lo <= 1u) { tau = lo; dn = true; }
            if (__all(dn)) break;
            if (TIMING && w == 0 && lane == 0) mstat[11] += 100u;
            unsigned mid = skey_f((lof * fhb - hbf * flo) * __builtin_amdgcn_rcpf(fhb - flo));
            if (it < 2) { const float tg = it == 0 ? tau0 : fmaf(lastside == 1 ? flo : fhb, idens, tprev); tprev = tg; const unsigned mg = skey_f(tg); mid = ((mg > lo) & (mg < hb)) ? mg : mid; }
            { const unsigned m2 = skey_f(0.5f * (lof + hbf)); const bool bad = (mid <= lo) | (mid >= hb); mid = bad ? m2 : mid; const bool bad2 = (mid <= lo) | (mid >= hb); mid = bad2 ? lo + ((hb - lo) >> 1) : mid; }
            const unsigned mm1 = mid - 1u;
            unsigned c0 = 0, c1 = 0, c2 = 0, c3 = 0;
#pragma unroll
            for (int tb = 0; tb < 4; ++tb) {
                if (16 * tb < ntl) {
                    unsigned a0_ = 0, a1_ = 0;
#pragma unroll
                    for (int tt = 0; tt < 16; tt += 2) { a0_ = __builtin_amdgcn_alignbit(a0_, mm1 - key[16 * tb + tt], 31); a1_ = __builtin_amdgcn_alignbit(a1_, mm1 - key[16 * tb + tt + 1], 31); }
                    if (tb & 1) { c1 += __builtin_popcount(a0_); c3 += __builtin_popcount(a1_); } else { c0 += __builtin_popcount(a0_); c2 += __builtin_popcount(a1_); }
                }
            }
            const unsigned c = half_sum((c0 + c1) + (c2 + c3), hi);
            if (!dn) {
                if (c == 256u) { tau = mid; dn = true; }
                else if (c > 256u) { lo = mid; lof = unskey(mid); flo = (float)c - 256.5f; if (lastside == 1) fhb *= 0.5f; lastside = 1; }
                else { hb = mid; hbf = unskey(mid); fhb = (float)c - 256.5f; if (lastside == 2) flo *= 0.5f; lastside = 2; }
            }
        }
    }
    unsigned long long ti1_ = 0; if (TIMING && w == 0) { ti1_ = __builtin_amdgcn_s_memrealtime(); if (lane == 0) mstat[9] += (unsigned)(ti1_ - ti0_); }
    LAS unsigned* mb = (r32 == 0) ? masks + (4 * w + 2 * hi + S) * 64 : masks + 2048 + lane;
#pragma unroll
    for (int tb = 0; tb < 4; ++tb) {
        if (16 * tb < ntl) {
#pragma unroll
            for (int tt = 0; tt < 16; ++tt) { const int t = 16 * tb + tt;
                const unsigned long long m0 = __ballot(key[t] >= tau);
                mb[t] = hi ? (unsigned)(m0 >> 32) : (unsigned)m0; }
        }
    }
    if (TIMING && w == 0) { const unsigned long long ti2_ = __builtin_amdgcn_s_memrealtime(); if (lane == 0) mstat[10] += (unsigned)(ti2_ - ti1_); }
}
__device__ __forceinline__ void gather8(float (&v)[8], const f32x16& o, int gp) {
#pragma unroll
    for (int i = 0; i < 4; ++i) { auto rr = __builtin_amdgcn_permlane32_swap(__float_as_uint(o[8 * gp + i]), __float_as_uint(o[8 * gp + 4 + i]), false, false); v[i] = __uint_as_float(rr[0]); v[4 + i] = __uint_as_float(rr[1]); }
}
__device__ __forceinline__ v4u pack8(const float (&v)[8]) { v4u o; o.x = cvtpk(v[0], v[1]); o.y = cvtpk(v[2], v[3]); o.z = cvtpk(v[4], v[5]); o.w = cvtpk(v[6], v[7]); return o; }
__device__ __forceinline__ void unpack8(float (&g)[8], v4u w) { g[0] = bf2f(w.x & 0xffffu); g[1] = bf2f(w.x >> 16); g[2] = bf2f(w.y & 0xffffu); g[3] = bf2f(w.y >> 16); g[4] = bf2f(w.z & 0xffffu); g[5] = bf2f(w.z >> 16); g[6] = bf2f(w.w & 0xffffu); g[7] = bf2f(w.w >> 16); }
__device__ __forceinline__ void unit_A(Frame& F, int b, int qb32, int dmode) {
    const bool dry = dmode != 0;
    const Bufs& B = F.B; int tid_ = F.tid; asm volatile("" : "+v"(tid_)); const int tid = tid_, lane = tid & 63, w = F.wave, r32 = lane & 31, hi = lane >> 5;
    const int t0 = qb32 * 32, limit = ((t0 >> 6) + 1) << 6, ntl = limit >> 5;
    const size_t rowb = (size_t)b * SEQ;
    LAS unsigned* masks = (LAS unsigned*)(F.lds + L_MASK);
    {
        { const char* src = (const char*)(WSP(const bf16, WS_IK) + rowb * 32);
          const int P0 = w * 1024 + lane * 16, key0 = P0 >> 6, slot = (P0 >> 4) & 3;
#pragma unroll 1
          for (int s0 = 0; s0 < limit * 64; s0 += 8192) {
              const int key = key0 + (s0 >> 6);
              __builtin_amdgcn_global_load_lds((const unsigned*)(src + (size_t)key * 64 + ((slot ^ ((key >> 2) & 3)) << 4)), (LAS unsigned*)(F.lds + s0 + w * 1024), 16, 0, 0);
          } }
        asm volatile("s_waitcnt vmcnt(0)" ::: "memory");
        __syncthreads();
        TST(1);
        if (dmode != 3) {
#pragma unroll 1
        for (int sl = 0; sl < 2; ++sl) {
            const int rho = r32, qa = 2 * ((rho >> 2) & 1) + ((rho >> 4) ^ sl), ha = 4 * ((rho >> 3) & 1) + (rho & 3);
            const bf16* iqp = WSP(const bf16, WS_IQ) + (rowb + t0 + 4 * w + qa) * 256 + ha * 32 + 8 * hi;
            const bf16x8 a0 = *(const bf16x8*)iqp, a1 = *(const bf16x8*)(iqp + 16);
            indexer_pass(B, sl, F.lds, masks, rowb, t0, w, lane, ntl, limit, a0, a1);
        }
        }
    }
    __syncthreads();
    TST(2);
    {
        const int ql = 4 * w + (r32 >> 3), head = r32 & 7; const size_t row = rowb + t0 + ql;
        bf16* qrow = WSP(bf16, WS_QAB) + row * 1024 + head * 64;
        WState<64, 64> W; wstate_init<64, 64>(W, qrow, hi);
        const int nT = limit >> 6;
        __builtin_amdgcn_global_load_lds((const unsigned*)(WSP(const bf16, WS_AG) + row * 512 + head * 64), (LAS unsigned*)(F.lds + 98304 + w * 256), 4, 0, 0);
        tile_loop<64, 64, 128, true>(W, F.lds, (const char*)(WSP(const bf16, WS_AK) + rowb * 64), 128, (const char*)(WSP(const bf16, WS_AV) + rowb * 64), 128, dmode == 2 ? 1 : nT, dmode == 2 ? 1 : nT, 0, tid, lane, masks + ql * 64);
        TST(3);
        const float inv = 1.f / hswap_sum(W.l);
        const bf16* grow = WSP(const bf16, WS_AG) + row * 512 + head * 64;
        v4u gw[4];
#pragma unroll
        for (int q = 0; q < 4; ++q) gw[q] = *(const v4u*)(grow + 16 * q + 8 * hi);
#pragma unroll
        for (int dt = 0; dt < 2; ++dt)
#pragma unroll
            for (int gp = 0; gp < 2; ++gp) { const int d0 = 32 * dt + 16 * gp + 8 * hi;
                float v[8], g[8]; gather8(v, W.o[dt], gp); unpack8(g, gw[2 * dt + gp]);
#pragma unroll
                for (int i = 0; i < 8; ++i) v[i] = v[i] * inv * g[i];
                if (!dry) *(v4u*)(qrow + d0) = pack8(v); }
    }
    __syncthreads();
    TST(4);
}

__device__ __forceinline__ void unit_B(Frame& F, int b, int h, int qb128, int dmode) {
    const bool dry = dmode != 0;
    const Bufs& B = F.B; int tid_ = F.tid; asm volatile("" : "+v"(tid_)); const int tid = tid_, lane = tid & 63, w = F.wave, r32 = lane & 31, hi = lane >> 5;
    const int qb = w >> 1, c = w & 1, t0 = qb128 * 128 + qb * 32;
    const size_t rowb = (size_t)b * SEQ, row = rowb + t0 + r32;
    const int nT = 2 * qb128 + 2, my_nt = ((t0 >> 6) + 1);
    bf16* qrow = WSP(bf16, WS_QAB) + row * 1024 + 512 + h * 128;
    WState<64, 128> W; wstate_init<64, 128>(W, qrow + c * 64, hi);
    tile_loop<64, 128, 256, false>(W, F.lds, (const char*)(WSP(const bf16, WS_BK) + rowb * 512 + h * 128), 1024, (const char*)(WSP(const bf16, WS_BV) + rowb * 512 + h * 128), 1024, nT, my_nt, c * 8, tid, lane, nullptr, dmode);
    TST(5);
    const float inv = 1.f / hswap_sum(W.l);
    LAS float* X = (LAS float*)(F.lds + L_X) + qb * 4096 + lane;
    const bf16* grow = WSP(const bf16, WS_BG) + row * 512 + h * 128;
    v4u gpre[8];
    if (c == 0) {
#pragma unroll
        for (int q = 0; q < 8; ++q) gpre[q] = *(const v4u*)(grow + 16 * q + 8 * hi);
    }
    if (c == 1) {
#pragma unroll
        for (int dt = 0; dt < 4; ++dt)
#pragma unroll
            for (int r = 0; r < 16; ++r) X[(dt * 16 + r) * 64] = W.o[dt][r] * inv;
    }
    __syncthreads();
    if (c == 0) {
        const float lam = *(const LAS float*)(F.lds + L_NG + 512);
        float ss = 0.f;
#pragma unroll
        for (int dt = 0; dt < 4; ++dt)
#pragma unroll
            for (int r = 0; r < 16; ++r) { const float v = W.o[dt][r] * inv - lam * X[(dt * 16 + r) * 64]; W.o[dt][r] = v; ss += v * v; }
        ss = hswap_sum(ss);
        const float rn = rsqrtf(ss * (1.f / 128.f) + LN_EPS) * (1.f - LAM_INIT);
#pragma unroll
        for (int dt = 0; dt < 4; ++dt)
#pragma unroll
            for (int gp = 0; gp < 2; ++gp) { const int d0 = 32 * dt + 16 * gp + 8 * hi;
                float v[8], g[8]; gather8(v, W.o[dt], gp); unpack8(g, gpre[2 * dt + gp]);
                const f32x4 n0 = *(const LAS f32x4*)(F.lds + L_NG + d0 * 4), n1 = *(const LAS f32x4*)(F.lds + L_NG + d0 * 4 + 16);
#pragma unroll
                for (int i = 0; i < 8; ++i) v[i] = v[i] * rn * (i < 4 ? n0[i] : n1[i - 4]) * g[i];
                if (!dry) *(v4u*)(qrow + d0) = pack8(v); }
    }
    __syncthreads();
    TST(6);
}

__device__ __forceinline__ void unit_C(Frame& F, int b, int h, int qb256, bool dry) {
    const Bufs& B = F.B; int tid_ = F.tid; asm volatile("" : "+v"(tid_)); const int tid = tid_, lane = tid & 63, w = F.wave, r32 = lane & 31, hi = lane >> 5;
    const size_t row = (size_t)b * SEQ + qb256 * 256 + w * 32 + r32;
    bf16* qrow = WSP(bf16, WS_QC) + row * 1024 + h * 128;
    WState<128, 128> W; wstate_init<128, 128>(W, qrow, hi);
    const char* kv = (const char*)(WSP(const bf16, WS_MKV) + (size_t)b * MEM_LEN * 1024 + h * 128);
    __builtin_amdgcn_global_load_lds((const unsigned*)(qrow + 512 + hi * 64), (LAS unsigned*)(F.lds + L_MASK + w * 256), 4, 0, 0);
    { v4u kr[8], vr[8];
#pragma unroll
      for (int i = 0; i < 8; ++i) { const int idx = tid + 512 * i, key = idx >> 4, ch = idx & 15; kr[i] = *(const v4u*)(kv + (size_t)key * 2048 + ch * 16); vr[i] = *(const v4u*)(kv + 1024 + (size_t)key * 2048 + ch * 16); }
#pragma unroll
      for (int i = 0; i < 8; ++i) { const int idx = tid + 512 * i, key = idx >> 4, ch = idx & 15, t = key >> 6, k64 = key & 63;
          *(LAS v4u*)(F.lds + t * 16384 + k64 * 256 + ((ch ^ ksw<256>(k64)) << 4)) = kr[i];
          *(LAS v4u*)(F.lds + 65536 + t * 16384 + (ch >> 2) * 4096 + k64 * 64 + (ch & 3) * 16) = vr[i]; } }
    __syncthreads();
    { f32x16 sc[2], sn[2]; bf16x8 pf[4];
      qk_tile<128, 256>(sc, W.qf, F.lds, 0, r32, hi);
#pragma unroll 1
      for (int t = 0; t < 4; ++t) {
          step_sm<128, 128, 256, false>(W, sc, sn, pf, F.lds + ((t + 1) & 3) * 16384, 0, lane, nullptr);
          step_pv<128, 128>(W, pf, F.lds + 65536 + t * 16384, lane);
#pragma unroll
          for (int r = 0; r < 16; ++r) { sc[0][r] = sn[0][r]; sc[1][r] = sn[1][r]; }
      } }
    const float inv = 1.f / hswap_sum(W.l);
    const bf16* grow = qrow + 512;
    v4u gwc[8];
#pragma unroll
    for (int q = 0; q < 8; ++q) gwc[q] = *(const v4u*)(grow + 16 * q + 8 * hi);
#pragma unroll
    for (int dt = 0; dt < 4; ++dt)
#pragma unroll
        for (int gp = 0; gp < 2; ++gp) { const int d0 = 32 * dt + 16 * gp + 8 * hi;
            float v[8], g[8]; gather8(v, W.o[dt], gp); unpack8(g, gwc[2 * dt + gp]);
#pragma unroll
            for (int i = 0; i < 8; ++i) v[i] = v[i] * inv * g[i];
            if (!dry) *(v4u*)(qrow + d0) = pack8(v); }
    __syncthreads();
    TST(7);
}

__device__ __forceinline__ void unit_MKV(Frame& F, int b, int pn) {
    const Bufs& B = F.B;
    SchedOne S; S.pm = b; S.pn = pn; S.MEMB = (const char*)(B.ws + WS_MEMB); S.WMEM = (const char*)(B.ws + WS_WMEM);
    EpiIn E{B};
    pg8::gemm_phase<EpiIn, SchedOne, true, true>(F.lds + RING_OFF, S, E);
    asm volatile("s_waitcnt vmcnt(0)" ::: "memory");
    __syncthreads();
    if (F.tid == 0) { __builtin_amdgcn_fence(__ATOMIC_RELEASE, "agent"); asm volatile("s_waitcnt vmcnt(0)" ::: "memory"); __hip_atomic_fetch_add(F.ctl + CW_MKV + 64 * b, 1u, __ATOMIC_RELAXED, __HIP_MEMORY_SCOPE_AGENT); }
    __syncthreads();
}
__device__ __forceinline__ void wait_MKV(Frame& F, int b) {
    if (F.tid == 0) {
        unsigned sp = 0;
        while (__hip_atomic_load(F.ctl + CW_MKV + 64 * b, __ATOMIC_RELAXED, __HIP_MEMORY_SCOPE_AGENT) < 4u) { __builtin_amdgcn_s_sleep(2); if (++sp > (1u << 22)) break; }
        __builtin_amdgcn_fence(__ATOMIC_ACQUIRE, "agent"); asm volatile("s_waitcnt vmcnt(0)" ::: "memory");
    }
    __syncthreads();
}
constexpr int QUNITS = 328;
__device__ __forceinline__ void attn_phase(Frame& F, unsigned* qctr) {
    const int q0 = (int)(xb_xcc_id() & 7u);
    if (F.tid < 128) ((LAS float*)(F.lds + L_NG))[F.tid] = F.B.diff_norm_g[F.tid];
    if (F.tid == 128) ((LAS float*)(F.lds + L_NG))[128] = *(const float*)(F.B.ws + WS_LAM);
    if (TIMING && threadIdx.x == 0) F.MISC[14] = (unsigned)__builtin_amdgcn_s_memrealtime();
    for (int k = 0; k < 8; ++k) {
        const int q = (q0 + k) & 7;
        for (;;) {
            __syncthreads();
            if (F.tid == 0) F.MISC[0] = atomicAdd(qctr + 64 * q, 1u);
            __syncthreads();
            int pos = (int)F.MISC[0]; int dmode = 0;
            TST(0);
#if PROBE_DRY
            if (pos < 128) { dmode = PROBE_DMODE; pos = ((pos >> 2) << 3) + (pos & 3) + (PROBE_DRY == 1 ? 0 : 4); } else pos -= 128;
#endif
            if (pos >= QUNITS) break;
            if (pos < 8) { unit_MKV(F, q + 8 * (pos >> 2), pos & 3); continue; }
            pos -= 8;
            if (pos < 256) {
                const int b = q + 8 * (pos >> 7), p = pos & 127, L = 15 - (p >> 3), r = p & 7;
                if (r < 4) unit_A(F, b, 4 * L + 3 - r, dmode);
                else unit_B(F, b, r - 4, L, dmode);
            } else { const int c = pos - 256, b = q + 8 * (c >> 5), cc = c & 31; wait_MKV(F, b); unit_C(F, b, cc & 3, cc >> 2, false); }
        }
    }
    if (TIMING) { __syncthreads(); if (F.tid < 16) atomicAdd(F.ctl + CW_TIME + F.tid, F.MISC[16 + F.tid]); }
}
}
constexpr size_t WS_SCR = WS_XN;
struct SchedMerge {
    pg8::TileOrder T; int G, c; const char *QAB, *QC, *WAB, *WC;
    __device__ __forceinline__ bool next(int i, pg8::Unit& u) const {
        const int ti = i / 3, br = i - ti * 3, L = ti * G + c;
        if (L >= T.nwg) return false;
        T.tile(L, u.pm, u.pn); u.kind = br; u.nt = 8; u.keep = br < 2 ? 1 : 0;
        if (br == 0) { u.A = QAB + (size_t)u.pm * pg8::TSTEP; u.B = WAB + (size_t)u.pn * pg8::TSTEP; }
        else if (br == 1) { u.A = QAB + (size_t)u.pm * pg8::TSTEP + 1024; u.B = WAB + (size_t)u.pn * pg8::TSTEP + 1024; }
        else { u.A = QC + (size_t)u.pm * pg8::TSTEP; u.B = WC + (size_t)u.pn * pg8::TSTEP; }
        return true;
    }
    __device__ __forceinline__ void a_ready(const pg8::Unit&) const {}
    __device__ __forceinline__ void done(const pg8::Unit&) const {}
};
struct EpiMerge {
    static constexpr bool PERM = true, AFTER_DRAIN = false; bf16* merged; const unsigned char* ws_;
    __device__ __forceinline__ static void ld_u8(pg8::f32x4& a, pg8::f32x4& b, const unsigned char* p) {
        const uint2 gw = *(const uint2*)p; const float s = 1.f / 255.f;
        a = (pg8::f32x4){fmaxf((float)(gw.x & 255u), 1.f), fmaxf((float)((gw.x >> 8) & 255u), 1.f), fmaxf((float)((gw.x >> 16) & 255u), 1.f), fmaxf((float)(gw.x >> 24), 1.f)} * s;
        b = (pg8::f32x4){fmaxf((float)(gw.y & 255u), 1.f), fmaxf((float)((gw.y >> 8) & 255u), 1.f), fmaxf((float)((gw.y >> 16) & 255u), 1.f), fmaxf((float)(gw.y >> 24), 1.f)} * s;
    }
    __device__ __forceinline__ static void ld_bf(pg8::f32x4& a, pg8::f32x4& b, const bf16* p) {
        const v4u gw = *(const v4u*)p;
        a = (pg8::f32x4){bf2f(gw.x & 0xffffu), bf2f(gw.x >> 16), bf2f(gw.y & 0xffffu), bf2f(gw.y >> 16)}; b = (pg8::f32x4){bf2f(gw.z & 0xffffu), bf2f(gw.z >> 16), bf2f(gw.w & 0xffffu), bf2f(gw.w >> 16)};
    }
    __device__ __forceinline__ static pg8::f32x4 rcp4(pg8::f32x4 v) { return (pg8::f32x4){__builtin_amdgcn_rcpf(v[0]), __builtin_amdgcn_rcpf(v[1]), __builtin_amdgcn_rcpf(v[2]), __builtin_amdgcn_rcpf(v[3])}; }
    __device__ __forceinline__ static void cv_u8(pg8::f32x4& a, pg8::f32x4& b, uint2 gw) {
        const float s = 1.f / 255.f;
        a = (pg8::f32x4){fmaxf((float)(gw.x & 255u), 1.f), fmaxf((float)((gw.x >> 8) & 255u), 1.f), fmaxf((float)((gw.x >> 16) & 255u), 1.f), fmaxf((float)(gw.x >> 24), 1.f)} * s;
        b = (pg8::f32x4){fmaxf((float)(gw.y & 255u), 1.f), fmaxf((float)((gw.y >> 8) & 255u), 1.f), fmaxf((float)((gw.y >> 16) & 255u), 1.f), fmaxf((float)(gw.y >> 24), 1.f)} * s;
    }
    __device__ __forceinline__ static void cv_bf(pg8::f32x4& a, pg8::f32x4& b, v4u gw) {
        a = (pg8::f32x4){bf2f(gw.x & 0xffffu), bf2f(gw.x >> 16), bf2f(gw.y & 0xffffu), bf2f(gw.y >> 16)}; b = (pg8::f32x4){bf2f(gw.z & 0xffffu), bf2f(gw.z >> 16), bf2f(gw.w & 0xffffu), bf2f(gw.w >> 16)};
    }
    __device__ __forceinline__ void operator()(pg8::f32x4 (&acc)[2][2][4][2], const pg8::Unit& u, int wr, int wc, int fr, int fq) const {
        const int row0 = u.pm * 256 + wr * 64 + fr, col0 = u.pn * 256 + wc * 32 + 8 * fq;
        const size_t rt = (size_t)u.pm * 256, lo = (size_t)(wr * 64 + fr) * 1024 + col0;
        const int wv = wr * 4 + wc, ln = fq * 16 + fr;
        const size_t tA = ((size_t)(u.pm * 4 + u.pn) * 8 + wv) * 8192, tB = ((size_t)(u.pm * 4 + u.pn) * 8 + wv) * 16384;
        const __amdgpu_buffer_rsrc_t rA = __builtin_amdgcn_make_buffer_rsrc((void*)(ws_ + WS_GA + tA), 0, 8192, 0x00020000);
        const __amdgpu_buffer_rsrc_t rC = __builtin_amdgcn_make_buffer_rsrc((void*)(rt < GC_SPLIT ? ws_ + WS_GC + tA : ws_ + WS_GC2 + (tA - (size_t)GC_SPLIT * 1024)), 0, 8192, 0x00020000);
        const __amdgpu_buffer_rsrc_t rB = __builtin_amdgcn_make_buffer_rsrc((void*)(ws_ + WS_GB + tB), 0, 16384, 0x00020000);
        const int vl = ln * 16;
#define LD8P(r, p) __builtin_amdgcn_raw_buffer_load_b128(r, vl, (p) * 1024, 2)
#define LD16(ix) __builtin_amdgcn_raw_buffer_load_b128(rB, vl, (ix) * 1024, 2)
#define OFS(ix) ((((((ix) >> 3) & 1) * 128 + ((ix) & 3) * 16) * 1024) + (((ix) >> 2) & 1) * 128)
#pragma unroll
        for (int h = 0; h < 2; ++h) {
            uint2 q8[8]; v4u q16[8];
            if (u.kind == 0) {
#pragma unroll
                for (int j = 0; j < 4; ++j) { const v4u t_ = LD8P(rA, h * 4 + j); q8[2 * j] = make_uint2(t_.x, t_.y); q8[2 * j + 1] = make_uint2(t_.z, t_.w); }
#pragma unroll
                for (int j = 0; j < 8; ++j) q16[j] = LD16(h * 8 + j);
#pragma unroll
                for (int j = 0; j < 8; ++j) { const int ix = h * 8 + j; pg8::f32x4 na, nb, da, db; cv_u8(na, nb, q8[j]); cv_bf(da, db, q16[j]);
                    acc[ix >> 3][(ix >> 2) & 1][ix & 3][0] *= na * rcp4(da); acc[ix >> 3][(ix >> 2) & 1][ix & 3][1] *= nb * rcp4(db); }
            } else if (u.kind == 1) {
#pragma unroll
                for (int j = 0; j < 4; ++j) { const v4u t_ = LD8P(rC, h * 4 + j); q8[2 * j] = make_uint2(t_.x, t_.y); q8[2 * j + 1] = make_uint2(t_.z, t_.w); }
#pragma unroll
                for (int j = 0; j < 8; ++j) q16[j] = LD16(h * 8 + j);
#pragma unroll
                for (int j = 0; j < 8; ++j) { const int ix = h * 8 + j; pg8::f32x4 na, nb, da, db; cv_bf(na, nb, q16[j]); cv_u8(da, db, q8[j]);
                    acc[ix >> 3][(ix >> 2) & 1][ix & 3][0] *= na * rcp4(da); acc[ix >> 3][(ix >> 2) & 1][ix & 3][1] *= nb * rcp4(db); }
            } else {
#pragma unroll
                for (int j = 0; j < 4; ++j) { const v4u t_ = LD8P(rC, h * 4 + j); q8[2 * j] = make_uint2(t_.x, t_.y); q8[2 * j + 1] = make_uint2(t_.z, t_.w); }
#pragma unroll
                for (int j = 0; j < 8; ++j) { const int ix = h * 8 + j; pg8::f32x4 na, nb; cv_u8(na, nb, q8[j]); const int ai = ix >> 3, bj = (ix >> 2) & 1, m = ix & 3;
                    const pg8::f32x4 t0 = acc[ai][bj][m][0] * na, t1 = acc[ai][bj][m][1] * nb; float v[8] = {t0[0], t0[1], t0[2], t0[3], t1[0], t1[1], t1[2], t1[3]};
                    store8c(merged + (size_t)(row0 + ai * 128 + m * 16) * 1024 + col0 + bj * 128, v); }
            }
            asm volatile("" ::: "memory");
        }
#undef LD8P
#undef LD16
#undef OFS
    }
};
struct SchedOut {
    pg8::TileOrder T; int G, c; const char *MG, *WO;
    __device__ __forceinline__ bool next(int i, pg8::Unit& u) const {
        const int L = i * G + c; if (L >= T.nwg) return false;
        T.tile(L, u.pm, u.pn); u.A = MG + (size_t)u.pm * pg8::TSTEP; u.B = WO + (size_t)u.pn * pg8::TSTEP; u.nt = 16; u.kind = 0; u.keep = 0; return true;
    }
    __device__ __forceinline__ void a_ready(const pg8::Unit&) const {}
    __device__ __forceinline__ void done(const pg8::Unit&) const {}
};
struct EpiOutF {
    static constexpr bool PERM = true, AFTER_DRAIN = false; bf16* Y;
    __device__ __forceinline__ void operator()(const pg8::f32x4 (&acc)[2][2][4][2], const pg8::Unit& u, int wr, int wc, int fr, int fq) const {
        const int row0 = u.pm * 256 + wr * 64 + fr, col0 = u.pn * 256 + wc * 32 + 8 * fq;
#pragma unroll
        for (int ai = 0; ai < 2; ++ai)
#pragma unroll
            for (int m = 0; m < 4; ++m)
#pragma unroll
                for (int bj = 0; bj < 2; ++bj) { const pg8::f32x4 t0 = acc[ai][bj][m][0], t1 = acc[ai][bj][m][1];
                    float v[8] = {t0[0], t0[1], t0[2], t0[3], t1[0], t1[1], t1[2], t1[3]};
                    store8c(Y + (size_t)(row0 + ai * 128 + m * 16) * 1024 + col0 + bj * 128, v); }
    }
};
__device__ __forceinline__ void ln_out_rows(const Bufs& B, const bf16* Y, int gw, int NGW, int lane) {
    f32x4 gi[4], bi[4];
#pragma unroll
    for (int j = 0; j < 4; ++j) { gi[j] = *((const f32x4*)B.ln_in_g + lane + 64 * j) * ALPHA; bi[j] = *((const f32x4*)B.ln_in_b + lane + 64 * j) * ALPHA; }
    f32x4 v[4], nx[4]; uint2 yv[4], ny[4]; float2 st = {0.f, 0.f}, nst = {0.f, 0.f};
    if (gw < M) { const f32x4* xr = (const f32x4*)(B.x + (size_t)gw * D) + lane; const uint2* yr = (const uint2*)(Y + (size_t)gw * D) + lane;
#pragma unroll
        for (int j = 0; j < 4; ++j) { v[j] = __builtin_nontemporal_load(xr + 64 * j); { typedef unsigned v2u_ __attribute__((ext_vector_type(2))); const v2u_ t_ = __builtin_nontemporal_load((const v2u_*)(yr + 64 * j)); yv[j] = make_uint2(t_.x, t_.y); } }
        st = *(const float2*)(WSP(const float, WS_STATS) + (size_t)gw * 2); }
    for (int row = gw; row < M; row += NGW) {
        const int nr = row + NGW;
        if (nr < M) { const f32x4* xr = (const f32x4*)(B.x + (size_t)nr * D) + lane; const uint2* yr = (const uint2*)(Y + (size_t)nr * D) + lane;
#pragma unroll
            for (int j = 0; j < 4; ++j) { nx[j] = __builtin_nontemporal_load(xr + 64 * j); { typedef unsigned v2u_ __attribute__((ext_vector_type(2))); const v2u_ t_ = __builtin_nontemporal_load((const v2u_*)(yr + 64 * j)); ny[j] = make_uint2(t_.x, t_.y); } }
            nst = *(const float2*)(WSP(const float, WS_STATS) + (size_t)nr * 2); }
        float s = 0.f;
#pragma unroll
        for (int j = 0; j < 4; ++j) { const f32x4 yy = {bf2f(yv[j].x & 0xffffu), bf2f(yv[j].x >> 16), bf2f(yv[j].y & 0xffffu), bf2f(yv[j].y >> 16)};
            v[j] = (v[j] - st.x) * st.y * gi[j] + bi[j] + yy; s += (v[j].x + v[j].y) + (v[j].z + v[j].w); }
        const float mean = wave_sum(s) * (1.f / D); float s2 = 0.f;
#pragma unroll
        for (int j = 0; j < 4; ++j) { v[j] = v[j] - mean; s2 += (v[j].x * v[j].x + v[j].y * v[j].y) + (v[j].z * v[j].z + v[j].w * v[j].w); }
        const float rstd = rsqrtf(wave_sum(s2) * (1.f / D) + LN_EPS);
        f32x4* orow = (f32x4*)(B.out + (size_t)row * D) + lane;
#pragma unroll
        for (int j = 0; j < 4; ++j) { const f32x4 g = *((const f32x4*)B.ln_g + lane + 64 * j), b = *((const f32x4*)B.ln_b + lane + 64 * j); __builtin_nontemporal_store(v[j] * rstd * g + b, orow + 64 * j); }
#pragma unroll
        for (int j = 0; j < 4; ++j) { v[j] = nx[j]; yv[j] = ny[j]; }
        st = nst;
    }
}
__device__ __forceinline__ void ln_out_row(const Bufs& B, int row, int lane) {
    f32x4* xr = (f32x4*)(B.out + (size_t)row * D) + lane;
    f32x4 v[4]; float s = 0.f;
#pragma unroll
    for (int j = 0; j < 4; ++j) { v[j] = xr[64 * j]; s += (v[j].x + v[j].y) + (v[j].z + v[j].w); }
    const float mean = wave_sum(s) * (1.f / D); float s2 = 0.f;
#pragma unroll
    for (int j = 0; j < 4; ++j) { v[j] = v[j] - mean; s2 += (v[j].x * v[j].x + v[j].y * v[j].y) + (v[j].z * v[j].z + v[j].w * v[j].w); }
    const float rstd = rsqrtf(wave_sum(s2) * (1.f / D) + LN_EPS);
#pragma unroll
    for (int j = 0; j < 4; ++j) { const f32x4 g = *((const f32x4*)B.ln_g + lane + 64 * j), b = *((const f32x4*)B.ln_b + lane + 64 * j); xr[64 * j] = v[j] * rstd * g + b; }
}
struct Args { Bufs B; int nprog; int prog[11]; };
__global__ void __launch_bounds__(NWAVES * 64, 2) skel_fwd(Args args) {
    extern __shared__ __attribute__((aligned(16))) unsigned char lds[];
    Frame F;
    F.lds = (LAS unsigned char*)lds; F.MISC = (volatile LAS unsigned*)(F.lds + MISC_OFF);
    F.tid = threadIdx.x; F.lane = F.tid & 63; F.wave = __builtin_amdgcn_readfirstlane(F.tid >> 6);
    F.G = gridDim.x; { const int bx = blockIdx.x; F.vcu = (F.G % 8 == 0) ? (bx % 8) * (F.G / 8) + bx / 8 : bx; }
    F.B = args.B; F.ctl = (unsigned*)(args.B.ws + WS_CTL);
    const Bufs& B = F.B;
    for (int u = F.tid; u < (LDS_BYTES - LDSCTL_OFF) / 4; u += NWAVES * 64) ((LAS unsigned*)(F.lds + LDSCTL_OFF))[u] = 0u;
    __syncthreads();
    XcdBarrier bar = xcd_barrier_post(F.ctl + CW_BAR, F.MISC + 8);
    const int en = args.nprog;
#define P_PRO()  do { if (en & 1) p0_prologue(F); } while (0)
#define P_IN()   do { if (en & 2) { SchedIn S; S.T.init(M / 256, NPOS / 256); S.G = F.G; S.c = (int)blockIdx.x; \
            S.XN = (const char*)(B.ws + WS_XN); S.WIN = (const char*)(B.ws + WS_WIN); S.MEMB = (const char*)(B.ws + WS_MEMB); S.WMEM = (const char*)(B.ws + WS_WMEM); \
            EpiIn E{B}; pg8::gemm_phase<EpiIn, SchedIn, true, true>(F.lds + RING_OFF, S, E); } } while (0)
#define P_ATT(qi) do { if (en & 4) att::attn_phase(F, F.ctl + CW_QUEUE + 512 * (qi)); } while (0)
#define P_MRG()  do { if (en & 8) { SchedMerge S; S.T.init(M / 256, 4); S.G = F.G; S.c = (int)blockIdx.x; \
            S.QAB = (const char*)(B.ws + WS_QAB); S.QC = (const char*)(B.ws + WS_QC); S.WAB = (const char*)(B.ws + WS_WAB); S.WC = (const char*)(B.ws + WS_WC); \
            EpiMerge E{WSP(bf16, WS_MERGED), (const unsigned char*)B.ws}; \
            pg8::gemm_phase<EpiMerge, SchedMerge, true, true>(F.lds + RING_OFF, S, E); } } while (0)
#define P_OUT()  do { if (en & 16) { SchedOut S; S.T.init(M / 256, 4); S.G = F.G; S.c = (int)blockIdx.x; S.MG = (const char*)(B.ws + WS_MERGED); S.WO = (const char*)(B.ws + WS_WOUT); \
            EpiOutF E{WSP(bf16, WS_XN)}; pg8::gemm_phase<EpiOutF, SchedOut, true, true>(F.lds + RING_OFF, S, E); } } while (0)
#define P_LN()   do { if (en & 32) ln_out_rows(B, WSP(const bf16, WS_XN), F.vcu * NWAVES + F.wave, F.G * NWAVES, (int)(threadIdx.x & 63u)); } while (0)
#define BAR() xcd_barrier(bar)
#ifndef PROBE_REP
#define PROBE_REP 0
#endif
    P_PRO(); BAR();
#if PROBE_REP == 10
    P_PRO(); BAR();
#endif
    P_IN(); BAR();
#if PROBE_REP == 1
    P_IN(); BAR();
#endif
    P_ATT(0); BAR();
#if PROBE_REP == 12
    P_IN(); BAR(); P_ATT(1); BAR();
#endif
    P_MRG(); BAR();
#if PROBE_REP == 3
    P_MRG(); BAR();
#endif
    P_OUT(); BAR();
    P_LN();
#if PROBE_REP == 45
    BAR(); P_OUT(); BAR(); P_LN();
#endif
#if TIMING_SEL >= 0
    BAR(); if (blockIdx.x == 0 && F.tid == 0) { const unsigned v = __hip_atomic_load(F.ctl + CW_TIME + TIMING_SEL, __ATOMIC_RELAXED, __HIP_MEMORY_SCOPE_AGENT); B.out[0] = (float)v / (float)F.G / 100.f; }
#endif
}
#ifndef FAST_UPTO
#define FAST_UPTO 6
#endif
#ifndef PROG_LIST
#define PROG_LIST 0, 1, 2, 3, 4, 5
#endif
static void launch_skel(const Bufs& B, hipStream_t stream, int grid) {
    static const int prog[] = {PROG_LIST};
    Args a{}; a.B = B; a.nprog = 63; (void)prog;
    hipLaunchKernelGGL(skel_fwd, dim3(grid), dim3(NWAVES * 64), LDS_BYTES, stream, a);
}
extern "C" void kernel_launch(void* const* d_in, const int* in_sizes, int n_in, void* d_out, int out_size, void* d_ws, size_t ws_size, hipStream_t stream) {
    (void)in_sizes; (void)n_in; (void)out_size;
    static int grid = 0;
    if (grid == 0) {
        if (ws_size < WS_END) { fprintf(stderr, "workspace too small: %zu < %zu\n", ws_size, (size_t)WS_END); grid = -1; return; }
        int dev = 0, cus = 0;
        if (hipGetDevice(&dev) != hipSuccess || hipDeviceGetAttribute(&cus, hipDeviceAttributeMultiprocessorCount, dev) != hipSuccess) { grid = -1; return; }
        if (hipFuncSetAttribute((const void*)skel_fwd, hipFuncAttributeMaxDynamicSharedMemorySize, LDS_BYTES) != hipSuccess) { fprintf(stderr, "hipFuncSetAttribute failed\n"); grid = -1; return; }
        int per_cu = 0; (void)hipOccupancyMaxActiveBlocksPerMultiprocessor(&per_cu, (const void*)skel_fwd, NWAVES * 64, LDS_BYTES); (void)hipGetLastError();
        if (per_cu < 1) fprintf(stderr, "note: occupancy query reports %d blocks/CU\n", per_cu);
        grid = cus;
    }
    if (grid < 0) return;
    Bufs B{};
    B.x = (const float*)d_in[0]; B.mem = (const float*)d_in[1]; B.ln_in_g = (const float*)d_in[2]; B.ln_in_b = (const float*)d_in[3]; B.w_in = (const float*)d_in[4];
    B.w_mem_kv = (const float*)d_in[5]; B.diff_lambda = (const float*)d_in[6]; B.diff_norm_g = (const float*)d_in[7]; B.w_proj_a = (const float*)d_in[8];
    B.w_proj_b = (const float*)d_in[9]; B.w_proj_c = (const float*)d_in[10]; B.w_out = (const float*)d_in[11]; B.ln_g = (const float*)d_in[12]; B.ln_b = (const float*)d_in[13];
    B.out = (float*)d_out; B.ws = (unsigned char*)d_ws;
    unsigned char* ws = B.ws;
    (void)hipMemsetAsync(ws + WS_CTL, 0, CTL_ZERO_BYTES, stream);
    launch_skel(B, stream, grid);
}
```

```cpp
#include <hip/hip_runtime.h>
#include <hip/hip_bf16.h>
#include <cstdint>
#include <cstdio>
#include <cmath>

typedef unsigned short bf16;
typedef unsigned v4u __attribute__((ext_vector_type(4)));
typedef float f32x4 __attribute__((ext_vector_type(4)));

constexpr int D = 1024, BATCH = 16, SEQ = 2048, M = BATCH * SEQ;
constexpr int MEM_LEN = 256, MM = BATCH * MEM_LEN;
constexpr int IN_WIDTH = 7592;
constexpr int NPOS = 7680;
constexpr int O_AQ = 0, O_AK = 512, O_AV = 576, O_AG = 640, O_IQ = 1152, O_IK = 1408, O_IW = 1440, O_BQ = 1448, O_BK = 1960, O_BV = 2472,
              O_BG = 2984, O_CQ = 3496, O_CG = 4008, O_MG = 4520;
constexpr float LN_EPS = 1e-5f;
constexpr float LOG2E = 1.4426950408889634f;
constexpr float ALPHA = 1.189207115002721f;
constexpr float LAM_INIT = 0.2f;

constexpr size_t MiB = 1u << 20;
constexpr size_t WS_CTL = 0;
constexpr size_t WS_TAB = 1 * MiB;
constexpr size_t WS_TAB32 = WS_TAB + 128 * 1024;
constexpr size_t WS_LAM = WS_TAB + 256 * 1024;
constexpr size_t WS_STATS = WS_TAB + 512 * 1024;
constexpr size_t WS_WIN = 2 * MiB;
constexpr size_t WS_WMG = 11 * MiB;
constexpr size_t WS_WMEM = 17 * MiB;
constexpr size_t WS_WAB = 19 * MiB;
constexpr size_t WS_WC = 21 * MiB;
constexpr size_t WS_WOUT = 23 * MiB;
constexpr size_t WS_MEMB = 25 * MiB;
constexpr size_t WS_MKV = 2 * MiB;
constexpr size_t WS_XN = 41 * MiB;
constexpr size_t WS_QAB = 105 * MiB;
constexpr size_t WS_QC = 169 * MiB;
constexpr size_t WS_AG = 233 * MiB;
constexpr size_t WS_BK = 265 * MiB;
constexpr size_t WS_BV = 297 * MiB;
constexpr size_t WS_BG = 329 * MiB;
constexpr size_t WS_IQ = 361 * MiB;
constexpr size_t WS_AK = 377 * MiB;
constexpr size_t WS_AV = 381 * MiB;
constexpr size_t WS_IK = 385 * MiB;
constexpr size_t WS_IW = 387 * MiB;
constexpr size_t WS_MASK = 388 * MiB;
constexpr size_t WS_MERGED = WS_BK;
constexpr size_t WS_GTMP = WS_BG;
constexpr size_t WS_GB = 388 * MiB;
constexpr size_t WS_GA = 452 * MiB;
constexpr size_t WS_GC = 484 * MiB;
constexpr size_t WS_GC2 = 33 * MiB;
constexpr int GC_SPLIT = 28672;
constexpr size_t WS_END = 512 * MiB;

__device__ __forceinline__ unsigned f2bf(float f) { unsigned u = __float_as_uint(f); return (u + 0x7fffu + ((u >> 16) & 1u)) >> 16; }
__device__ __forceinline__ float bf2f(unsigned v) { return __uint_as_float(v << 16); }
__device__ __forceinline__ unsigned pk2(float lo, float hi) { typedef float f2_ __attribute__((ext_vector_type(2))); typedef __bf16 b2_ __attribute__((ext_vector_type(2))); f2_ v = {lo, hi}; b2_ b = __builtin_convertvector(v, b2_); return __builtin_bit_cast(unsigned, b); }
__device__ __forceinline__ float silu_f(float x) { return x * __builtin_amdgcn_rcpf(1.f + __builtin_amdgcn_exp2f(-LOG2E * x)); }
__device__ __forceinline__ float sigmoid_f(float x) { return 1.f / (1.f + __expf(-x)); }

__host__ __device__ __forceinline__ int rp64(int j) { return j < 16 ? ((j >> 1) + 8 * (j & 1)) : j; }
__host__ __device__ __forceinline__ int rp32(int j) { return j < 8 ? ((j >> 1) + 4 * (j & 1)) : j; }
__host__ __device__ __forceinline__ int orig_of_pos(int p) {
    const int tile = p >> 8;
    if (tile < 2) { return O_AQ + (p & ~63) + rp64(p & 63); }
    if (tile < 4) { return O_AG + (p - 512); }
    if (tile < 6) { const int c = p - 1024; return O_BQ + (c & ~63) + rp64(c & 63); }
    if (tile < 8) { const int c = p - 1536; return O_BK + (c & ~63) + rp64(c & 63); }
    if (tile < 10) { return O_BV + (p - 2048); }
    if (tile < 12) { return O_BG + (p - 2560); }
    if (tile < 14) { return O_CQ + (p - 3072); }
    if (tile < 16) { return O_CG + (p - 3584); }
    if (tile == 16) { const int c = p - 4096; return O_IQ + (c & ~31) + rp32(c & 31); }
    if (tile >= 18) return O_MG + (p - 4608);
    const int j = p - 4352;
    if (j < 64) return O_AK + rp64(j);
    if (j < 128) return O_AV + (j - 64);
    if (j < 160) return O_IK + rp32(j - 128);
    if (j < 168) return O_IW + (j - 160);
    return -1;
}

struct Bufs {
    const float *x, *mem, *ln_in_g, *ln_in_b, *w_in, *w_mem_kv, *diff_lambda, *diff_norm_g, *w_proj_a, *w_proj_b, *w_proj_c, *w_out, *ln_g, *ln_b;
    float* out; unsigned char* ws;
};
#define WSP(T, off) ((T*)(B.ws + (off)))

__device__ __forceinline__ void rope8_64(float* v, const float* tab, int i0) {
    const f32x4 c = *(const f32x4*)(tab + i0), s = *(const f32x4*)(tab + 8 + i0);
#pragma unroll
    for (int j = 0; j < 4; ++j) { const float x1 = v[2 * j], x2 = v[2 * j + 1]; v[2 * j] = x1 * c[j] - x2 * s[j]; v[2 * j + 1] = x2 * c[j] + x1 * s[j]; }
}
__device__ __forceinline__ void store8c(bf16* dst, const float* v) {
    v4u o; o.x = pk2(v[0], v[1]); o.y = pk2(v[2], v[3]); o.z = pk2(v[4], v[5]); o.w = pk2(v[6], v[7]); *(v4u*)dst = o;
}
__device__ __forceinline__ void store8(bf16* dst, const float* v) {
    v4u o; o.x = pk2(v[0], v[1]); o.y = pk2(v[2], v[3]); o.z = pk2(v[4], v[5]); o.w = pk2(v[6], v[7]); __builtin_nontemporal_store(o, (v4u*)dst);
}
enum { K_AQ = 0, K_AG, K_BQ, K_BK, K_BV, K_BG, K_CQ, K_CG, K_IQ, K_MISC, K_MG };
__host__ __device__ __forceinline__ int kind_of_tile(int tile) { return tile < 16 ? (tile >> 1) : (tile == 16 ? K_IQ : (tile == 17 ? K_MISC : K_MG)); }
__device__ __forceinline__ void rope8_32(float* v, const float* tab32) {
    const f32x4 cs = *(const f32x4*)(tab32), sn = *(const f32x4*)(tab32 + 4);
#pragma unroll
    for (int j = 0; j < 4; ++j) { const float x1 = v[2 * j], x2 = v[2 * j + 1]; v[2 * j] = x1 * cs[j] - x2 * sn[j]; v[2 * j + 1] = x2 * cs[j] + x1 * sn[j]; }
}
template <int KIND> __device__ __forceinline__ void emit8k(const Bufs& B, int t, int c, float* v) {
    const int pos = t & (SEQ - 1);
    const float* tab64 = WSP(const float, WS_TAB) + pos * 16;
    const float* tab32 = WSP(const float, WS_TAB32) + pos * 8;
    const float SQ64 = 0.125f * LOG2E, SQ128 = 0.08838834764831845f * LOG2E;
    if constexpr (KIND == K_AQ || KIND == K_BQ) {
        const int w = c & 63; if (w < 16) rope8_64(v, tab64, w >> 1);
#pragma unroll
        for (int j = 0; j < 8; ++j) v[j] *= SQ64;
        store8(WSP(bf16, WS_QAB) + (size_t)t * 1024 + (KIND == K_BQ ? 512 : 0) + c, v);
    } else if constexpr (KIND == K_AG || KIND == K_BG) {
#pragma unroll
        for (int j = 0; j < 8; ++j) v[j] = silu_f(v[j]);
        store8(WSP(bf16, KIND == K_AG ? WS_AG : WS_BG) + (size_t)t * 512 + c, v);
    } else if constexpr (KIND == K_BK) {
        const int w = c & 63; if (w < 16) rope8_64(v, tab64, w >> 1);
        store8c(WSP(bf16, WS_BK) + (size_t)t * 512 + c, v);
    } else if constexpr (KIND == K_BV) {
        store8c(WSP(bf16, WS_BV) + (size_t)t * 512 + c, v);
    } else if constexpr (KIND == K_CQ) {
#pragma unroll
        for (int j = 0; j < 8; ++j) v[j] *= SQ128;
        store8(WSP(bf16, WS_QC) + (size_t)t * 1024 + c, v);
    } else if constexpr (KIND == K_CG) {
#pragma unroll
        for (int j = 0; j < 8; ++j) v[j] = silu_f(v[j]);
        store8(WSP(bf16, WS_QC) + (size_t)t * 1024 + 512 + c, v);
    } else if constexpr (KIND == K_IQ) {
        if ((c & 31) < 8) rope8_32(v, tab32);
        store8(WSP(bf16, WS_IQ) + (size_t)t * 256 + c, v);
    } else if constexpr (KIND == K_MG) {
        const int br = c >> 10, col = c & 1023, pm_ = t >> 8, r_ = t & 255, cc_ = col & 255;
        const int ix_ = (r_ >> 7) * 8 + (cc_ >> 7) * 4 + ((r_ >> 4) & 3), wv_ = ((r_ >> 6) & 1) * 4 + ((cc_ >> 5) & 3), ln_ = ((cc_ >> 3) & 3) * 16 + (r_ & 15);
        const size_t tl_ = (size_t)(pm_ * 4 + (col >> 8)) * 8 + wv_;
        if (br == 1) {
#pragma unroll
            for (int j = 0; j < 8; ++j) v[j] = __builtin_amdgcn_rcpf(1.f + __builtin_amdgcn_exp2f(-LOG2E * v[j]));
            store8(WSP(bf16, WS_GB) + (tl_ * 16384 + (size_t)(ix_ * 64 + ln_) * 16) / 2, v);
        } else {
            unsigned w0 = 0u, w1 = 0u;
#pragma unroll
            for (int j = 0; j < 8; ++j) { const float g = fmaxf(__builtin_amdgcn_rcpf(fmaf(__builtin_amdgcn_exp2f(-LOG2E * v[j]), 1.f / 255.f, 1.f / 255.f)), 1.f);
                if (j < 4) w0 = __builtin_amdgcn_cvt_pk_u8_f32(g, j, w0); else w1 = __builtin_amdgcn_cvt_pk_u8_f32(g, j - 4, w1); }
            const unsigned long long w = (unsigned long long)w0 | ((unsigned long long)w1 << 32);
            const size_t o_ = tl_ * 8192 + (size_t)((ix_ >> 1) * 64 + ln_) * 16 + (ix_ & 1) * 8;
            unsigned char* gp = br == 0 ? WSP(unsigned char, WS_GA) + o_ : (t < GC_SPLIT ? WSP(unsigned char, WS_GC) + o_ : WSP(unsigned char, WS_GC2) + (o_ - (size_t)GC_SPLIT * 1024));
            __builtin_nontemporal_store(w, (unsigned long long*)gp); }
    } else {
        if (c < 64) { if (c < 16) rope8_64(v, tab64, c >> 1); store8c(WSP(bf16, WS_AK) + (size_t)t * 64 + c, v); }
        else if (c < 128) { store8c(WSP(bf16, WS_AV) + (size_t)t * 64 + (c - 64), v); }
        else if (c < 160) { const int w = c - 128; if (w < 8) rope8_32(v, tab32); store8c(WSP(bf16, WS_IK) + (size_t)t * 32 + w, v); }
        else if (c == 160) { float* o = WSP(float, WS_IW) + (size_t)t * 8; *(f32x4*)o = (f32x4){v[0] * 0.0625f, v[1] * 0.0625f, v[2] * 0.0625f, v[3] * 0.0625f}; *(f32x4*)(o + 4) = (f32x4){v[4] * 0.0625f, v[5] * 0.0625f, v[6] * 0.0625f, v[7] * 0.0625f}; }
    }
}
__device__ __forceinline__ void inproj_emit8(const Bufs& B, int t, int p0, float* v) {
    const int tile = p0 >> 8, c = (tile < 16) ? (p0 & 511) : (tile < 18 ? (p0 & 255) : p0 - 4608);
    switch (kind_of_tile(tile)) {
    case K_AQ: emit8k<K_AQ>(B, t, c, v); break;  case K_AG: emit8k<K_AG>(B, t, c, v); break;
    case K_BQ: emit8k<K_BQ>(B, t, c, v); break;  case K_BK: emit8k<K_BK>(B, t, c, v); break;
    case K_BV: emit8k<K_BV>(B, t, c, v); break;  case K_BG: emit8k<K_BG>(B, t, c, v); break;
    case K_CQ: emit8k<K_CQ>(B, t, c, v); break;  case K_CG: emit8k<K_CG>(B, t, c, v); break;
    case K_IQ: emit8k<K_IQ>(B, t, c, v); break;  case K_MG: emit8k<K_MG>(B, t, c, v); break;  default:   emit8k<K_MISC>(B, t, c, v); break;
    }
}
__device__ __forceinline__ float wsrc(const Bufs& B, int kind, int k, int n) {
    switch (kind) {
    case 0: { const int o = orig_of_pos(n); return o < 0 ? 0.f : __builtin_nontemporal_load(B.w_in + (size_t)k * IN_WIDTH + o); }
    case 1: return __builtin_nontemporal_load(B.w_in + (size_t)k * IN_WIDTH + O_MG + n);
    case 2: return __builtin_nontemporal_load(B.w_mem_kv + (size_t)k * 1024 + n);
    case 3: return k < 512 ? __builtin_nontemporal_load(B.w_proj_a + (size_t)k * 1024 + n) : __builtin_nontemporal_load(B.w_proj_b + (size_t)(k - 512) * 1024 + n);
    case 4: return k < 512 ? __builtin_nontemporal_load(B.w_proj_c + (size_t)k * 1024 + n) : 0.f;
    default: return __builtin_nontemporal_load(B.w_out + (size_t)k * 1024 + n);
    }
}

namespace pg8 {
#define PG8_LAS __attribute__((address_space(3)))
typedef unsigned short bf16_t;
typedef short bf16x8 __attribute__((ext_vector_type(8)));
typedef float f32x4 __attribute__((ext_vector_type(4)));
typedef unsigned u32x4 __attribute__((ext_vector_type(4)));
constexpr int BM = 256, BK = 64, HALF = 128, HTB = HALF * BK * 2, STAGE_BYTES = 8 * HTB, NXCD = 8, WGM = 8, KP = 1024;
constexpr size_t TSTEP = (size_t)BM * KP * 2;

__host__ __device__ __forceinline__ int lds_byte(int r, int c) { const int st = (r >> 4) * 2 + (c >> 5), rr = r & 15, cc = c & 31, ob = rr * 64 + cc * 2; return st * 1024 + (ob ^ (((ob >> 9) & 1) << 5)); }
__host__ __device__ __forceinline__ void stage_rc(int b, int& R, int& C) { const int st = b / 1024, sb = b % 1024, swz = sb ^ (((sb >> 9) & 1) << 5); R = (st >> 1) * 16 + swz / 64; C = (st & 1) * 32 + (swz % 64) / 2; }
__host__ __device__ __forceinline__ int perm32(int rho) { const int n = rho >> 4, i = rho & 15; return 8 * (i >> 2) + 4 * n + (i & 3); }

struct Unit { int pm, pn; const char* A; const char* B; int nt; int kind; int keep; int pad; };

struct TileOrder {
    int nM, nN, nwg;
    __host__ __device__ void init(int nM_, int nN_) { nM = nM_; nN = nN_; nwg = nM * nN; }
    __host__ __device__ void tile(int L, int& pm, int& pn) const {
        int wgid = L; { const int q = nwg / NXCD, r = nwg % NXCD, xcd = wgid % NXCD, off = wgid / NXCD; wgid = (xcd < r ? xcd * (q + 1) : r * (q + 1) + (xcd - r) * q) + off; }
        const int nig = WGM * nN, gid = wgid / nig, fm = gid * WGM, gsz = (nM - fm) < WGM ? (nM - fm) : WGM;
        pm = fm + ((wgid % nig) % gsz); pn = (wgid % nig) / gsz;
    }
};
__device__ __forceinline__ unsigned cvt_pk_bf16(float lo, float hi) { unsigned r; asm volatile("v_cvt_pk_bf16_f32 %0, %1, %2" : "=v"(r) : "v"(lo), "v"(hi)); return r; }

template <class Epi, class Sched, bool ALIGN_EPI = false, bool SP2 = false>
__device__ __forceinline__ void gemm_phase(PG8_LAS unsigned char* lds, const Sched& S, const Epi& E) {
    int tid_ = threadIdx.x; asm volatile("" : "+v"(tid_));
    const int tid = tid_, wid = __builtin_amdgcn_readfirstlane(tid >> 6), lane = tid & 63, wr = wid >> 2, wc = wid & 3, fr = lane & 15, fq = lane >> 4;
    constexpr int K = KP; int nt;
    unsigned voffA[2], voffB[2];
#pragma unroll
    for (int i = 0; i < 2; ++i) { int R, C; stage_rc(tid * 16 + i * 8192, R, C); const int Rb = Epi::PERM ? ((R & ~31) + perm32(R & 31)) : R;
        voffA[i] = (unsigned)(R * K + C) * 2u; voffB[i] = (unsigned)(Rb * K + C) * 2u; }
    const size_t kstep = (size_t)(BK * 2);
    const size_t hstep = (size_t)HALF * K * 2;
    const size_t tstep = 2 * hstep;
    const unsigned ldsw = (unsigned)wid * 1024u;
    const int aoff = lds_byte(wr * 64 + fr, fq * 8), boff = lds_byte(wc * 32 + fr, fq * 8);
#define PG8_SA(b, h) (((b) * 2 + (h)) * HTB)
#define PG8_SB(b, h) ((4 + (b) * 2 + (h)) * HTB)
#define PG8_STAGE(bufoff, gbase, voff) do { _Pragma("unroll") for (int _i = 0; _i < 2; ++_i) \
        __builtin_amdgcn_global_load_lds((const unsigned*)((const char*)(gbase) + (voff)[_i]), (PG8_LAS unsigned*)(lds + (bufoff) + ldsw + _i * 8192), 16, 0, 0); } while (0)
#define PG8_LDA(dst, b, h) do { _Pragma("unroll") for (int m = 0; m < 4; ++m) _Pragma("unroll") for (int k = 0; k < 2; ++k) dst[m][k] = *(const PG8_LAS bf16x8*)(lds + PG8_SA(b, h) + aoff + m * 2048 + k * 1024); } while (0)
#define PG8_LDB(dst, b, h) do { _Pragma("unroll") for (int n = 0; n < 2; ++n) _Pragma("unroll") for (int k = 0; k < 2; ++k) dst[n][k] = *(const PG8_LAS bf16x8*)(lds + PG8_SB(b, h) + boff + n * 2048 + k * 1024); } while (0)
#define PG8_MMA(ai, bj, At, Bt) do { __builtin_amdgcn_s_setprio(1); _Pragma("unroll") for (int m = 0; m < 4; ++m) _Pragma("unroll") for (int n = 0; n < 2; ++n) _Pragma("unroll") for (int k = 0; k < 2; ++k) \
        acc[ai][bj][m][n] = __builtin_amdgcn_mfma_f32_16x16x32_bf16(Bt[n][k], At[m][k], acc[ai][bj][m][n], 0, 0, 0); __builtin_amdgcn_s_setprio(0); } while (0)
#define PG8_WAIT_V(n) asm volatile("s_waitcnt vmcnt(" #n ")" ::: "memory")
#define PG8_WAIT_L(n) asm volatile("s_waitcnt lgkmcnt(" #n ")" ::: "memory")
#define PG8_BAR __builtin_amdgcn_s_barrier()
#define PG8_SCHED __builtin_amdgcn_sched_barrier(0)
    Unit cur, nxt; int ui = 0;
    if (!S.next(0, cur)) return;
    f32x4 acc[2][2][4][2];
#pragma unroll
    for (int a = 0; a < 2; ++a)
#pragma unroll
        for (int b = 0; b < 2; ++b)
#pragma unroll
            for (int m = 0; m < 4; ++m)
#pragma unroll
                for (int n = 0; n < 2; ++n) acc[a][b][m][n] = (f32x4){0.f, 0.f, 0.f, 0.f};
    bf16x8 At[4][2], B0[2][2], B1[2][2];
    const char* cA = cur.A; const char* cB = cur.B; nt = cur.nt;
    S.a_ready(cur);
    if constexpr (SP2) {
        PG8_STAGE(PG8_SB(0, 0), cB, voffB); PG8_STAGE(PG8_SB(0, 1), cB + hstep, voffB); PG8_STAGE(PG8_SA(0, 0), cA, voffA); PG8_STAGE(PG8_SA(0, 1), cA + hstep, voffA);
        if (wr == 1) PG8_BAR;
        PG8_WAIT_V(2); PG8_BAR;
        PG8_STAGE(PG8_SB(1, 0), cB + kstep, voffB); PG8_STAGE(PG8_SA(1, 0), cA + kstep, voffA); PG8_STAGE(PG8_SB(1, 1), cB + hstep + kstep, voffB);
        PG8_WAIT_V(6); PG8_BAR;
    } else {
        PG8_STAGE(PG8_SB(0, 0), cB, voffB); PG8_STAGE(PG8_SA(0, 0), cA, voffA); PG8_STAGE(PG8_SB(0, 1), cB + hstep, voffB); PG8_STAGE(PG8_SA(0, 1), cA + hstep, voffA);
        if (wr == 1) PG8_BAR;
        PG8_WAIT_V(4); PG8_BAR;
        PG8_STAGE(PG8_SB(1, 0), cB + kstep, voffB); PG8_STAGE(PG8_SA(1, 0), cA + kstep, voffA); PG8_STAGE(PG8_SB(1, 1), cB + hstep + kstep, voffB);
        PG8_WAIT_V(6); PG8_BAR;
    }
    for (;;) {
        const bool has_next = S.next(ui + 1, nxt);
        const char* nA = has_next ? nxt.A : cA; const char* nB = has_next ? nxt.B : cB;
        for (int t = 0; t < nt; t += 2) {
            const bool last = (t == nt - 2);
            const char* a1 = cA + (size_t)(t + 1) * kstep;
            const char* a2 = last ? nA : cA + (size_t)(t + 2) * kstep; const char* b2 = last ? nB : cB + (size_t)(t + 2) * kstep;
            const char* a3 = a2 + kstep; const char* b3 = b2 + kstep;
            if (last && has_next) S.a_ready(nxt);
            if constexpr (SP2) {
            PG8_LDB(B0, 0, 0); PG8_LDB(B1, 0, 1); PG8_SCHED; PG8_LDA(At, 0, 0); PG8_STAGE(PG8_SA(1, 1), a1 + hstep, voffA);
            PG8_WAIT_V(8); PG8_WAIT_L(0); PG8_BAR; PG8_MMA(0, 0, At, B0); PG8_MMA(0, 1, At, B1); PG8_BAR; PG8_SCHED;
            PG8_LDA(At, 0, 1); PG8_STAGE(PG8_SB(0, 0), b2, voffB); PG8_STAGE(PG8_SB(0, 1), b2 + hstep, voffB); PG8_STAGE(PG8_SA(0, 0), a2, voffA);
            PG8_WAIT_V(8); PG8_WAIT_L(0); PG8_BAR; PG8_MMA(1, 0, At, B0); PG8_MMA(1, 1, At, B1); PG8_BAR; PG8_SCHED;
            PG8_LDB(B0, 1, 0); PG8_LDB(B1, 1, 1); PG8_SCHED; PG8_LDA(At, 1, 0); PG8_STAGE(PG8_SA(0, 1), a2 + hstep, voffA);
            PG8_WAIT_V(8); PG8_WAIT_L(0); PG8_BAR; PG8_MMA(0, 0, At, B0); PG8_MMA(0, 1, At, B1); PG8_BAR; PG8_SCHED;
            PG8_LDA(At, 1, 1); PG8_STAGE(PG8_SB(1, 0), b3, voffB); PG8_STAGE(PG8_SB(1, 1), b3 + hstep, voffB); PG8_STAGE(PG8_SA(1, 0), a3, voffA);
            PG8_WAIT_V(8); PG8_WAIT_L(0); PG8_BAR; PG8_MMA(1, 0, At, B0); PG8_MMA(1, 1, At, B1); PG8_BAR; PG8_SCHED;
            } else {
            PG8_LDB(B0, 0, 0); PG8_SCHED; PG8_LDA(At, 0, 0); PG8_STAGE(PG8_SA(1, 1), a1 + hstep, voffA);
            PG8_WAIT_L(8); PG8_BAR; PG8_WAIT_L(0); PG8_MMA(0, 0, At, B0); PG8_BAR; PG8_SCHED;
            PG8_LDB(B1, 0, 1); PG8_STAGE(PG8_SB(0, 0), b2, voffB);
            PG8_BAR; PG8_WAIT_L(0); PG8_MMA(0, 1, At, B1); PG8_BAR;
            PG8_LDA(At, 0, 1); PG8_STAGE(PG8_SA(0, 0), a2, voffA);
            PG8_BAR; PG8_WAIT_L(0); PG8_MMA(1, 0, At, B0); PG8_BAR; PG8_SCHED;
            PG8_STAGE(PG8_SB(0, 1), b2 + hstep, voffB);
            PG8_WAIT_V(6); PG8_BAR; PG8_MMA(1, 1, At, B1); PG8_BAR;
            PG8_LDB(B0, 1, 0); PG8_SCHED; PG8_LDA(At, 1, 0); PG8_STAGE(PG8_SA(0, 1), a2 + hstep, voffA);
            PG8_WAIT_L(8); PG8_BAR; PG8_WAIT_L(0); PG8_MMA(0, 0, At, B0); PG8_BAR; PG8_SCHED;
            PG8_LDB(B1, 1, 1); PG8_STAGE(PG8_SB(1, 0), b3, voffB);
            PG8_BAR; PG8_WAIT_L(0); PG8_MMA(0, 1, At, B1); PG8_BAR;
            PG8_LDA(At, 1, 1); PG8_STAGE(PG8_SA(1, 0), a3, voffA);
            PG8_BAR; PG8_WAIT_L(0); PG8_MMA(1, 0, At, B0); PG8_BAR; PG8_SCHED;
            PG8_STAGE(PG8_SB(1, 1), b3 + hstep, voffB);
            PG8_WAIT_V(6); PG8_BAR; PG8_MMA(1, 1, At, B1); PG8_BAR;
            }
        }
        if constexpr (ALIGN_EPI) { if (wr == 0) PG8_BAR; }
        if constexpr (!Epi::AFTER_DRAIN) { E(acc, cur, wr, wc, fr, fq); S.done(cur); }
        if (!has_next) break;
        if (!cur.keep) {
#pragma unroll
        for (int a = 0; a < 2; ++a)
#pragma unroll
            for (int b = 0; b < 2; ++b)
#pragma unroll
                for (int m = 0; m < 4; ++m)
#pragma unroll
                    for (int n = 0; n < 2; ++n) acc[a][b][m][n] = (f32x4){0.f, 0.f, 0.f, 0.f};
        }
        cur = nxt; cA = nA; cB = nB; nt = cur.nt; ++ui;
        if constexpr (ALIGN_EPI) { if (wr == 1) PG8_BAR; }
    }
    PG8_WAIT_V(0);
    if constexpr (!ALIGN_EPI) { if (wr == 0) PG8_BAR; }
    PG8_BAR;
    if constexpr (Epi::AFTER_DRAIN) { E.fused(acc, cur, wr, wc, fr, fq, lds, wid, lane); S.done(cur); }
#undef PG8_SA
#undef PG8_SB
#undef PG8_STAGE
#undef PG8_LDA
#undef PG8_LDB
#undef PG8_MMA
#undef PG8_WAIT_V
#undef PG8_WAIT_L
#undef PG8_BAR
#undef PG8_SCHED
}
}

#define GAS __attribute__((address_space(1)))
#define LAS __attribute__((address_space(3)))
typedef GAS unsigned gu32;
#define RLX_AGENT __ATOMIC_RELAXED, __HIP_MEMORY_SCOPE_AGENT
#define LDS_WAIT() asm volatile("s_waitcnt lgkmcnt(0)" ::: "memory")
#define VM_WAIT() asm volatile("s_waitcnt vmcnt(0)" ::: "memory")
#define XB_TMO      128
#define XB_XCNT(j)  (256  + 64 * (j))
#define XB_XSUB(j)  (1280 + 64 * (j))
#define XB_XGEN(j)  (2304 + 64 * (j))
#define XB_TOP      3328
#define XB_TOPGEN   3392
#define XCD_BAR_WORDS 3456
#define XB_SPIN_CAP (1u << 20)
__device__ __forceinline__ unsigned xb_ld(unsigned* p)              { return __hip_atomic_load(p, __ATOMIC_RELAXED, __HIP_MEMORY_SCOPE_AGENT); }
__device__ __forceinline__ unsigned xb_add(unsigned* p, unsigned v) { return __hip_atomic_fetch_add(p, v, __ATOMIC_RELAXED, __HIP_MEMORY_SCOPE_AGENT); }
__device__ __forceinline__ unsigned xb_xcc_id() { return (unsigned)__builtin_amdgcn_s_getreg((3 << 11) | 20) & 0xFu; }
#define XB_SPIN(cond, bar) do { unsigned _sp = 0; while (cond) { __builtin_amdgcn_s_sleep(1); \
    if ((++_sp & 255u) == 0u) { if (xb_ld(&(bar)[XB_TMO])) break; if (_sp > XB_SPIN_CAP) { atomicAdd(&(bar)[XB_TMO], 1u); break; } } } } while (0)
struct XcdBarrier { unsigned* bar; unsigned x; volatile LAS unsigned* st; };
__device__ __forceinline__ XcdBarrier xcd_barrier_post(unsigned* bar, volatile LAS unsigned* st) {
    XcdBarrier b; b.bar = bar; b.x = xb_xcc_id(); b.st = st;
    if (threadIdx.x == 0) (void)xb_add(&bar[XB_XCNT(b.x)], 1u);
    return b;
}
__device__ __forceinline__ void xcd_barrier_complete(unsigned* bar, unsigned x, unsigned& nloc, unsigned& nx) {
    const unsigned G = gridDim.x * gridDim.y * gridDim.z;
    unsigned sum, cnt, mine, sp = 0u;
    for (;;) {
        sum = 0u; cnt = 0u; mine = 0u;
#pragma unroll
        for (unsigned j = 0; j < 16; ++j) { const unsigned c = xb_ld(&bar[XB_XCNT(j)]); sum += c; cnt += (c > 0u) ? 1u : 0u; mine = (j == x) ? c : mine; }
        if (sum == G) break;
        __builtin_amdgcn_s_sleep(1);
        if ((++sp & 255u) == 0u) { if (xb_ld(&bar[XB_TMO])) break; if (sp > XB_SPIN_CAP) { atomicAdd(&bar[XB_TMO], 1u); break; } }
    }
    nloc = mine > 0u ? mine : 1u; nx = cnt > 0u ? cnt : 1u;
}
__device__ __forceinline__ void xcd_barrier(const XcdBarrier& b) {
    asm volatile("s_waitcnt vmcnt(0)" ::: "memory");
    __syncthreads();
    if (threadIdx.x == 0) {
        unsigned* bar = b.bar;
        __builtin_amdgcn_s_waitcnt(0);
        unsigned nloc = b.st[0], nx = b.st[1];
        if (nloc == 0u) { xcd_barrier_complete(bar, b.x, nloc, nx); b.st[0] = nloc; b.st[1] = nx; }
        const unsigned old = xb_add(&bar[XB_XSUB(b.x)], 1u);
        const unsigned gen = old / nloc;
        if (old + 1u == (gen + 1u) * nloc) {
            __builtin_amdgcn_fence(__ATOMIC_RELEASE, "agent");
            asm volatile("s_waitcnt vmcnt(0)" ::: "memory");
            const unsigned og = xb_add(&bar[XB_TOP], 1u);
            const unsigned tg = og / nx;
            if (og + 1u == (tg + 1u) * nx) xb_add(&bar[XB_TOPGEN], 1u);
            else XB_SPIN(xb_ld(&bar[XB_TOPGEN]) == tg, bar);
            __builtin_amdgcn_fence(__ATOMIC_ACQUIRE, "agent");
            xb_add(&bar[XB_XGEN(b.x)], 1u);
            asm volatile("s_waitcnt vmcnt(0)" ::: "memory");
        } else {
            XB_SPIN(xb_ld(&bar[XB_XGEN(b.x)]) == gen, bar);
            __builtin_amdgcn_fence(__ATOMIC_ACQUIRE, "agent");
            asm volatile("s_waitcnt vmcnt(0)" ::: "memory");
        }
    }
    __syncthreads();
}

constexpr int NWAVES = 8;
constexpr int RING_OFF = 0, RING_BYTES = 131072;
constexpr int LDSCTL_OFF = RING_BYTES, MISC_OFF = LDSCTL_OFF + 320;
constexpr int LDS_BYTES = 147456;
constexpr int CW_TMO = 0, CW_CODE = 1, CW_BAR = 4096, CW_QUEUE = 8192, CW_MKV = 10240, CW_TIME = 12288, CW_SEAM = 16384;
constexpr size_t CTL_ZERO_BYTES = 64 * 1024;

struct Frame {
    LAS unsigned char* lds; volatile LAS unsigned* MISC; unsigned* ctl;
    int tid, lane, wave, vcu, G;
    unsigned long long tprev;
    Bufs B;
};

__device__ __forceinline__ void p0_transpose_item(const Bufs& B, int kind, int N, size_t dst_off, LAS float* scr, int item, int lane) {
    const int nblk = N / 32, kb = item / nblk, nb = item % nblk, k0 = 64 * kb, n0 = 32 * nb;
#pragma unroll
    for (int h = 0; h < 2; ++h) { float tv[16];
#pragma unroll
        for (int i = 0; i < 16; ++i) tv[i] = wsrc(B, kind, k0 + 2 * (16 * h + i) + (lane >> 5), n0 + (lane & 31));
#pragma unroll
        for (int i = 0; i < 16; ++i) scr[(2 * (16 * h + i) + (lane >> 5)) * 33 + (lane & 31)] = tv[i]; }
    LDS_WAIT(); asm volatile("" ::: "memory");
    const int c = lane & 7; bf16* WT = WSP(bf16, dst_off);
#pragma unroll
    for (int j = 0; j < 4; ++j) { const int n = (lane >> 3) + 8 * j; const LAS float* s = scr + (8 * c) * 33 + n;
        v4u o; o.x = pk2(s[0 * 33], s[1 * 33]); o.y = pk2(s[2 * 33], s[3 * 33]); o.z = pk2(s[4 * 33], s[5 * 33]); o.w = pk2(s[6 * 33], s[7 * 33]);
        *(v4u*)(WT + (size_t)(n0 + n) * 1024 + k0 + 8 * c) = o; }
    LDS_WAIT(); asm volatile("" ::: "memory");
}
__device__ __forceinline__ float wave_sum(float v) {
#pragma unroll
    for (int o = 1; o < 64; o <<= 1) v += __shfl_xor(v, o);
    return v;
}
__device__ __forceinline__ void ln_in_rows(const Bufs& B, int gw, int NGW, int lane) {
    f32x4 v[4], nx[4];
    if (gw < M) { const f32x4* xr = (const f32x4*)(B.x + (size_t)gw * D) + lane;
#pragma unroll
        for (int j = 0; j < 4; ++j) v[j] = __builtin_nontemporal_load(xr + 64 * j); }
    f32x4 g[4], b[4];
#pragma unroll
    for (int j = 0; j < 4; ++j) { g[j] = *((const f32x4*)B.ln_in_g + lane + 64 * j); b[j] = *((const f32x4*)B.ln_in_b + lane + 64 * j); }
    for (int row = gw; row < M; row += NGW) {
        const int nr = row + NGW;
        if (nr < M) { const f32x4* xr = (const f32x4*)(B.x + (size_t)nr * D) + lane;
#pragma unroll
            for (int j = 0; j < 4; ++j) nx[j] = __builtin_nontemporal_load(xr + 64 * j); }
        float s = 0.f;
#pragma unroll
        for (int j = 0; j < 4; ++j) s += (v[j].x + v[j].y) + (v[j].z + v[j].w);
        const float mean = wave_sum(s) * (1.f / D); float s2 = 0.f;
#pragma unroll
        for (int j = 0; j < 4; ++j) { v[j] = v[j] - mean; s2 += (v[j].x * v[j].x + v[j].y * v[j].y) + (v[j].z * v[j].z + v[j].w * v[j].w); }
        const float rstd = rsqrtf(wave_sum(s2) * (1.f / D) + LN_EPS);
        if (lane == 0) { float* st = WSP(float, WS_STATS) + (size_t)row * 2; st[0] = mean; st[1] = rstd; }
        unsigned long long* o8 = (unsigned long long*)(WSP(bf16, WS_XN) + (size_t)row * D) + lane;
#pragma unroll
        for (int j = 0; j < 4; ++j) { const f32x4 y = v[j] * rstd * g[j] + b[j];
            o8[64 * j] = (unsigned long long)pk2(y.x, y.y) | ((unsigned long long)pk2(y.z, y.w) << 32); }
#pragma unroll
        for (int j = 0; j < 4; ++j) v[j] = nx[j];
    }
}
__device__ __forceinline__ void p0_prologue(Frame& F) {
    const Bufs& B = F.B;
    LAS float* scr = (LAS float*)(F.lds + RING_OFF + F.wave * 16384);
    const int gw = F.vcu * NWAVES + F.wave, NGW = F.G * NWAVES;
    constexpr int I0 = 16 * (NPOS / 32), I2 = 16 * 32;
    constexpr int NITEMS = I0 + 4 * I2;
    for (int it = gw; it < NITEMS; it += NGW) {
        int r = it;
        if (r < I0) { p0_transpose_item(B, 0, NPOS, WS_WIN, scr, r, (int)(threadIdx.x & 63u)); continue; } r -= I0;
        if (r < I2) { p0_transpose_item(B, 2, 1024, WS_WMEM, scr, r, (int)(threadIdx.x & 63u)); continue; } r -= I2;
        if (r < I2) { p0_transpose_item(B, 3, 1024, WS_WAB, scr, r, (int)(threadIdx.x & 63u)); continue; } r -= I2;
        if (r < I2) { p0_transpose_item(B, 4, 1024, WS_WC, scr, r, (int)(threadIdx.x & 63u)); continue; } r -= I2;
        p0_transpose_item(B, 5, 1024, WS_WOUT, scr, r, (int)(threadIdx.x & 63u));
    }
    ln_in_rows(B, gw, NGW, (int)(threadIdx.x & 63u));
    const int gid = gw * 64 + (int)(threadIdx.x & 63u), nth = NGW * 64;
    for (int i = gid; i < MM * D / 4; i += nth) { const f32x4 v = __builtin_nontemporal_load((const f32x4*)B.mem + i); ((unsigned long long*)WSP(bf16, WS_MEMB))[i] = (unsigned long long)pk2(v.x, v.y) | ((unsigned long long)pk2(v.z, v.w) << 32); }
    for (int i = gid; i < SEQ * 8; i += nth) { const int pos = i >> 3, f = i & 7;
        const float inv = powf(500000.0f, -(float)f * 0.125f); const float ang = (float)pos * inv;
        float* t64 = WSP(float, WS_TAB) + pos * 16; t64[f] = cosf(ang); t64[8 + f] = sinf(ang);
        if ((f & 1) == 0) { float* t32 = WSP(float, WS_TAB32) + pos * 8; t32[f >> 1] = cosf(ang); t32[4 + (f >> 1)] = sinf(ang); } }
    if (gid == 0) { float a = 0.f, b = 0.f; for (int i = 0; i < 64; ++i) { a += B.diff_lambda[i] * B.diff_lambda[64 + i]; b += B.diff_lambda[128 + i] * B.diff_lambda[192 + i]; }
        *WSP(float, WS_LAM) = expf(a) - expf(b) + LAM_INIT; }
}

struct SchedOne {
    int pm, pn; const char* MEMB; const char* WMEM;
    __device__ __forceinline__ bool next(int i, pg8::Unit& u) const {
        if (i > 0) return false;
        u.pm = pm; u.pn = pn; u.A = MEMB + (size_t)pm * pg8::TSTEP; u.B = WMEM + (size_t)pn * pg8::TSTEP; u.nt = 16; u.kind = 1; u.keep = 0; return true;
    }
    __device__ __forceinline__ void a_ready(const pg8::Unit&) const {}
    __device__ __forceinline__ void done(const pg8::Unit&) const {}
};
struct SchedIn {
    pg8::TileOrder T; int G, c; const char* XN; const char* WIN; const char* MEMB; const char* WMEM;
    __device__ __forceinline__ bool next(int i, pg8::Unit& u) const {
        const int L = i * G + c;
        if (L < T.nwg) { T.tile(L, u.pm, u.pn); u.A = XN + (size_t)u.pm * pg8::TSTEP; u.B = WIN + (size_t)u.pn * pg8::TSTEP; u.nt = 16; u.kind = 0; u.keep = 0; return true; }
        return false;
    }
    __device__ __forceinline__ void a_ready(const pg8::Unit&) const {}
    __device__ __forceinline__ void done(const pg8::Unit&) const {}
};
template <int KIND> __device__ __forceinline__ void epi_in_loops(const Bufs& B, const pg8::f32x4 (&acc)[2][2][4][2], int row0, int c0) {
#pragma unroll
    for (int ai = 0; ai < 2; ++ai)
#pragma unroll
        for (int m = 0; m < 4; ++m)
#pragma unroll
            for (int bj = 0; bj < 2; ++bj) {
                float v[8] = {acc[ai][bj][m][0][0], acc[ai][bj][m][0][1], acc[ai][bj][m][0][2], acc[ai][bj][m][0][3], acc[ai][bj][m][1][0], acc[ai][bj][m][1][1], acc[ai][bj][m][1][2], acc[ai][bj][m][1][3]};
                const int row = row0 + ai * 128 + m * 16, c = c0 + bj * 128;
                if constexpr (KIND == 100) store8(WSP(bf16, WS_MKV) + (size_t)row * 1024 + c, v);
                else emit8k<KIND>(B, row, c, v);
            }
}
struct EpiIn {
    static constexpr bool PERM = true, AFTER_DRAIN = false; Bufs B;
    __device__ __forceinline__ void operator()(const pg8::f32x4 (&acc)[2][2][4][2], const pg8::Unit& u, int wr, int wc, int fr, int fq) const {
        const int row0 = u.pm * 256 + wr * 64 + fr, cw = wc * 32 + 8 * fq;
        if (u.kind == 1) { epi_in_loops<100>(B, acc, row0, u.pn * 256 + cw); return; }
        const int c0 = (u.pn < 16 ? (u.pn & 1) * 256 : (u.pn < 18 ? 0 : (u.pn - 18) * 256)) + cw;
        switch (kind_of_tile(u.pn)) {
        case K_AQ: epi_in_loops<K_AQ>(B, acc, row0, c0); break;  case K_AG: epi_in_loops<K_AG>(B, acc, row0, c0); break;
        case K_BQ: epi_in_loops<K_BQ>(B, acc, row0, c0); break;  case K_BK: epi_in_loops<K_BK>(B, acc, row0, c0); break;
        case K_BV: epi_in_loops<K_BV>(B, acc, row0, c0); break;  case K_BG: epi_in_loops<K_BG>(B, acc, row0, c0); break;
        case K_CQ: epi_in_loops<K_CQ>(B, acc, row0, c0); break;  case K_CG: epi_in_loops<K_CG>(B, acc, row0, c0); break;
        case K_IQ: epi_in_loops<K_IQ>(B, acc, row0, c0); break;  case K_MG: epi_in_loops<K_MG>(B, acc, row0, c0); break;  default:   epi_in_loops<K_MISC>(B, acc, row0, c0); break;
        }
    }
};

#ifndef PROBE_DRY
#define PROBE_DRY 0
#endif
#ifndef PROBE_DMODE
#define PROBE_DMODE 1
#endif
#ifndef FAST_A
#define FAST_A 1
#endif
#ifndef FAST_B
#define FAST_B 1
#endif
#ifndef FAST_C
#define FAST_C 1
#endif
#ifndef TIMING_SEL
#define TIMING_SEL -1
#endif
#define TIMING (TIMING_SEL >= 0)
#define TST(k) do { if (TIMING && threadIdx.x == 0) { const unsigned now_ = (unsigned)__builtin_amdgcn_s_memrealtime(); F.MISC[16 + (k)] += now_ - F.MISC[14]; F.MISC[14] = now_; } } while (0)
namespace att {
typedef short bf16x8 __attribute__((ext_vector_type(8)));
typedef short v4i16_t __attribute__((ext_vector_type(4)));
typedef float f32x16 __attribute__((ext_vector_type(16)));
constexpr int L_K = 0, L_V = 32768, L_MASK = 131072 + 1024, L_X = 65536, L_NG = 141312;
constexpr float NEG_BIG = -1.0e30f;

__device__ __forceinline__ float hswap_max(float v) { auto rr = __builtin_amdgcn_permlane32_swap(__float_as_uint(v), __float_as_uint(v), false, false); return fmaxf(__uint_as_float(rr[0]), __uint_as_float(rr[1])); }
__device__ __forceinline__ float hswap_sum(float v) { auto rr = __builtin_amdgcn_permlane32_swap(__float_as_uint(v), __float_as_uint(v), false, false); return __uint_as_float(rr[0]) + __uint_as_float(rr[1]); }
__device__ __forceinline__ unsigned cvtpk(float lo, float hi) { typedef float f2 __attribute__((ext_vector_type(2))); typedef __bf16 b2 __attribute__((ext_vector_type(2))); f2 v = {lo, hi}; b2 b = __builtin_convertvector(v, b2); return __builtin_bit_cast(unsigned, b); }

template <int DQK, int DV> struct WState { bf16x8 qf[DQK / 16]; f32x16 o[DV / 32]; float m, l; };

template <int KPB> __device__ __forceinline__ int ksw(int row) { return KPB == 128 ? ((row >> 1) & 7) : (row & 15); }
template <int KPB, int DV> struct Stage {
    static constexpr int NK = KPB / 128, NV = DV / 64;
    v4u kr[NK], vr[NV];
    __device__ __forceinline__ void load(const char* kg, size_t kpitch, const char* vg, size_t vpitch, int key0, int tid) {
#pragma unroll
        for (int i = 0; i < NK; ++i) { const int idx = tid + 512 * i, key = idx / (KPB / 16), ch = idx % (KPB / 16); kr[i] = *(const v4u*)(kg + (size_t)(key0 + key) * kpitch + ch * 16); }
#pragma unroll
        for (int i = 0; i < NV; ++i) { const int idx = tid + 512 * i, key = idx / (DV / 8), ch = idx % (DV / 8); vr[i] = *(const v4u*)(vg + (size_t)(key0 + key) * vpitch + ch * 16); }
    }
    __device__ __forceinline__ void store(LAS unsigned char* lds, int buf, int tid) const {
#pragma unroll
        for (int i = 0; i < NK; ++i) { const int idx = tid + 512 * i, key = idx / (KPB / 16), ch = idx % (KPB / 16); *(LAS v4u*)(lds + L_K + buf * 16384 + key * KPB + ((ch ^ ksw<KPB>(key)) << 4)) = kr[i]; }
#pragma unroll
        for (int i = 0; i < NV; ++i) { const int idx = tid + 512 * i, key = idx / (DV / 8), ch = idx % (DV / 8); *(LAS v4u*)(lds + L_V + buf * 16384 + (ch >> 2) * 4096 + key * 64 + (ch & 3) * 16) = vr[i]; }
    }
};

template <int DQK, int DV, int KPB, bool MASKED>
__device__ __forceinline__ void tile_compute(WState<DQK, DV>& W, LAS unsigned char* lds, int buf, int kc0, int lane, const LAS unsigned* mrow  , int koff = -1, int voff = -1) {
    const int r32 = lane & 31, hi = lane >> 5;
    const LAS unsigned char* kb = lds + (koff >= 0 ? koff : L_K + buf * 16384);
    const LAS unsigned char* vb = lds + (voff >= 0 ? voff : L_V + buf * 16384) + ((lane >> 4) & 1) * 32 + (lane & 3) * 8 + (4 * hi + ((lane & 15) >> 2)) * 64;
#pragma unroll
    for (int kh = 0; kh < 2; ++kh) {
        const int row = 32 * kh + r32;
        f32x16 s = {};
#pragma unroll
        for (int ks = 0; ks < DQK / 16; ++ks) {
            const bf16x8 kf = *(const LAS bf16x8*)(kb + row * KPB + (((kc0 + 2 * ks + hi) ^ ksw<KPB>(row)) << 4));
            s = __builtin_amdgcn_mfma_f32_32x32x16_bf16(kf, W.qf[ks], s, 0, 0, 0);
        }
        if constexpr (MASKED) {
            const unsigned wsh = mrow[kh] >> (4 * hi);
#pragma unroll
            for (int r = 0; r < 16; ++r) { const unsigned mm = (unsigned)__builtin_amdgcn_sbfe((int)wsh, (r & 3) + 8 * (r >> 2), 1); s[r] = __uint_as_float((__float_as_uint(s[r]) & mm) | (0xFF800000u & ~mm)); }
        }
        float mx = s[0];
#pragma unroll
        for (int r = 1; r < 16; ++r) mx = fmaxf(mx, s[r]);
        mx = hswap_max(mx);
        const float mn = fmaxf(W.m, mx), alpha = __builtin_amdgcn_exp2f(W.m - mn);
        W.m = mn;
        float ps = 0.f;
#pragma unroll
        for (int r = 0; r < 16; ++r) { s[r] = __builtin_amdgcn_exp2f(s[r] - mn); ps += s[r]; }
        W.l = W.l * alpha + ps;
        if (__any(alpha != 1.0f)) {
#pragma unroll
            for (int dt = 0; dt < DV / 32; ++dt)
#pragma unroll
                for (int r = 0; r < 16; ++r) W.o[dt][r] *= alpha;
        }
        v4u pw0, pw1;
        pw0.x = cvtpk(s[0], s[1]); pw0.y = cvtpk(s[2], s[3]); pw0.z = cvtpk(s[4], s[5]); pw0.w = cvtpk(s[6], s[7]);
        pw1.x = cvtpk(s[8], s[9]); pw1.y = cvtpk(s[10], s[11]); pw1.z = cvtpk(s[12], s[13]); pw1.w = cvtpk(s[14], s[15]);
        const bf16x8 pf0 = __builtin_bit_cast(bf16x8, pw0), pf1 = __builtin_bit_cast(bf16x8, pw1);
#pragma unroll
        for (int dt = 0; dt < DV / 32; ++dt) {
#pragma unroll
            for (int sidx = 0; sidx < 2; ++sidx) {
                const LAS unsigned char* p = vb + dt * 4096 + (32 * kh + 16 * sidx) * 64;
                const v4i16_t lo = __builtin_amdgcn_ds_read_tr16_b64_v4i16((LAS v4i16_t*)p);
                const v4i16_t hh = __builtin_amdgcn_ds_read_tr16_b64_v4i16((LAS v4i16_t*)(p + 512));
                const bf16x8 vf = (bf16x8){lo[0], lo[1], lo[2], lo[3], hh[0], hh[1], hh[2], hh[3]};
                W.o[dt] = __builtin_amdgcn_mfma_f32_32x32x16_bf16(vf, sidx == 0 ? pf0 : pf1, W.o[dt], 0, 0, 0);
            }
        }
    }
}

template <int DQK, int DV, int KPB, bool MASKED>
__device__ __forceinline__ void tile_loop_simple(WState<DQK, DV>& W, LAS unsigned char* lds, const char* kg, size_t kpitch, const char* vg, size_t vpitch, int nT, int my_nt, int kc0, int tid, int lane, const LAS unsigned* mq) {
    Stage<KPB, DV> st;
    st.load(kg, kpitch, vg, vpitch, 0, tid); st.store(lds, 0, tid);
    __syncthreads();
    for (int t = 0; t < nT; ++t) {
        if (t + 1 < nT) st.load(kg, kpitch, vg, vpitch, 64 * (t + 1), tid);
        if (t < my_nt) tile_compute<DQK, DV, KPB, MASKED>(W, lds, t & 1, kc0, lane, MASKED ? mq + 2 * t : mq);
        if (t + 1 < nT) st.store(lds, (t + 1) & 1, tid);
        __syncthreads();
    }
}
template <int KPB> struct StageK {
    static constexpr int NK = KPB / 128; v4u kr[NK];
    __device__ __forceinline__ void load(const char* kg, size_t kpitch, int key0, int tid) {
#pragma unroll
        for (int i = 0; i < NK; ++i) { const int idx = tid + 512 * i, key = idx / (KPB / 16), ch = idx % (KPB / 16); kr[i] = *(const v4u*)(kg + (size_t)(key0 + key) * kpitch + ch * 16); }
    }
    __device__ __forceinline__ void store(LAS unsigned char* lds, int slot, int tid) const {
#pragma unroll
        for (int i = 0; i < NK; ++i) { const int idx = tid + 512 * i, key = idx / (KPB / 16), ch = idx % (KPB / 16); *(LAS v4u*)(lds + L_K + slot * 16384 + key * KPB + ((ch ^ ksw<KPB>(key)) << 4)) = kr[i]; }
    }
};
template <int DV> struct StageV {
    static constexpr int NV = DV / 64; v4u vr[NV];
    __device__ __forceinline__ void load(const char* vg, size_t vpitch, int key0, int tid) {
#pragma unroll
        for (int i = 0; i < NV; ++i) { const int idx = tid + 512 * i, key = idx / (DV / 8), ch = idx % (DV / 8); vr[i] = *(const v4u*)(vg + (size_t)(key0 + key) * vpitch + ch * 16); }
    }
    __device__ __forceinline__ void store(LAS unsigned char* lds, int slot, int tid) const { store_off(lds, slot * 16384, tid); }
    __device__ __forceinline__ void store_off(LAS unsigned char* lds, int off, int tid) const {
#pragma unroll
        for (int i = 0; i < NV; ++i) { const int idx = tid + 512 * i, key = idx / (DV / 8), ch = idx % (DV / 8); *(LAS v4u*)(lds + L_V + off + (ch >> 2) * 4096 + key * 64 + (ch & 3) * 16) = vr[i]; }
    }
};
#define SBAR() __builtin_amdgcn_sched_barrier(0)
template <int DQK, int KPB> __device__ __forceinline__ void k_frags(bf16x8 (&kf)[DQK / 16], const LAS unsigned char* kb, int kc0, int r32, int hi, int kh) {
    const int row = 32 * kh + r32;
#pragma unroll
    for (int ks = 0; ks < DQK / 16; ++ks) kf[ks] = *(const LAS bf16x8*)(kb + row * KPB + (((kc0 + 2 * ks + hi) ^ ksw<KPB>(row)) << 4));
}
template <int DQK, int KPB> __device__ __forceinline__ void qk_tile(f32x16 (&s)[2], const bf16x8* qf, const LAS unsigned char* kb, int kc0, int r32, int hi) {
    bf16x8 kf0[DQK / 16], kf1[DQK / 16]; k_frags<DQK, KPB>(kf0, kb, kc0, r32, hi, 0); k_frags<DQK, KPB>(kf1, kb, kc0, r32, hi, 1);
    f32x16 a = {}, b = {};
#pragma unroll
    for (int ks = 0; ks < DQK / 16; ++ks) a = __builtin_amdgcn_mfma_f32_32x32x16_bf16(kf0[ks], qf[ks], a, 0, 0, 0);
#pragma unroll
    for (int ks = 0; ks < DQK / 16; ++ks) b = __builtin_amdgcn_mfma_f32_32x32x16_bf16(kf1[ks], qf[ks], b, 0, 0, 0);
    s[0] = a; s[1] = b;
}
template <int DQK, int DV, int KPB, bool MASKED> __device__ __forceinline__ void step_sm(WState<DQK, DV>& W, f32x16 (&sc)[2], f32x16 (&sn)[2], bf16x8 (&pf)[4], const LAS unsigned char* kb_next, int kc0, int lane, const LAS unsigned* mrow) {
    const int r32 = lane & 31, hi = lane >> 5;
    bf16x8 kf0[DQK / 16]; k_frags<DQK, KPB>(kf0, kb_next, kc0, r32, hi, 0);
    if constexpr (MASKED) {
#pragma unroll
        for (int kh = 0; kh < 2; ++kh) { const unsigned wsh = mrow[kh] >> (4 * hi);
#pragma unroll
            for (int r = 0; r < 16; ++r) { const unsigned mm = (unsigned)__builtin_amdgcn_sbfe((int)wsh, (r & 3) + 8 * (r >> 2), 1); sc[kh][r] = __uint_as_float((__float_as_uint(sc[kh][r]) & mm) | (0xFF800000u & ~mm)); } }
    }
    float mx = fmaxf(sc[0][0], sc[1][0]);
#pragma unroll
    for (int r = 1; r < 16; ++r) mx = fmaxf(fmaxf(mx, sc[0][r]), sc[1][r]);
    mx = hswap_max(mx);
    const float mn = (mx > W.m + 8.0f) ? mx : W.m, alpha = __builtin_amdgcn_exp2f(W.m - mn);
    W.m = mn;
    if (__any(alpha != 1.0f)) {
#pragma unroll
        for (int dt = 0; dt < DV / 32; ++dt)
#pragma unroll
            for (int r = 0; r < 16; ++r) W.o[dt][r] *= alpha;
    }
    SBAR();
    float mn_ = mn; asm volatile("" : "+v"(kf0[0]), "+v"(mn_));
    float ps0 = 0.f, ps1 = 0.f;
    { f32x16 a = {}, b = {};
#pragma unroll
      for (int ks = 0; ks < DQK / 16; ++ks) a = __builtin_amdgcn_mfma_f32_32x32x16_bf16(kf0[ks], W.qf[ks], a, 0, 0, 0);
      k_frags<DQK, KPB>(kf0, kb_next, kc0, r32, hi, 1);
#pragma unroll
      for (int ks = 0; ks < DQK / 16; ++ks) b = __builtin_amdgcn_mfma_f32_32x32x16_bf16(kf0[ks], W.qf[ks], b, 0, 0, 0);
      sn[0] = a; sn[1] = b; }
#pragma unroll
    for (int r = 0; r < 16; ++r) { sc[0][r] = __builtin_amdgcn_exp2f(sc[0][r] - mn_); ps0 += sc[0][r]; sc[1][r] = __builtin_amdgcn_exp2f(sc[1][r] - mn_); ps1 += sc[1][r]; }
#pragma unroll
    for (int i = 0; i < 2 * (DQK / 16); ++i) { __builtin_amdgcn_sched_group_barrier(0x008, 1, 0); __builtin_amdgcn_sched_group_barrier(0x002, (96 + 2 * (DQK / 16) - 1) / (2 * (DQK / 16)), 0); }
    SBAR();
    W.l = W.l * alpha + (ps0 + ps1);
#pragma unroll
    for (int kh = 0; kh < 2; ++kh) { v4u a, b;
        a.x = cvtpk(sc[kh][0], sc[kh][1]); a.y = cvtpk(sc[kh][2], sc[kh][3]); a.z = cvtpk(sc[kh][4], sc[kh][5]); a.w = cvtpk(sc[kh][6], sc[kh][7]);
        b.x = cvtpk(sc[kh][8], sc[kh][9]); b.y = cvtpk(sc[kh][10], sc[kh][11]); b.z = cvtpk(sc[kh][12], sc[kh][13]); b.w = cvtpk(sc[kh][14], sc[kh][15]);
        pf[2 * kh] = __builtin_bit_cast(bf16x8, a); pf[2 * kh + 1] = __builtin_bit_cast(bf16x8, b); }
}
template <int DQK, int DV> __device__ __forceinline__ void step_pv(WState<DQK, DV>& W, const bf16x8 (&pf)[4], const LAS unsigned char* vbase, int lane) {
    const int hi = lane >> 5;
    const LAS unsigned char* vb = vbase + ((lane >> 4) & 1) * 32 + (lane & 3) * 8 + (4 * hi + ((lane & 15) >> 2)) * 64;
    if constexpr (DV <= 64) {
        v4i16_t vl[2][4], vh[2][4];
#pragma unroll
        for (int k4 = 0; k4 < 4; ++k4) { vl[0][k4] = __builtin_amdgcn_ds_read_tr16_b64_v4i16((LAS v4i16_t*)(vb + (16 * k4) * 64)); vh[0][k4] = __builtin_amdgcn_ds_read_tr16_b64_v4i16((LAS v4i16_t*)(vb + (16 * k4) * 64 + 512)); }
#pragma unroll
        for (int dt = 0; dt < DV / 32; ++dt) {
            if (dt + 1 < DV / 32) {
#pragma unroll
                for (int k4 = 0; k4 < 4; ++k4) { vl[(dt + 1) & 1][k4] = __builtin_amdgcn_ds_read_tr16_b64_v4i16((LAS v4i16_t*)(vb + (dt + 1) * 4096 + (16 * k4) * 64)); vh[(dt + 1) & 1][k4] = __builtin_amdgcn_ds_read_tr16_b64_v4i16((LAS v4i16_t*)(vb + (dt + 1) * 4096 + (16 * k4) * 64 + 512)); }
            }
            SBAR();
#pragma unroll
            for (int k4 = 0; k4 < 4; ++k4) { const v4i16_t lo = vl[dt & 1][k4], hh = vh[dt & 1][k4];
                const bf16x8 vf = (bf16x8){lo[0], lo[1], lo[2], lo[3], hh[0], hh[1], hh[2], hh[3]};
                W.o[dt] = __builtin_amdgcn_mfma_f32_32x32x16_bf16(vf, pf[k4], W.o[dt], 0, 0, 0); }
            SBAR();
        }
    } else {
#pragma unroll
        for (int dt = 0; dt < DV / 32; ++dt) {
            v4i16_t vl[4], vh[4];
#pragma unroll
            for (int k4 = 0; k4 < 4; ++k4) { vl[k4] = __builtin_amdgcn_ds_read_tr16_b64_v4i16((LAS v4i16_t*)(vb + dt * 4096 + (16 * k4) * 64)); vh[k4] = __builtin_amdgcn_ds_read_tr16_b64_v4i16((LAS v4i16_t*)(vb + dt * 4096 + (16 * k4) * 64 + 512)); }
            SBAR();
#pragma unroll
            for (int k4 = 0; k4 < 4; ++k4) { const v4i16_t lo = vl[k4], hh = vh[k4];
                const bf16x8 vf = (bf16x8){lo[0], lo[1], lo[2], lo[3], hh[0], hh[1], hh[2], hh[3]};
                W.o[dt] = __builtin_amdgcn_mfma_f32_32x32x16_bf16(vf, pf[k4], W.o[dt], 0, 0, 0); }
            SBAR();
        }
    }
}
template <int DQK, int DV, int KPB, bool MASKED>
__device__ __forceinline__ void tile_loop(WState<DQK, DV>& W, LAS unsigned char* lds, const char* kg, size_t kpitch, const char* vg, size_t vpitch, int nT, int my_nt, int kc0, int tid, int lane, const LAS unsigned* mq, int mode = 0) {
    const int r32 = lane & 31, hi = lane >> 5;
    const bool lag = __builtin_amdgcn_readfirstlane(tid) >= 256;
    StageK<KPB> sk; StageV<DV> sv;
    sk.load(kg, kpitch, 0, tid); sv.load(vg, vpitch, 0, tid); sk.store(lds, 0, tid); sv.store(lds, 0, tid);
    if (nT > 1) { sk.load(kg, kpitch, 64, tid); sk.store(lds, 1, tid); }
    __syncthreads();
    f32x16 sc[2], sn[2]; bf16x8 pf[4];
    qk_tile<DQK, KPB>(sc, W.qf, lds + L_K, kc0, r32, hi);
    __syncthreads();
    volatile LAS unsigned* mstat = (volatile LAS unsigned*)(lds + MISC_OFF + 64);
    const bool tw = TIMING && (tid == 0);
    int vs_prev = 0, vs_cur = 0, vs_next = 16384;
    for (int t = 0; t < nT; ++t) {
        if (t + 2 < nT && mode != 3) sk.load(kg, kpitch, 64 * (t + 2), tid);
        if (t + 1 < nT && mode != 3) sv.load(vg, vpitch, 64 * (t + 1), tid);
        if (mode != 2 && t < my_nt) {
            if (lag && t > 0) step_pv<DQK, DV>(W, pf, lds + L_V + vs_prev, lane);
            step_sm<DQK, DV, KPB, MASKED>(W, sc, sn, pf, lds + L_K + ((t + 1) & 1) * 16384, kc0, lane, MASKED ? mq + 2 * t : mq);
            if (!lag) step_pv<DQK, DV>(W, pf, lds + L_V + vs_cur, lane);
#pragma unroll
            for (int r = 0; r < 16; ++r) { sc[0][r] = sn[0][r]; sc[1][r] = sn[1][r]; }
        }
        if (t + 2 < nT && mode != 3) sk.store(lds, t & 1, tid);
        if (t + 1 < nT && mode != 3) sv.store_off(lds, vs_next, tid);
        asm volatile("s_waitcnt vmcnt(0) lgkmcnt(0)" ::: "memory");
        __syncthreads();
        vs_prev = vs_cur; vs_cur = vs_next; vs_next = (vs_next == 32768) ? 0 : vs_next + 16384;
    }
    if (lag && mode != 2 && my_nt > 0) step_pv<DQK, DV>(W, pf, lds + L_V + vs_prev, lane);
    __syncthreads();
}
template <int DQK, int DV> __device__ __forceinline__ void wstate_init(WState<DQK, DV>& W, const bf16* qrow  , int hi) {
#pragma unroll
    for (int ks = 0; ks < DQK / 16; ++ks) W.qf[ks] = *(const bf16x8*)(qrow + 16 * ks + 8 * hi);
#pragma unroll
    for (int dt = 0; dt < DV / 32; ++dt) W.o[dt] = (f32x16){};
    W.m = NEG_BIG; W.l = 0.f;
}

__device__ __forceinline__ unsigned skey(float score, int idx) {
    const unsigned b = __float_as_uint(score); const unsigned k = b ^ ((unsigned)((int)b >> 31) | 0x80000000u);
    return ((k >> 1) & 0x7FFFF800u) | (unsigned)(2047 - idx);
}
__device__ __forceinline__ unsigned dpp_u(unsigned v, int ctrl_sel) {
    switch (ctrl_sel) {
    case 0: return (unsigned)__builtin_amdgcn_update_dpp(0, (int)v, 0xB1, 0xF, 0xF, true);
    case 1: return (unsigned)__builtin_amdgcn_update_dpp(0, (int)v, 0x4E, 0xF, 0xF, true);
    case 2: return (unsigned)__builtin_amdgcn_update_dpp(0, (int)v, 0x141, 0xF, 0xF, true);
    default: return (unsigned)__builtin_amdgcn_update_dpp(0, (int)v, 0x140, 0xF, 0xF, true);
    }
}
__device__ __forceinline__ unsigned half_sum(unsigned v, int hi) {
#pragma unroll
    for (int s = 0; s < 4; ++s) v += dpp_u(v, s);
    const unsigned s0 = (unsigned)__builtin_amdgcn_readlane((int)v, 0) + (unsigned)__builtin_amdgcn_readlane((int)v, 16), s1 = (unsigned)__builtin_amdgcn_readlane((int)v, 32) + (unsigned)__builtin_amdgcn_readlane((int)v, 48);
    return hi ? s1 : s0;
}
__device__ __forceinline__ float half_sumf(float v, int hi) {
#pragma unroll
    for (int s = 0; s < 4; ++s) v += __uint_as_float(dpp_u(__float_as_uint(v), s));
    const float s0 = __uint_as_float((unsigned)__builtin_amdgcn_readlane((int)__float_as_uint(v), 0)) + __uint_as_float((unsigned)__builtin_amdgcn_readlane((int)__float_as_uint(v), 16));
    const float s1 = __uint_as_float((unsigned)__builtin_amdgcn_readlane((int)__float_as_uint(v), 32)) + __uint_as_float((unsigned)__builtin_amdgcn_readlane((int)__float_as_uint(v), 48));
    return hi ? s1 : s0;
}
__device__ __forceinline__ unsigned half_max(unsigned v, int hi) {
#pragma unroll
    for (int s = 0; s < 4; ++s) { const unsigned o = dpp_u(v, s); v = v > o ? v : o; }
    const unsigned a0 = (unsigned)__builtin_amdgcn_readlane((int)v, 0), a1 = (unsigned)__builtin_amdgcn_readlane((int)v, 16), b0 = (unsigned)__builtin_amdgcn_readlane((int)v, 32), b1 = (unsigned)__builtin_amdgcn_readlane((int)v, 48);
    const unsigned s0 = a0 > a1 ? a0 : a1, s1 = b0 > b1 ? b0 : b1;
    return hi ? s1 : s0;
}
__device__ __forceinline__ float unskey(unsigned k31) { const unsigned k = k31 << 1; const unsigned b = (k & 0x80000000u) ? (k ^ 0x80000000u) : ~k; return __uint_as_float(b); }
__device__ __forceinline__ unsigned skey_f(float f) { const unsigned b = __float_as_uint(f); return ((b ^ ((unsigned)((int)b >> 31) | 0x80000000u)) >> 1) & 0x7FFFF800u; }
__device__ __forceinline__ void indexer_pass(const Bufs& B, const int S, const LAS unsigned char* ikl, LAS unsigned* masks, size_t rowb, int t0, int w, int lane, int ntl, int limit, bf16x8 a0, bf16x8 a1) {
    const int r32 = lane & 31, hi = lane >> 5;
    volatile LAS unsigned* mstat = (volatile LAS unsigned*)(ikl + MISC_OFF + 64);
    unsigned long long tstart_ = 0; if (TIMING && w == 0) tstart_ = __builtin_amdgcn_s_memrealtime();
    float wt[8];
    { const float* iwp = WSP(const float, WS_IW) + (rowb + t0 + 4 * w + 2 * hi + S) * 8;
      const f32x4 v0 = *(const f32x4*)iwp, v1 = *(const f32x4*)(iwp + 4); wt[0] = v0.x; wt[1] = v0.y; wt[2] = v0.z; wt[3] = v0.w; wt[4] = v1.x; wt[5] = v1.y; wt[6] = v1.z; wt[7] = v1.w; }
    const int sw = (r32 >> 2) & 3;
    const LAS unsigned char* p0 = ikl + r32 * 64 + ((hi ^ sw) << 4);
    const LAS unsigned char* p1 = ikl + r32 * 64 + (((2 + hi) ^ sw) << 4);
    unsigned key[64]; unsigned kmax = 0u, kmin = 0xFFFFFFFFu; float sm1 = 0.f, sm2 = 0.f;
#pragma unroll
    for (int tb = 0; tb < 16; ++tb) {
        if (4 * tb < ntl) {
#pragma unroll
            for (int tt = 0; tt < 4; ++tt) { const int t = 4 * tb + tt;
                const bf16x8 b0 = *(const LAS bf16x8*)(p0 + t * 2048), b1 = *(const LAS bf16x8*)(p1 + t * 2048);
                f32x16 acc = {};
                acc = __builtin_amdgcn_mfma_f32_32x32x16_bf16(a0, b0, acc, 0, 0, 0);
                acc = __builtin_amdgcn_mfma_f32_32x32x16_bf16(a1, b1, acc, 0, 0, 0);
                float s0 = 0.f;
#pragma unroll
                for (int h = 0; h < 8; ++h) { const int ai = __float_as_int(acc[h]); s0 += wt[h] * __int_as_float(ai > 0 ? ai : 0); }
                const unsigned k = skey(s0, 32 * t + r32);
                if (tt < 2) { key[t] = k; kmax = kmax > k ? kmax : k; kmin = kmin < k ? kmin : k; sm1 += s0; sm2 = fmaf(s0, s0, sm2); }
                else { const bool valid = t < ntl; const float sv_ = valid ? s0 : 0.f; sm1 += sv_; sm2 = fmaf(sv_, sv_, sm2); key[t] = valid ? k : 0u; const unsigned kx = valid ? k : 0u, kn = valid ? k : 0xFFFFFFFFu; kmax = kmax > kx ? kmax : kx; kmin = kmin < kn ? kmin : kn; }
            }
        } else {
#pragma unroll
            for (int tt = 0; tt < 4; ++tt) key[4 * tb + tt] = 0u;
        }
    }
    unsigned long long ti0_ = 0; if (TIMING && w == 0) { ti0_ = __builtin_amdgcn_s_memrealtime(); if (lane == 0) mstat[8] += (unsigned)(ti0_ - tstart_); }
    unsigned tau = 1u;
    if (limit > 256) {
        kmax = half_max(kmax, hi); kmin = ~half_max(~kmin, hi);
        unsigned lo = kmin & ~0x7FFu, hb = kmax + 1u; float lof = unskey(lo), hbf = unskey(kmax); bool dn = false;
        float flo = (float)limit - 256.5f, fhb = -256.5f; int lastside = 0;
        const float invn = __builtin_amdgcn_rcpf((float)limit), mu = half_sumf(sm1, hi) * invn, var = fmaxf(half_sumf(sm2, hi) * invn - mu * mu, 1e-30f), sg = __builtin_amdgcn_sqrtf(var);
        const float pq = 256.5f * invn, zq = __builtin_amdgcn_logf((1.f - pq) * __builtin_amdgcn_rcpf(pq)) * 0.40726f;
        const float tau0 = fmaf(zq, sg, mu), idens = sg * __builtin_amdgcn_rcpf((float)limit * 1.702f * pq * (1.f - pq));
        float tprev = tau0;
        for (int it = 0; it < 64; ++it) {
            if (!dn && hb - lo <= 1u) { tau = lo; dn = true; }
            if (__all(dn)) break;
            if (TIMING && w == 0 && lane == 0) mstat[11] += 100u;
            unsigned mid = skey_f((lof * fhb - hbf * flo) * __builtin_amdgcn_rcpf(fhb - flo));
            if (it < 2) { const float tg = it == 0 ? tau0 : fmaf(lastside == 1 ? flo : fhb, idens, tprev); tprev = tg; const unsigned mg = skey_f(tg); mid = ((mg > lo) & (mg < hb)) ? mg : mid; }
            { const unsigned m2 = skey_f(0.5f * (lof + hbf)); const bool bad = (mid <= lo) | (mid >= hb); mid = bad ? m2 : mid; const bool bad2 = (mid <= lo) | (mid >= hb); mid = bad2 ? lo + ((hb - lo) >> 1) : mid; }
            const unsigned mm1 = mid - 1u;
            unsigned c0 = 0, c1 = 0, c2 = 0, c3 = 0;
#pragma unroll
            for (int tb = 0; tb < 4; ++tb) {
                if (16 * tb < ntl) {
                    unsigned a0_ = 0, a1_ = 0;
#pragma unroll
                    for (int tt = 0; tt < 16; tt += 2) { a0_ = __builtin_amdgcn_alignbit(a0_, mm1 - key[16 * tb + tt], 31); a1_ = __builtin_amdgcn_alignbit(a1_, mm1 - key[16 * tb + tt + 1], 31); }
                    if (tb & 1) { c1 += __builtin_popcount(a0_); c3 += __builtin_popcount(a1_); } else { c0 += __builtin_popcount(a0_); c2 += __builtin_popcount(a1_); }
                }
            }
            const unsigned c = half_sum((c0 + c1) + (c2 + c3), hi);
            if (!dn) {
                if (c == 256u) { tau = mid; dn = true; }
                else if (c > 256u) { lo = mid; lof = unskey(mid); flo = (float)c - 256.5f; if (lastside == 1) fhb *= 0.5f; lastside = 1; }
                else { hb = mid; hbf = unskey(mid); fhb = (float)c - 256.5f; if (lastside == 2) flo *= 0.5f; lastside = 2; }
            }
        }
    }
    unsigned long long ti1_ = 0; if (TIMING && w == 0) { ti1_ = __builtin_amdgcn_s_memrealtime(); if (lane == 0) mstat[9] += (unsigned)(ti1_ - ti0_); }
    LAS unsigned* mb = (r32 == 0) ? masks + (4 * w + 2 * hi + S) * 64 : masks + 2048 + lane;
#pragma unroll
    for (int tb = 0; tb < 4; ++tb) {
        if (16 * tb < ntl) {
#pragma unroll
            for (int tt = 0; tt < 16; ++tt) { const int t = 16 * tb + tt;
                const unsigned long long m0 = __ballot(key[t] >= tau);
                mb[t] = hi ? (unsigned)(m0 >> 32) : (unsigned)m0; }
        }
    }
    if (TIMING && w == 0) { const unsigned long long ti2_ = __builtin_amdgcn_s_memrealtime(); if (lane == 0) mstat[10] += (unsigned)(ti2_ - ti1_); }
}
__device__ __forceinline__ void gather8(float (&v)[8], const f32x16& o, int gp) {
#pragma unroll
    for (int i = 0; i < 4; ++i) { auto rr = __builtin_amdgcn_permlane32_swap(__float_as_uint(o[8 * gp + i]), __float_as_uint(o[8 * gp + 4 + i]), false, false); v[i] = __uint_as_float(rr[0]); v[4 + i] = __uint_as_float(rr[1]); }
}
__device__ __forceinline__ v4u pack8(const float (&v)[8]) { v4u o; o.x = cvtpk(v[0], v[1]); o.y = cvtpk(v[2], v[3]); o.z = cvtpk(v[4], v[5]); o.w = cvtpk(v[6], v[7]); return o; }
__device__ __forceinline__ void unpack8(float (&g)[8], v4u w) { g[0] = bf2f(w.x & 0xffffu); g[1] = bf2f(w.x >> 16); g[2] = bf2f(w.y & 0xffffu); g[3] = bf2f(w.y >> 16); g[4] = bf2f(w.z & 0xffffu); g[5] = bf2f(w.z >> 16); g[6] = bf2f(w.w & 0xffffu); g[7] = bf2f(w.w >> 16); }
__device__ __forceinline__ void unit_A(Frame& F, int b, int qb32, int dmode) {
    const bool dry = dmode != 0;
    const Bufs& B = F.B; int tid_ = F.tid; asm volatile("" : "+v"(tid_)); const int tid = tid_, lane = tid & 63, w = F.wave, r32 = lane & 31, hi = lane >> 5;
    const int t0 = qb32 * 32, limit = ((t0 >> 6) + 1) << 6, ntl = limit >> 5;
    const size_t rowb = (size_t)b * SEQ;
    LAS unsigned* masks = (LAS unsigned*)(F.lds + L_MASK);
    {
        { const char* src = (const char*)(WSP(const bf16, WS_IK) + rowb * 32);
          const int P0 = w * 1024 + lane * 16, key0 = P0 >> 6, slot = (P0 >> 4) & 3;
#pragma unroll 1
          for (int s0 = 0; s0 < limit * 64; s0 += 8192) {
              const int key = key0 + (s0 >> 6);
              __builtin_amdgcn_global_load_lds((const unsigned*)(src + (size_t)key * 64 + ((slot ^ ((key >> 2) & 3)) << 4)), (LAS unsigned*)(F.lds + s0 + w * 1024), 16, 0, 0);
          } }
        asm volatile("s_waitcnt vmcnt(0)" ::: "memory");
        __syncthreads();
        TST(1);
        if (dmode != 3) {
#pragma unroll 1
        for (int sl = 0; sl < 2; ++sl) {
            const int rho = r32, qa = 2 * ((rho >> 2) & 1) + ((rho >> 4) ^ sl), ha = 4 * ((rho >> 3) & 1) + (rho & 3);
            const bf16* iqp = WSP(const bf16, WS_IQ) + (rowb + t0 + 4 * w + qa) * 256 + ha * 32 + 8 * hi;
            const bf16x8 a0 = *(const bf16x8*)iqp, a1 = *(const bf16x8*)(iqp + 16);
            indexer_pass(B, sl, F.lds, masks, rowb, t0, w, lane, ntl, limit, a0, a1);
        }
        }
    }
    __syncthreads();
    TST(2);
    {
        const int ql = 4 * w + (r32 >> 3), head = r32 & 7; const size_t row = rowb + t0 + ql;
        bf16* qrow = WSP(bf16, WS_QAB) + row * 1024 + head * 64;
        WState<64, 64> W; wstate_init<64, 64>(W, qrow, hi);
        const int nT = limit >> 6;
        __builtin_amdgcn_global_load_lds((const unsigned*)(WSP(const bf16, WS_AG) + row * 512 + head * 64), (LAS unsigned*)(F.lds + 98304 + w * 256), 4, 0, 0);
        tile_loop<64, 64, 128, true>(W, F.lds, (const char*)(WSP(const bf16, WS_AK) + rowb * 64), 128, (const char*)(WSP(const bf16, WS_AV) + rowb * 64), 128, dmode == 2 ? 1 : nT, dmode == 2 ? 1 : nT, 0, tid, lane, masks + ql * 64);
        TST(3);
        const float inv = 1.f / hswap_sum(W.l);
        const bf16* grow = WSP(const bf16, WS_AG) + row * 512 + head * 64;
        v4u gw[4];
#pragma unroll
        for (int q = 0; q < 4; ++q) gw[q] = *(const v4u*)(grow + 16 * q + 8 * hi);
#pragma unroll
        for (int dt = 0; dt < 2; ++dt)
#pragma unroll
            for (int gp = 0; gp < 2; ++gp) { const int d0 = 32 * dt + 16 * gp + 8 * hi;
                float v[8], g[8]; gather8(v, W.o[dt], gp); unpack8(g, gw[2 * dt + gp]);
#pragma unroll
                for (int i = 0; i < 8; ++i) v[i] = v[i] * inv * g[i];
                if (!dry) *(v4u*)(qrow + d0) = pack8(v); }
    }
    __syncthreads();
    TST(4);
}

__device__ __forceinline__ void unit_B(Frame& F, int b, int h, int qb128, int dmode) {
    const bool dry = dmode != 0;
    const Bufs& B = F.B; int tid_ = F.tid; asm volatile("" : "+v"(tid_)); const int tid = tid_, lane = tid & 63, w = F.wave, r32 = lane & 31, hi = lane >> 5;
    const int qb = w >> 1, c = w & 1, t0 = qb128 * 128 + qb * 32;
    const size_t rowb = (size_t)b * SEQ, row = rowb + t0 + r32;
    const int nT = 2 * qb128 + 2, my_nt = ((t0 >> 6) + 1);
    bf16* qrow = WSP(bf16, WS_QAB) + row * 1024 + 512 + h * 128;
    WState<64, 128> W; wstate_init<64, 128>(W, qrow + c * 64, hi);
    tile_loop<64, 128, 256, false>(W, F.lds, (const char*)(WSP(const bf16, WS_BK) + rowb * 512 + h * 128), 1024, (const char*)(WSP(const bf16, WS_BV) + rowb * 512 + h * 128), 1024, nT, my_nt, c * 8, tid, lane, nullptr, dmode);
    TST(5);
    const float inv = 1.f / hswap_sum(W.l);
    LAS float* X = (LAS float*)(F.lds + L_X) + qb * 4096 + lane;
    const bf16* grow = WSP(const bf16, WS_BG) + row * 512 + h * 128;
    v4u gpre[8];
    if (c == 0) {
#pragma unroll
        for (int q = 0; q < 8; ++q) gpre[q] = *(const v4u*)(grow + 16 * q + 8 * hi);
    }
    if (c == 1) {
#pragma unroll
        for (int dt = 0; dt < 4; ++dt)
#pragma unroll
            for (int r = 0; r < 16; ++r) X[(dt * 16 + r) * 64] = W.o[dt][r] * inv;
    }
    __syncthreads();
    if (c == 0) {
        const float lam = *(const LAS float*)(F.lds + L_NG + 512);
        float ss = 0.f;
#pragma unroll
        for (int dt = 0; dt < 4; ++dt)
#pragma unroll
            for (int r = 0; r < 16; ++r) { const float v = W.o[dt][r] * inv - lam * X[(dt * 16 + r) * 64]; W.o[dt][r] = v; ss += v * v; }
        ss = hswap_sum(ss);
        const float rn = rsqrtf(ss * (1.f / 128.f) + LN_EPS) * (1.f - LAM_INIT);
#pragma unroll
        for (int dt = 0; dt < 4; ++dt)
#pragma unroll
            for (int gp = 0; gp < 2; ++gp) { const int d0 = 32 * dt + 16 * gp + 8 * hi;
                float v[8], g[8]; gather8(v, W.o[dt], gp); unpack8(g, gpre[2 * dt + gp]);
                const f32x4 n0 = *(const LAS f32x4*)(F.lds + L_NG + d0 * 4), n1 = *(const LAS f32x4*)(F.lds + L_NG + d0 * 4 + 16);
#pragma unroll
                for (int i = 0; i < 8; ++i) v[i] = v[i] * rn * (i < 4 ? n0[i] : n1[i - 4]) * g[i];
                if (!dry) *(v4u*)(qrow + d0) = pack8(v); }
    }
    __syncthreads();
    TST(6);
}

__device__ __forceinline__ void unit_C(Frame& F, int b, int h, int qb256, bool dry) {
    const Bufs& B = F.B; int tid_ = F.tid; asm volatile("" : "+v"(tid_)); const int tid = tid_, lane = tid & 63, w = F.wave, r32 = lane & 31, hi = lane >> 5;
    const size_t row = (size_t)b * SEQ + qb256 * 256 + w * 32 + r32;
    bf16* qrow = WSP(bf16, WS_QC) + row * 1024 + h * 128;
    WState<128, 128> W; wstate_init<128, 128>(W, qrow, hi);
    const char* kv = (const char*)(WSP(const bf16, WS_MKV) + (size_t)b * MEM_LEN * 1024 + h * 128);
    __builtin_amdgcn_global_load_lds((const unsigned*)(qrow + 512 + hi * 64), (LAS unsigned*)(F.lds + L_MASK + w * 256), 4, 0, 0);
    { v4u kr[8], vr[8];
#pragma unroll
      for (int i = 0; i < 8; ++i) { const int idx = tid + 512 * i, key = idx >> 4, ch = idx & 15; kr[i] = *(const v4u*)(kv + (size_t)key * 2048 + ch * 16); vr[i] = *(const v4u*)(kv + 1024 + (size_t)key * 2048 + ch * 16); }
#pragma unroll
      for (int i = 0; i < 8; ++i) { const int idx = tid + 512 * i, key = idx >> 4, ch = idx & 15, t = key >> 6, k64 = key & 63;
          *(LAS v4u*)(F.lds + t * 16384 + k64 * 256 + ((ch ^ ksw<256>(k64)) << 4)) = kr[i];
          *(LAS v4u*)(F.lds + 65536 + t * 16384 + (ch >> 2) * 4096 + k64 * 64 + (ch & 3) * 16) = vr[i]; } }
    __syncthreads();
    { f32x16 sc[2], sn[2]; bf16x8 pf[4];
      qk_tile<128, 256>(sc, W.qf, F.lds, 0, r32, hi);
#pragma unroll 1
      for (int t = 0; t < 4; ++t) {
          step_sm<128, 128, 256, false>(W, sc, sn, pf, F.lds + ((t + 1) & 3) * 16384, 0, lane, nullptr);
          step_pv<128, 128>(W, pf, F.lds + 65536 + t * 16384, lane);
#pragma unroll
          for (int r = 0; r < 16; ++r) { sc[0][r] = sn[0][r]; sc[1][r] = sn[1][r]; }
      } }
    const float inv = 1.f / hswap_sum(W.l);
    const bf16* grow = qrow + 512;
    v4u gwc[8];
#pragma unroll
    for (int q = 0; q < 8; ++q) gwc[q] = *(const v4u*)(grow + 16 * q + 8 * hi);
#pragma unroll
    for (int dt = 0; dt < 4; ++dt)
#pragma unroll
        for (int gp = 0; gp < 2; ++gp) { const int d0 = 32 * dt + 16 * gp + 8 * hi;
            float v[8], g[8]; gather8(v, W.o[dt], gp); unpack8(g, gwc[2 * dt + gp]);
#pragma unroll
            for (int i = 0; i < 8; ++i) v[i] = v[i] * inv * g[i];
            if (!dry) *(v4u*)(qrow + d0) = pack8(v); }
    __syncthreads();
    TST(7);
}

__device__ __forceinline__ void unit_MKV(Frame& F, int b, int pn) {
    const Bufs& B = F.B;
    SchedOne S; S.pm = b; S.pn = pn; S.MEMB = (const char*)(B.ws + WS_MEMB); S.WMEM = (const char*)(B.ws + WS_WMEM);
    EpiIn E{B};
    pg8::gemm_phase<EpiIn, SchedOne, true, true>(F.lds + RING_OFF, S, E);
    asm volatile("s_waitcnt vmcnt(0)" ::: "memory");
    __syncthreads();
    if (F.tid == 0) { __builtin_amdgcn_fence(__ATOMIC_RELEASE, "agent"); asm volatile("s_waitcnt vmcnt(0)" ::: "memory"); __hip_atomic_fetch_add(F.ctl + CW_MKV + 64 * b, 1u, __ATOMIC_RELAXED, __HIP_MEMORY_SCOPE_AGENT); }
    __syncthreads();
}
__device__ __forceinline__ void wait_MKV(Frame& F, int b) {
    if (F.tid == 0) {
        unsigned sp = 0;
        while (__hip_atomic_load(F.ctl + CW_MKV + 64 * b, __ATOMIC_RELAXED, __HIP_MEMORY_SCOPE_AGENT) < 4u) { __builtin_amdgcn_s_sleep(2); if (++sp > (1u << 22)) break; }
        __builtin_amdgcn_fence(__ATOMIC_ACQUIRE, "agent"); asm volatile("s_waitcnt vmcnt(0)" ::: "memory");
    }
    __syncthreads();
}
constexpr int QUNITS = 328;
__device__ __forceinline__ void attn_phase(Frame& F, unsigned* qctr) {
    const int q0 = (int)(xb_xcc_id() & 7u);
    if (F.tid < 128) ((LAS float*)(F.lds + L_NG))[F.tid] = F.B.diff_norm_g[F.tid];
    if (F.tid == 128) ((LAS float*)(F.lds + L_NG))[128] = *(const float*)(F.B.ws + WS_LAM);
    if (TIMING && threadIdx.x == 0) F.MISC[14] = (unsigned)__builtin_amdgcn_s_memrealtime();
    for (int k = 0; k < 8; ++k) {
        const int q = (q0 + k) & 7;
        for (;;) {
            __syncthreads();
            if (F.tid == 0) F.MISC[0] = atomicAdd(qctr + 64 * q, 1u);
            __syncthreads();
            int pos = (int)F.MISC[0]; int dmode = 0;
            TST(0);
#if PROBE_DRY
            if (pos < 128) { dmode = PROBE_DMODE; pos = ((pos >> 2) << 3) + (pos & 3) + (PROBE_DRY == 1 ? 0 : 4); } else pos -= 128;
#endif
            if (pos >= QUNITS) break;
            if (pos < 8) { unit_MKV(F, q + 8 * (pos >> 2), pos & 3); continue; }
            pos -= 8;
            if (pos < 256) {
                const int b = q + 8 * (pos >> 7), p = pos & 127, L = 15 - (p >> 3), r = p & 7;
                if (r < 4) unit_A(F, b, 4 * L + 3 - r, dmode);
                else unit_B(F, b, r - 4, L, dmode);
            } else { const int c = pos - 256, b = q + 8 * (c >> 5), cc = c & 31; wait_MKV(F, b); unit_C(F, b, cc & 3, cc >> 2, false); }
        }
    }
    if (TIMING) { __syncthreads(); if (F.tid < 16) atomicAdd(F.ctl + CW_TIME + F.tid, F.MISC[16 + F.tid]); }
}
}
constexpr size_t WS_SCR = WS_XN;
struct SchedMerge {
    pg8::TileOrder T; int G, c; const char *QAB, *QC, *WAB, *WC;
    __device__ __forceinline__ bool next(int i, pg8::Unit& u) const {
        const int ti = i / 3, br = i - ti * 3, L = ti * G + c;
        if (L >= T.nwg) return false;
        T.tile(L, u.pm, u.pn); u.kind = br; u.nt = 8; u.keep = br < 2 ? 1 : 0;
        if (br == 0) { u.A = QAB + (size_t)u.pm * pg8::TSTEP; u.B = WAB + (size_t)u.pn * pg8::TSTEP; }
        else if (br == 1) { u.A = QAB + (size_t)u.pm * pg8::TSTEP + 1024; u.B = WAB + (size_t)u.pn * pg8::TSTEP + 1024; }
        else { u.A = QC + (size_t)u.pm * pg8::TSTEP; u.B = WC + (size_t)u.pn * pg8::TSTEP; }
        return true;
    }
    __device__ __forceinline__ void a_ready(const pg8::Unit&) const {}
    __device__ __forceinline__ void done(const pg8::Unit&) const {}
};
struct EpiMerge {
    static constexpr bool PERM = true, AFTER_DRAIN = false; bf16* merged; const unsigned char* ws_;
    __device__ __forceinline__ static void ld_u8(pg8::f32x4& a, pg8::f32x4& b, const unsigned char* p) {
        const uint2 gw = *(const uint2*)p; const float s = 1.f / 255.f;
        a = (pg8::f32x4){fmaxf((float)(gw.x & 255u), 1.f), fmaxf((float)((gw.x >> 8) & 255u), 1.f), fmaxf((float)((gw.x >> 16) & 255u), 1.f), fmaxf((float)(gw.x >> 24), 1.f)} * s;
        b = (pg8::f32x4){fmaxf((float)(gw.y & 255u), 1.f), fmaxf((float)((gw.y >> 8) & 255u), 1.f), fmaxf((float)((gw.y >> 16) & 255u), 1.f), fmaxf((float)(gw.y >> 24), 1.f)} * s;
    }
    __device__ __forceinline__ static void ld_bf(pg8::f32x4& a, pg8::f32x4& b, const bf16* p) {
        const v4u gw = *(const v4u*)p;
        a = (pg8::f32x4){bf2f(gw.x & 0xffffu), bf2f(gw.x >> 16), bf2f(gw.y & 0xffffu), bf2f(gw.y >> 16)}; b = (pg8::f32x4){bf2f(gw.z & 0xffffu), bf2f(gw.z >> 16), bf2f(gw.w & 0xffffu), bf2f(gw.w >> 16)};
    }
    __device__ __forceinline__ static pg8::f32x4 rcp4(pg8::f32x4 v) { return (pg8::f32x4){__builtin_amdgcn_rcpf(v[0]), __builtin_amdgcn_rcpf(v[1]), __builtin_amdgcn_rcpf(v[2]), __builtin_amdgcn_rcpf(v[3])}; }
    __device__ __forceinline__ static void cv_u8(pg8::f32x4& a, pg8::f32x4& b, uint2 gw) {
        const float s = 1.f / 255.f;
        a = (pg8::f32x4){(float)(gw.x & 255u), (float)((gw.x >> 8) & 255u), (float)((gw.x >> 16) & 255u), (float)(gw.x >> 24)} * s;
        b = (pg8::f32x4){(float)(gw.y & 255u), (float)((gw.y >> 8) & 255u), (float)((gw.y >> 16) & 255u), (float)(gw.y >> 24)} * s;
    }
    __device__ __forceinline__ static void cv_bf(pg8::f32x4& a, pg8::f32x4& b, v4u gw) {
        a = (pg8::f32x4){bf2f(gw.x & 0xffffu), bf2f(gw.x >> 16), bf2f(gw.y & 0xffffu), bf2f(gw.y >> 16)}; b = (pg8::f32x4){bf2f(gw.z & 0xffffu), bf2f(gw.z >> 16), bf2f(gw.w & 0xffffu), bf2f(gw.w >> 16)};
    }
    __device__ __forceinline__ void operator()(pg8::f32x4 (&acc)[2][2][4][2], const pg8::Unit& u, int wr, int wc, int fr, int fq) const {
        const int row0 = u.pm * 256 + wr * 64 + fr, col0 = u.pn * 256 + wc * 32 + 8 * fq;
        const size_t rt = (size_t)u.pm * 256, lo = (size_t)(wr * 64 + fr) * 1024 + col0;
        const int wv = wr * 4 + wc, ln = fq * 16 + fr;
        const size_t tA = ((size_t)(u.pm * 4 + u.pn) * 8 + wv) * 8192, tB = ((size_t)(u.pm * 4 + u.pn) * 8 + wv) * 16384;
        const __amdgpu_buffer_rsrc_t rA = __builtin_amdgcn_make_buffer_rsrc((void*)(ws_ + WS_GA + tA), 0, 8192, 0x00020000);
        const __amdgpu_buffer_rsrc_t rC = __builtin_amdgcn_make_buffer_rsrc((void*)(rt < GC_SPLIT ? ws_ + WS_GC + tA : ws_ + WS_GC2 + (tA - (size_t)GC_SPLIT * 1024)), 0, 8192, 0x00020000);
        const __amdgpu_buffer_rsrc_t rB = __builtin_amdgcn_make_buffer_rsrc((void*)(ws_ + WS_GB + tB), 0, 16384, 0x00020000);
        const int vl = ln * 16;
#define LD8P(r, p) __builtin_amdgcn_raw_buffer_load_b128(r, vl, (p) * 1024, 2)
#define LD16(ix) __builtin_amdgcn_raw_buffer_load_b128(rB, vl, (ix) * 1024, 2)
#define OFS(ix) ((((((ix) >> 3) & 1) * 128 + ((ix) & 3) * 16) * 1024) + (((ix) >> 2) & 1) * 128)
#pragma unroll
        for (int h = 0; h < 2; ++h) {
            uint2 q8[8]; v4u q16[8];
            if (u.kind == 0) {
#pragma unroll
                for (int j = 0; j < 4; ++j) { const v4u t_ = LD8P(rA, h * 4 + j); q8[2 * j] = make_uint2(t_.x, t_.y); q8[2 * j + 1] = make_uint2(t_.z, t_.w); }
#pragma unroll
                for (int j = 0; j < 8; ++j) q16[j] = LD16(h * 8 + j);
#pragma unroll
                for (int j = 0; j < 8; ++j) { const int ix = h * 8 + j; pg8::f32x4 na, nb, da, db; cv_u8(na, nb, q8[j]); cv_bf(da, db, q16[j]);
                    acc[ix >> 3][(ix >> 2) & 1][ix & 3][0] *= na * rcp4(da); acc[ix >> 3][(ix >> 2) & 1][ix & 3][1] *= nb * rcp4(db); }
            } else if (u.kind == 1) {
#pragma unroll
                for (int j = 0; j < 4; ++j) { const v4u t_ = LD8P(rC, h * 4 + j); q8[2 * j] = make_uint2(t_.x, t_.y); q8[2 * j + 1] = make_uint2(t_.z, t_.w); }
#pragma unroll
                for (int j = 0; j < 8; ++j) q16[j] = LD16(h * 8 + j);
#pragma unroll
                for (int j = 0; j < 8; ++j) { const int ix = h * 8 + j; pg8::f32x4 na, nb, da, db; cv_bf(na, nb, q16[j]); cv_u8(da, db, q8[j]);
                    acc[ix >> 3][(ix >> 2) & 1][ix & 3][0] *= na * rcp4(da); acc[ix >> 3][(ix >> 2) & 1][ix & 3][1] *= nb * rcp4(db); }
            } else {
#pragma unroll
                for (int j = 0; j < 4; ++j) { const v4u t_ = LD8P(rC, h * 4 + j); q8[2 * j] = make_uint2(t_.x, t_.y); q8[2 * j + 1] = make_uint2(t_.z, t_.w); }
#pragma unroll
                for (int j = 0; j < 8; ++j) { const int ix = h * 8 + j; pg8::f32x4 na, nb; cv_u8(na, nb, q8[j]); const int ai = ix >> 3, bj = (ix >> 2) & 1, m = ix & 3;
                    const pg8::f32x4 t0 = acc[ai][bj][m][0] * na, t1 = acc[ai][bj][m][1] * nb; float v[8] = {t0[0], t0[1], t0[2], t0[3], t1[0], t1[1], t1[2], t1[3]};
                    store8c(merged + (size_t)(row0 + ai * 128 + m * 16) * 1024 + col0 + bj * 128, v); }
            }
            asm volatile("" ::: "memory");
        }
#undef LD8P
#undef LD16
#undef OFS
    }
};
struct SchedOut {
    pg8::TileOrder T; int G, c; const char *MG, *WO;
    __device__ __forceinline__ bool next(int i, pg8::Unit& u) const {
        const int L = i * G + c; if (L >= T.nwg) return false;
        T.tile(L, u.pm, u.pn); u.A = MG + (size_t)u.pm * pg8::TSTEP; u.B = WO + (size_t)u.pn * pg8::TSTEP; u.nt = 16; u.kind = 0; u.keep = 0; return true;
    }
    __device__ __forceinline__ void a_ready(const pg8::Unit&) const {}
    __device__ __forceinline__ void done(const pg8::Unit&) const {}
};
struct EpiOutF {
    static constexpr bool PERM = true, AFTER_DRAIN = false; bf16* Y;
    __device__ __forceinline__ void operator()(const pg8::f32x4 (&acc)[2][2][4][2], const pg8::Unit& u, int wr, int wc, int fr, int fq) const {
        const int row0 = u.pm * 256 + wr * 64 + fr, col0 = u.pn * 256 + wc * 32 + 8 * fq;
#pragma unroll
        for (int ai = 0; ai < 2; ++ai)
#pragma unroll
            for (int m = 0; m < 4; ++m)
#pragma unroll
                for (int bj = 0; bj < 2; ++bj) { const pg8::f32x4 t0 = acc[ai][bj][m][0], t1 = acc[ai][bj][m][1];
                    float v[8] = {t0[0], t0[1], t0[2], t0[3], t1[0], t1[1], t1[2], t1[3]};
                    store8c(Y + (size_t)(row0 + ai * 128 + m * 16) * 1024 + col0 + bj * 128, v); }
    }
};
__device__ __forceinline__ void ln_out_rows(const Bufs& B, const bf16* Y, int gw, int NGW, int lane) {
    f32x4 gi[4], bi[4];
#pragma unroll
    for (int j = 0; j < 4; ++j) { gi[j] = *((const f32x4*)B.ln_in_g + lane + 64 * j) * ALPHA; bi[j] = *((const f32x4*)B.ln_in_b + lane + 64 * j) * ALPHA; }
    f32x4 v[4], nx[4]; uint2 yv[4], ny[4]; float2 st = {0.f, 0.f}, nst = {0.f, 0.f};
    if (gw < M) { const f32x4* xr = (const f32x4*)(B.x + (size_t)gw * D) + lane; const uint2* yr = (const uint2*)(Y + (size_t)gw * D) + lane;
#pragma unroll
        for (int j = 0; j < 4; ++j) { v[j] = __builtin_nontemporal_load(xr + 64 * j); { typedef unsigned v2u_ __attribute__((ext_vector_type(2))); const v2u_ t_ = __builtin_nontemporal_load((const v2u_*)(yr + 64 * j)); yv[j] = make_uint2(t_.x, t_.y); } }
        st = *(const float2*)(WSP(const float, WS_STATS) + (size_t)gw * 2); }
    for (int row = gw; row < M; row += NGW) {
        const int nr = row + NGW;
        if (nr < M) { const f32x4* xr = (const f32x4*)(B.x + (size_t)nr * D) + lane; const uint2* yr = (const uint2*)(Y + (size_t)nr * D) + lane;
#pragma unroll
            for (int j = 0; j < 4; ++j) { nx[j] = __builtin_nontemporal_load(xr + 64 * j); { typedef unsigned v2u_ __attribute__((ext_vector_type(2))); const v2u_ t_ = __builtin_nontemporal_load((const v2u_*)(yr + 64 * j)); ny[j] = make_uint2(t_.x, t_.y); } }
            nst = *(const float2*)(WSP(const float, WS_STATS) + (size_t)nr * 2); }
        float s = 0.f;
#pragma unroll
        for (int j = 0; j < 4; ++j) { const f32x4 yy = {bf2f(yv[j].x & 0xffffu), bf2f(yv[j].x >> 16), bf2f(yv[j].y & 0xffffu), bf2f(yv[j].y >> 16)};
            v[j] = (v[j] - st.x) * st.y * gi[j] + bi[j] + yy; s += (v[j].x + v[j].y) + (v[j].z + v[j].w); }
        const float mean = wave_sum(s) * (1.f / D); float s2 = 0.f;
#pragma unroll
        for (int j = 0; j < 4; ++j) { v[j] = v[j] - mean; s2 += (v[j].x * v[j].x + v[j].y * v[j].y) + (v[j].z * v[j].z + v[j].w * v[j].w); }
        const float rstd = rsqrtf(wave_sum(s2) * (1.f / D) + LN_EPS);
        f32x4* orow = (f32x4*)(B.out + (size_t)row * D) + lane;
#pragma unroll
        for (int j = 0; j < 4; ++j) { const f32x4 g = *((const f32x4*)B.ln_g + lane + 64 * j), b = *((const f32x4*)B.ln_b + lane + 64 * j); __builtin_nontemporal_store(v[j] * rstd * g + b, orow + 64 * j); }
#pragma unroll
        for (int j = 0; j < 4; ++j) { v[j] = nx[j]; yv[j] = ny[j]; }
        st = nst;
    }
}
__device__ __forceinline__ void ln_out_row(const Bufs& B, int row, int lane) {
    f32x4* xr = (f32x4*)(B.out + (size_t)row * D) + lane;
    f32x4 v[4]; float s = 0.f;
#pragma unroll
    for (int j = 0; j < 4; ++j) { v[j] = xr[64 * j]; s += (v[j].x + v[j].y) + (v[j].z + v[j].w); }
    const float mean = wave_sum(s) * (1.f / D); float s2 = 0.f;
#pragma unroll
    for (int j = 0; j < 4; ++j) { v[j] = v[j] - mean; s2 += (v[j].x * v[j].x + v[j].y * v[j].y) + (v[j].z * v[j].z + v[j].w * v[j].w); }
    const float rstd = rsqrtf(wave_sum(s2) * (1.f / D) + LN_EPS);
#pragma unroll
    for (int j = 0; j < 4; ++j) { const f32x4 g = *((const f32x4*)B.ln_g + lane + 64 * j), b = *((const f32x4*)B.ln_b + lane + 64 * j); xr[64 * j] = v[j] * rstd * g + b; }
}
struct Args { Bufs B; int nprog; int prog[11]; };
__global__ void __launch_bounds__(NWAVES * 64, 2) skel_fwd(Args args) {
    extern __shared__ __attribute__((aligned(16))) unsigned char lds[];
    Frame F;
    F.lds = (LAS unsigned char*)lds; F.MISC = (volatile LAS unsigned*)(F.lds + MISC_OFF);
    F.tid = threadIdx.x; F.lane = F.tid & 63; F.wave = __builtin_amdgcn_readfirstlane(F.tid >> 6);
    F.G = gridDim.x; { const int bx = blockIdx.x; F.vcu = (F.G % 8 == 0) ? (bx % 8) * (F.G / 8) + bx / 8 : bx; }
    F.B = args.B; F.ctl = (unsigned*)(args.B.ws + WS_CTL);
    const Bufs& B = F.B;
    for (int u = F.tid; u < (LDS_BYTES - LDSCTL_OFF) / 4; u += NWAVES * 64) ((LAS unsigned*)(F.lds + LDSCTL_OFF))[u] = 0u;
    __syncthreads();
    XcdBarrier bar = xcd_barrier_post(F.ctl + CW_BAR, F.MISC + 8);
    const int en = args.nprog;
#define P_PRO()  do { if (en & 1) p0_prologue(F); } while (0)
#define P_IN()   do { if (en & 2) { SchedIn S; S.T.init(M / 256, NPOS / 256); S.G = F.G; S.c = (int)blockIdx.x; \
            S.XN = (const char*)(B.ws + WS_XN); S.WIN = (const char*)(B.ws + WS_WIN); S.MEMB = (const char*)(B.ws + WS_MEMB); S.WMEM = (const char*)(B.ws + WS_WMEM); \
            EpiIn E{B}; pg8::gemm_phase<EpiIn, SchedIn, true, true>(F.lds + RING_OFF, S, E); } } while (0)
#define P_ATT(qi) do { if (en & 4) att::attn_phase(F, F.ctl + CW_QUEUE + 512 * (qi)); } while (0)
#define P_MRG()  do { if (en & 8) { SchedMerge S; S.T.init(M / 256, 4); S.G = F.G; S.c = (int)blockIdx.x; \
            S.QAB = (const char*)(B.ws + WS_QAB); S.QC = (const char*)(B.ws + WS_QC); S.WAB = (const char*)(B.ws + WS_WAB); S.WC = (const char*)(B.ws + WS_WC); \
            EpiMerge E{WSP(bf16, WS_MERGED), (const unsigned char*)B.ws}; \
            pg8::gemm_phase<EpiMerge, SchedMerge, true, true>(F.lds + RING_OFF, S, E); } } while (0)
#define P_OUT()  do { if (en & 16) { SchedOut S; S.T.init(M / 256, 4); S.G = F.G; S.c = (int)blockIdx.x; S.MG = (const char*)(B.ws + WS_MERGED); S.WO = (const char*)(B.ws + WS_WOUT); \
            EpiOutF E{WSP(bf16, WS_XN)}; pg8::gemm_phase<EpiOutF, SchedOut, true, true>(F.lds + RING_OFF, S, E); } } while (0)
#define P_LN()   do { if (en & 32) ln_out_rows(B, WSP(const bf16, WS_XN), F.vcu * NWAVES + F.wave, F.G * NWAVES, (int)(threadIdx.x & 63u)); } while (0)
#define BAR() xcd_barrier(bar)
#ifndef PROBE_REP
#define PROBE_REP 0
#endif
    P_PRO(); BAR();
#if PROBE_REP == 10
    P_PRO(); BAR();
#endif
    P_IN(); BAR();
#if PROBE_REP == 1
    P_IN(); BAR();
#endif
    P_ATT(0); BAR();
#if PROBE_REP == 12
    P_IN(); BAR(); P_ATT(1); BAR();
#endif
    P_MRG(); BAR();
#if PROBE_REP == 3
    P_MRG(); BAR();
#endif
    P_OUT(); BAR();
    P_LN();
#if PROBE_REP == 45
    BAR(); P_OUT(); BAR(); P_LN();
#endif
#if TIMING_SEL >= 0
    BAR(); if (blockIdx.x == 0 && F.tid == 0) { const unsigned v = __hip_atomic_load(F.ctl + CW_TIME + TIMING_SEL, __ATOMIC_RELAXED, __HIP_MEMORY_SCOPE_AGENT); B.out[0] = (float)v / (float)F.G / 100.f; }
#endif
}
#ifndef FAST_UPTO
#define FAST_UPTO 6
#endif
#ifndef PROG_LIST
#define PROG_LIST 0, 1, 2, 3, 4, 5
#endif
static void launch_skel(const Bufs& B, hipStream_t stream, int grid) {
    static const int prog[] = {PROG_LIST};
    Args a{}; a.B = B; a.nprog = 63; (void)prog;
    hipLaunchKernelGGL(skel_fwd, dim3(grid), dim3(NWAVES * 64), LDS_BYTES, stream, a);
}
extern "C" void kernel_launch(void* const* d_in, const int* in_sizes, int n_in, void* d_out, int out_size, void* d_ws, size_t ws_size, hipStream_t stream) {
    (void)in_sizes; (void)n_in; (void)out_size;
    static int grid = 0;
    if (grid == 0) {
        if (ws_size < WS_END) { fprintf(stderr, "workspace too small: %zu < %zu\n", ws_size, (size_t)WS_END); grid = -1; return; }
        int dev = 0, cus = 0;
        if (hipGetDevice(&dev) != hipSuccess || hipDeviceGetAttribute(&cus, hipDeviceAttributeMultiprocessorCount, dev) != hipSuccess) { grid = -1; return; }
        if (hipFuncSetAttribute((const void*)skel_fwd, hipFuncAttributeMaxDynamicSharedMemorySize, LDS_BYTES) != hipSuccess) { fprintf(stderr, "hipFuncSetAttribute failed\n"); grid = -1; return; }
        int per_cu = 0; (void)hipOccupancyMaxActiveBlocksPerMultiprocessor(&per_cu, (const void*)skel_fwd, NWAVES * 64, LDS_BYTES); (void)hipGetLastError();
        if (per_cu < 1) fprintf(stderr, "note: occupancy query reports %d blocks/CU\n", per_cu);
        grid = cus;
    }
    if (grid < 0) return;
    Bufs B{};
    B.x = (const float*)d_in[0]; B.mem = (const float*)d_in[1]; B.ln_in_g = (const float*)d_in[2]; B.ln_in_b = (const float*)d_in[3]; B.w_in = (const float*)d_in[4];
    B.w_mem_kv = (const float*)d_in[5]; B.diff_lambda = (const float*)d_in[6]; B.diff_norm_g = (const float*)d_in[7]; B.w_proj_a = (const float*)d_in[8];
    B.w_proj_b = (const float*)d_in[9]; B.w_proj_c = (const float*)d_in[10]; B.w_out = (const float*)d_in[11]; B.ln_g = (const float*)d_in[12]; B.ln_b = (const float*)d_in[13];
    B.out = (float*)d_out; B.ws = (unsigned char*)d_ws;
    unsigned char* ws = B.ws;
    (void)hipMemsetAsync(ws + WS_CTL, 0, CTL_ZERO_BYTES, stream);
    launch_skel(B, stream, grid);
}
```

```cpp
#include <hip/hip_runtime.h>
#include <hip/hip_bf16.h>
#include <cstdint>
#include <cstdio>
#include <cmath>

typedef unsigned short bf16;
typedef unsigned v4u __attribute__((ext_vector_type(4)));
typedef float f32x4 __attribute__((ext_vector_type(4)));

constexpr int D = 1024, BATCH = 16, SEQ = 2048, M = BATCH * SEQ;
constexpr int MEM_LEN = 256, MM = BATCH * MEM_LEN;
constexpr int IN_WIDTH = 7592;
constexpr int NPOS = 7680;
constexpr int O_AQ = 0, O_AK = 512, O_AV = 576, O_AG = 640, O_IQ = 1152, O_IK = 1408, O_IW = 1440, O_BQ = 1448, O_BK = 1960, O_BV = 2472,
              O_BG = 2984, O_CQ = 3496, O_CG = 4008, O_MG = 4520;
constexpr float LN_EPS = 1e-5f;
constexpr float LOG2E = 1.4426950408889634f;
constexpr float ALPHA = 1.189207115002721f;
constexpr float LAM_INIT = 0.2f;

constexpr size_t MiB = 1u << 20;
constexpr size_t WS_CTL = 0;
constexpr size_t WS_TAB = 1 * MiB;
constexpr size_t WS_TAB32 = WS_TAB + 128 * 1024;
constexpr size_t WS_LAM = WS_TAB + 256 * 1024;
constexpr size_t WS_STATS = WS_TAB + 512 * 1024;
constexpr size_t WS_TABH = WS_TAB + 768 * 1024;
constexpr size_t WS_WIN = 2 * MiB;
constexpr size_t WS_WMG = 11 * MiB;
constexpr size_t WS_WMEM = 17 * MiB;
constexpr size_t WS_WAB = 19 * MiB;
constexpr size_t WS_WC = 21 * MiB;
constexpr size_t WS_WOUT = 23 * MiB;
constexpr size_t WS_MEMB = 25 * MiB;
constexpr size_t WS_MKV = 2 * MiB;
constexpr size_t WS_XN = 41 * MiB;
constexpr size_t WS_QAB = 105 * MiB;
constexpr size_t WS_QC = 169 * MiB;
constexpr size_t WS_AG = 233 * MiB;
constexpr size_t WS_BK = 265 * MiB;
constexpr size_t WS_BV = 297 * MiB;
constexpr size_t WS_BG = 329 * MiB;
constexpr size_t WS_IQ = 361 * MiB;
constexpr size_t WS_AK = 377 * MiB;
constexpr size_t WS_AV = 381 * MiB;
constexpr size_t WS_IK = 385 * MiB;
constexpr size_t WS_IW = 387 * MiB;
constexpr size_t WS_MASK = 388 * MiB;
constexpr size_t WS_MERGED = WS_BK;
constexpr size_t WS_GTMP = WS_BG;
constexpr size_t WS_GB = 388 * MiB;
constexpr size_t WS_GA = 452 * MiB;
constexpr size_t WS_GC = 484 * MiB;
constexpr size_t WS_GC2 = 33 * MiB;
constexpr int GC_SPLIT = 28672;
constexpr size_t WS_END = 512 * MiB;

__device__ __forceinline__ unsigned f2bf(float f) { unsigned u = __float_as_uint(f); return (u + 0x7fffu + ((u >> 16) & 1u)) >> 16; }
__device__ __forceinline__ float bf2f(unsigned v) { return __uint_as_float(v << 16); }
__device__ __forceinline__ unsigned pk2(float lo, float hi) { typedef float f2_ __attribute__((ext_vector_type(2))); typedef __bf16 b2_ __attribute__((ext_vector_type(2))); f2_ v = {lo, hi}; b2_ b = __builtin_convertvector(v, b2_); return __builtin_bit_cast(unsigned, b); }
__device__ __forceinline__ float silu_f(float x) { return x * __builtin_amdgcn_rcpf(1.f + __builtin_amdgcn_exp2f(-LOG2E * x)); }
__device__ __forceinline__ float sigmoid_f(float x) { return 1.f / (1.f + __expf(-x)); }

__host__ __device__ __forceinline__ int rp64(int j) { return j < 16 ? ((j >> 1) + 8 * (j & 1)) : j; }
__host__ __device__ __forceinline__ int rp32(int j) { return j < 8 ? ((j >> 1) + 4 * (j & 1)) : j; }
__host__ __device__ __forceinline__ int orig_of_pos(int p) {
    const int tile = p >> 8;
    if (tile < 2) { return O_AQ + (p & ~63) + rp64(p & 63); }
    if (tile < 4) { return O_AG + (p - 512); }
    if (tile < 6) { const int c = p - 1024; return O_BQ + (c & ~63) + rp64(c & 63); }
    if (tile < 8) { const int c = p - 1536; return O_BK + (c & ~63) + rp64(c & 63); }
    if (tile < 10) { return O_BV + (p - 2048); }
    if (tile < 12) { return O_BG + (p - 2560); }
    if (tile < 14) { return O_CQ + (p - 3072); }
    if (tile < 16) { return O_CG + (p - 3584); }
    if (tile == 16) { const int c = p - 4096; return O_IQ + (c & ~31) + rp32(c & 31); }
    if (tile >= 18) return O_MG + (p - 4608);
    const int j = p - 4352;
    if (j < 64) return O_AK + rp64(j);
    if (j < 128) return O_AV + (j - 64);
    if (j < 160) return O_IK + rp32(j - 128);
    if (j < 168) return O_IW + (j - 160);
    return -1;
}

struct Bufs {
    const float *x, *mem, *ln_in_g, *ln_in_b, *w_in, *w_mem_kv, *diff_lambda, *diff_norm_g, *w_proj_a, *w_proj_b, *w_proj_c, *w_out, *ln_g, *ln_b;
    float* out; unsigned char* ws;
};
#define WSP(T, off) ((T*)(B.ws + (off)))

__device__ __forceinline__ void rope8_64r(float* v, f32x4 c, f32x4 s) {
#pragma unroll
    for (int j = 0; j < 4; ++j) { const float x1 = v[2 * j], x2 = v[2 * j + 1]; v[2 * j] = x1 * c[j] - x2 * s[j]; v[2 * j + 1] = x2 * c[j] + x1 * s[j]; }
}
__device__ __forceinline__ void rope8_64(float* v, const float* tab, int i0) {
    const f32x4 c = *(const f32x4*)(tab + i0), s = *(const f32x4*)(tab + 8 + i0);
#pragma unroll
    for (int j = 0; j < 4; ++j) { const float x1 = v[2 * j], x2 = v[2 * j + 1]; v[2 * j] = x1 * c[j] - x2 * s[j]; v[2 * j + 1] = x2 * c[j] + x1 * s[j]; }
}
__device__ __forceinline__ void store8c(bf16* dst, const float* v) {
    v4u o; o.x = pk2(v[0], v[1]); o.y = pk2(v[2], v[3]); o.z = pk2(v[4], v[5]); o.w = pk2(v[6], v[7]); *(v4u*)dst = o;
}
__device__ __forceinline__ void store8(bf16* dst, const float* v) {
    v4u o; o.x = pk2(v[0], v[1]); o.y = pk2(v[2], v[3]); o.z = pk2(v[4], v[5]); o.w = pk2(v[6], v[7]); __builtin_nontemporal_store(o, (v4u*)dst);
}
enum { K_AQ = 0, K_AG, K_BQ, K_BK, K_BV, K_BG, K_CQ, K_CG, K_IQ, K_MISC, K_MG };
__host__ __device__ __forceinline__ int kind_of_tile(int tile) { return tile < 16 ? (tile >> 1) : (tile == 16 ? K_IQ : (tile == 17 ? K_MISC : K_MG)); }
__device__ __forceinline__ void rope8_32(float* v, const float* tab32) {
    const f32x4 cs = *(const f32x4*)(tab32), sn = *(const f32x4*)(tab32 + 4);
#pragma unroll
    for (int j = 0; j < 4; ++j) { const float x1 = v[2 * j], x2 = v[2 * j + 1]; v[2 * j] = x1 * cs[j] - x2 * sn[j]; v[2 * j + 1] = x2 * cs[j] + x1 * sn[j]; }
}
template <int KIND> __device__ __forceinline__ void emit8k(const Bufs& B, int t, int c, float* v, f32x4 rc = (f32x4){0.f, 0.f, 0.f, 0.f}, f32x4 rs = (f32x4){0.f, 0.f, 0.f, 0.f}) {
    const int pos = t & (SEQ - 1);
    const float* tab64 = WSP(const float, WS_TAB) + pos * 16;
    const float* tab32 = WSP(const float, WS_TAB32) + pos * 8;
    const float SQ64 = 0.125f * LOG2E, SQ128 = 0.08838834764831845f * LOG2E;
    if constexpr (KIND == K_AQ || KIND == K_BQ) {
        const int w = c & 63; if (w < 16) rope8_64r(v, rc, rs);
#pragma unroll
        for (int j = 0; j < 8; ++j) v[j] *= SQ64;
        store8(WSP(bf16, WS_QAB) + (size_t)t * 1024 + (KIND == K_BQ ? 512 : 0) + c, v);
    } else if constexpr (KIND == K_AG || KIND == K_BG) {
#pragma unroll
        for (int j = 0; j < 8; ++j) v[j] = silu_f(v[j]);
        store8(WSP(bf16, KIND == K_AG ? WS_AG : WS_BG) + (size_t)t * 512 + c, v);
    } else if constexpr (KIND == K_BK) {
        const int w = c & 63; if (w < 16) rope8_64r(v, rc, rs);
        store8c(WSP(bf16, WS_BK) + (size_t)t * 512 + c, v);
    } else if constexpr (KIND == K_BV) {
        store8c(WSP(bf16, WS_BV) + (size_t)t * 512 + c, v);
    } else if constexpr (KIND == K_CQ) {
#pragma unroll
        for (int j = 0; j < 8; ++j) v[j] *= SQ128;
        store8(WSP(bf16, WS_QC) + (size_t)t * 1024 + c, v);
    } else if constexpr (KIND == K_CG) {
#pragma unroll
        for (int j = 0; j < 8; ++j) v[j] = silu_f(v[j]);
        store8(WSP(bf16, WS_QC) + (size_t)t * 1024 + 512 + c, v);
    } else if constexpr (KIND == K_IQ) {
        if ((c & 31) < 8) rope8_32(v, tab32);
        store8(WSP(bf16, WS_IQ) + (size_t)t * 256 + c, v);
    } else if constexpr (KIND == K_MG) {
        const int br = c >> 10, col = c & 1023, pm_ = t >> 8, r_ = t & 255, cc_ = col & 255;
        const int ix_ = (r_ >> 7) * 8 + (cc_ >> 7) * 4 + ((r_ >> 4) & 3), wv_ = ((r_ >> 6) & 1) * 4 + ((cc_ >> 5) & 3), ln_ = ((cc_ >> 3) & 3) * 16 + (r_ & 15);
        const size_t tl_ = (size_t)(pm_ * 4 + (col >> 8)) * 8 + wv_;
        if (br == 1) {
#pragma unroll
            for (int j = 0; j < 8; ++j) v[j] = __builtin_amdgcn_rcpf(1.f + __builtin_amdgcn_exp2f(-LOG2E * v[j]));
            store8(WSP(bf16, WS_GB) + (tl_ * 16384 + (size_t)(ix_ * 64 + ln_) * 16) / 2, v);
        } else {
            unsigned w0 = 0u, w1 = 0u;
#pragma unroll
            for (int j = 0; j < 8; ++j) { const float g = fmaxf(__builtin_amdgcn_rcpf(fmaf(__builtin_amdgcn_exp2f(-LOG2E * v[j]), 1.f / 255.f, 1.f / 255.f)), 1.f);
                if (j < 4) w0 = __builtin_amdgcn_cvt_pk_u8_f32(g, j, w0); else w1 = __builtin_amdgcn_cvt_pk_u8_f32(g, j - 4, w1); }
            const unsigned long long w = (unsigned long long)w0 | ((unsigned long long)w1 << 32);
            const size_t o_ = tl_ * 8192 + (size_t)((ix_ >> 1) * 64 + ln_) * 16 + (ix_ & 1) * 8;
            unsigned char* gp = br == 0 ? WSP(unsigned char, WS_GA) + o_ : (t < GC_SPLIT ? WSP(unsigned char, WS_GC) + o_ : WSP(unsigned char, WS_GC2) + (o_ - (size_t)GC_SPLIT * 1024));
            __builtin_nontemporal_store(w, (unsigned long long*)gp); }
    } else {
        if (c < 64) { if (c < 16) rope8_64(v, tab64, c >> 1); store8c(WSP(bf16, WS_AK) + (size_t)t * 64 + c, v); }
        else if (c < 128) { store8c(WSP(bf16, WS_AV) + (size_t)t * 64 + (c - 64), v); }
        else if (c < 160) { const int w = c - 128; if (w < 8) rope8_32(v, tab32); store8c(WSP(bf16, WS_IK) + (size_t)t * 32 + w, v); }
        else if (c == 160) { float* o = WSP(float, WS_IW) + (size_t)t * 8; *(f32x4*)o = (f32x4){v[0] * 0.0625f, v[1] * 0.0625f, v[2] * 0.0625f, v[3] * 0.0625f}; *(f32x4*)(o + 4) = (f32x4){v[4] * 0.0625f, v[5] * 0.0625f, v[6] * 0.0625f, v[7] * 0.0625f}; }
    }
}
__device__ __forceinline__ void inproj_emit8(const Bufs& B, int t, int p0, float* v) {
    const int tile = p0 >> 8, c = (tile < 16) ? (p0 & 511) : (tile < 18 ? (p0 & 255) : p0 - 4608);
    switch (kind_of_tile(tile)) {
    case K_AQ: emit8k<K_AQ>(B, t, c, v); break;  case K_AG: emit8k<K_AG>(B, t, c, v); break;
    case K_BQ: emit8k<K_BQ>(B, t, c, v); break;  case K_BK: emit8k<K_BK>(B, t, c, v); break;
    case K_BV: emit8k<K_BV>(B, t, c, v); break;  case K_BG: emit8k<K_BG>(B, t, c, v); break;
    case K_CQ: emit8k<K_CQ>(B, t, c, v); break;  case K_CG: emit8k<K_CG>(B, t, c, v); break;
    case K_IQ: emit8k<K_IQ>(B, t, c, v); break;  case K_MG: emit8k<K_MG>(B, t, c, v); break;  default:   emit8k<K_MISC>(B, t, c, v); break;
    }
}
__device__ __forceinline__ float wsrc(const Bufs& B, int kind, int k, int n) {
    switch (kind) {
    case 0: { const int o = orig_of_pos(n); return o < 0 ? 0.f : __builtin_nontemporal_load(B.w_in + (size_t)k * IN_WIDTH + o); }
    case 1: return __builtin_nontemporal_load(B.w_in + (size_t)k * IN_WIDTH + O_MG + n);
    case 2: return __builtin_nontemporal_load(B.w_mem_kv + (size_t)k * 1024 + n);
    case 3: return k < 512 ? __builtin_nontemporal_load(B.w_proj_a + (size_t)k * 1024 + n) : __builtin_nontemporal_load(B.w_proj_b + (size_t)(k - 512) * 1024 + n);
    case 4: return k < 512 ? __builtin_nontemporal_load(B.w_proj_c + (size_t)k * 1024 + n) : 0.f;
    default: return __builtin_nontemporal_load(B.w_out + (size_t)k * 1024 + n);
    }
}

namespace pg8 {
#define PG8_LAS __attribute__((address_space(3)))
typedef unsigned short bf16_t;
typedef short bf16x8 __attribute__((ext_vector_type(8)));
typedef float f32x4 __attribute__((ext_vector_type(4)));
typedef unsigned u32x4 __attribute__((ext_vector_type(4)));
constexpr int BM = 256, BK = 64, HALF = 128, HTB = HALF * BK * 2, STAGE_BYTES = 8 * HTB, NXCD = 8, WGM = 8, KP = 1024;
constexpr size_t TSTEP = (size_t)BM * KP * 2;

__host__ __device__ __forceinline__ int lds_byte(int r, int c) { const int st = (r >> 4) * 2 + (c >> 5), rr = r & 15, cc = c & 31, ob = rr * 64 + cc * 2; return st * 1024 + (ob ^ (((ob >> 9) & 1) << 5)); }
__host__ __device__ __forceinline__ void stage_rc(int b, int& R, int& C) { const int st = b / 1024, sb = b % 1024, swz = sb ^ (((sb >> 9) & 1) << 5); R = (st >> 1) * 16 + swz / 64; C = (st & 1) * 32 + (swz % 64) / 2; }
__host__ __device__ __forceinline__ int perm32(int rho) { const int n = rho >> 4, i = rho & 15; return 8 * (i >> 2) + 4 * n + (i & 3); }

struct Unit { int pm, pn; const char* A; const char* B; int nt; int kind; int keep; int pad; };

struct TileOrder {
    int nM, nN, nwg;
    __host__ __device__ void init(int nM_, int nN_) { nM = nM_; nN = nN_; nwg = nM * nN; }
    __host__ __device__ void tile(int L, int& pm, int& pn) const {
        int wgid = L; { const int q = nwg / NXCD, r = nwg % NXCD, xcd = wgid % NXCD, off = wgid / NXCD; wgid = (xcd < r ? xcd * (q + 1) : r * (q + 1) + (xcd - r) * q) + off; }
        const int nig = WGM * nN, gid = wgid / nig, fm = gid * WGM, gsz = (nM - fm) < WGM ? (nM - fm) : WGM;
        pm = fm + ((wgid % nig) % gsz); pn = (wgid % nig) / gsz;
    }
};
__device__ __forceinline__ unsigned cvt_pk_bf16(float lo, float hi) { unsigned r; asm volatile("v_cvt_pk_bf16_f32 %0, %1, %2" : "=v"(r) : "v"(lo), "v"(hi)); return r; }

template <class Epi, class Sched, bool ALIGN_EPI = false, bool SP2 = false>
__device__ __forceinline__ void gemm_phase(PG8_LAS unsigned char* lds, const Sched& S, const Epi& E) {
    int tid_ = threadIdx.x; asm volatile("" : "+v"(tid_));
    const int tid = tid_, wid = __builtin_amdgcn_readfirstlane(tid >> 6), lane = tid & 63, wr = wid >> 2, wc = wid & 3, fr = lane & 15, fq = lane >> 4;
    constexpr int K = KP; int nt;
    unsigned voffA[2], voffB[2];
#pragma unroll
    for (int i = 0; i < 2; ++i) { int R, C; stage_rc(tid * 16 + i * 8192, R, C); const int Rb = Epi::PERM ? ((R & ~31) + perm32(R & 31)) : R;
        voffA[i] = (unsigned)(R * K + C) * 2u; voffB[i] = (unsigned)(Rb * K + C) * 2u; }
    const size_t kstep = (size_t)(BK * 2);
    const size_t hstep = (size_t)HALF * K * 2;
    const size_t tstep = 2 * hstep;
    const unsigned ldsw = (unsigned)wid * 1024u;
    const int aoff = lds_byte(wr * 64 + fr, fq * 8), boff = lds_byte(wc * 32 + fr, fq * 8);
#define PG8_SA(b, h) (((b) * 2 + (h)) * HTB)
#define PG8_SB(b, h) ((4 + (b) * 2 + (h)) * HTB)
#define PG8_STAGE(bufoff, gbase, voff) do { _Pragma("unroll") for (int _i = 0; _i < 2; ++_i) \
        __builtin_amdgcn_global_load_lds((const unsigned*)((const char*)(gbase) + (voff)[_i]), (PG8_LAS unsigned*)(lds + (bufoff) + ldsw + _i * 8192), 16, 0, 0); } while (0)
#define PG8_LDA(dst, b, h) do { _Pragma("unroll") for (int m = 0; m < 4; ++m) _Pragma("unroll") for (int k = 0; k < 2; ++k) dst[m][k] = *(const PG8_LAS bf16x8*)(lds + PG8_SA(b, h) + aoff + m * 2048 + k * 1024); } while (0)
#define PG8_LDB(dst, b, h) do { _Pragma("unroll") for (int n = 0; n < 2; ++n) _Pragma("unroll") for (int k = 0; k < 2; ++k) dst[n][k] = *(const PG8_LAS bf16x8*)(lds + PG8_SB(b, h) + boff + n * 2048 + k * 1024); } while (0)
#define PG8_MMA(ai, bj, At, Bt) do { __builtin_amdgcn_s_setprio(1); _Pragma("unroll") for (int m = 0; m < 4; ++m) _Pragma("unroll") for (int n = 0; n < 2; ++n) _Pragma("unroll") for (int k = 0; k < 2; ++k) \
        acc[ai][bj][m][n] = __builtin_amdgcn_mfma_f32_16x16x32_bf16(Bt[n][k], At[m][k], acc[ai][bj][m][n], 0, 0, 0); __builtin_amdgcn_s_setprio(0); } while (0)
#define PG8_WAIT_V(n) asm volatile("s_waitcnt vmcnt(" #n ")" ::: "memory")
#define PG8_WAIT_L(n) asm volatile("s_waitcnt lgkmcnt(" #n ")" ::: "memory")
#define PG8_BAR __builtin_amdgcn_s_barrier()
#define PG8_SCHED __builtin_amdgcn_sched_barrier(0)
    Unit cur, nxt; int ui = 0;
    if (!S.next(0, cur)) return;
    f32x4 acc[2][2][4][2];
#pragma unroll
    for (int a = 0; a < 2; ++a)
#pragma unroll
        for (int b = 0; b < 2; ++b)
#pragma unroll
            for (int m = 0; m < 4; ++m)
#pragma unroll
                for (int n = 0; n < 2; ++n) acc[a][b][m][n] = (f32x4){0.f, 0.f, 0.f, 0.f};
    bf16x8 At[4][2], B0[2][2], B1[2][2];
    const char* cA = cur.A; const char* cB = cur.B; nt = cur.nt;
    S.a_ready(cur);
    if constexpr (SP2) {
        PG8_STAGE(PG8_SB(0, 0), cB, voffB); PG8_STAGE(PG8_SB(0, 1), cB + hstep, voffB); PG8_STAGE(PG8_SA(0, 0), cA, voffA); PG8_STAGE(PG8_SA(0, 1), cA + hstep, voffA);
        if (wr == 1) PG8_BAR;
        PG8_WAIT_V(2); PG8_BAR;
        PG8_STAGE(PG8_SB(1, 0), cB + kstep, voffB); PG8_STAGE(PG8_SA(1, 0), cA + kstep, voffA); PG8_STAGE(PG8_SB(1, 1), cB + hstep + kstep, voffB);
        PG8_WAIT_V(6); PG8_BAR;
    } else {
        PG8_STAGE(PG8_SB(0, 0), cB, voffB); PG8_STAGE(PG8_SA(0, 0), cA, voffA); PG8_STAGE(PG8_SB(0, 1), cB + hstep, voffB); PG8_STAGE(PG8_SA(0, 1), cA + hstep, voffA);
        if (wr == 1) PG8_BAR;
        PG8_WAIT_V(4); PG8_BAR;
        PG8_STAGE(PG8_SB(1, 0), cB + kstep, voffB); PG8_STAGE(PG8_SA(1, 0), cA + kstep, voffA); PG8_STAGE(PG8_SB(1, 1), cB + hstep + kstep, voffB);
        PG8_WAIT_V(6); PG8_BAR;
    }
    for (;;) {
        const bool has_next = S.next(ui + 1, nxt);
        const char* nA = has_next ? nxt.A : cA; const char* nB = has_next ? nxt.B : cB;
        for (int t = 0; t < nt; t += 2) {
            const bool last = (t == nt - 2);
            const char* a1 = cA + (size_t)(t + 1) * kstep;
            const char* a2 = last ? nA : cA + (size_t)(t + 2) * kstep; const char* b2 = last ? nB : cB + (size_t)(t + 2) * kstep;
            const char* a3 = a2 + kstep; const char* b3 = b2 + kstep;
            if (last && has_next) S.a_ready(nxt);
            if (last) E.pre(cur, tid);
            if constexpr (SP2) {
            PG8_LDB(B0, 0, 0); PG8_LDB(B1, 0, 1); PG8_SCHED; PG8_LDA(At, 0, 0); PG8_STAGE(PG8_SA(1, 1), a1 + hstep, voffA);
            PG8_WAIT_V(8); PG8_WAIT_L(0); PG8_BAR; PG8_MMA(0, 0, At, B0); PG8_MMA(0, 1, At, B1); PG8_BAR; PG8_SCHED;
            PG8_LDA(At, 0, 1); PG8_STAGE(PG8_SB(0, 0), b2, voffB); PG8_STAGE(PG8_SB(0, 1), b2 + hstep, voffB); PG8_STAGE(PG8_SA(0, 0), a2, voffA);
            PG8_WAIT_V(8); PG8_WAIT_L(0); PG8_BAR; PG8_MMA(1, 0, At, B0); PG8_MMA(1, 1, At, B1); PG8_BAR; PG8_SCHED;
            PG8_LDB(B0, 1, 0); PG8_LDB(B1, 1, 1); PG8_SCHED; PG8_LDA(At, 1, 0); PG8_STAGE(PG8_SA(0, 1), a2 + hstep, voffA);
            PG8_WAIT_V(8); PG8_WAIT_L(0); PG8_BAR; PG8_MMA(0, 0, At, B0); PG8_MMA(0, 1, At, B1); PG8_BAR; PG8_SCHED;
            PG8_LDA(At, 1, 1); PG8_STAGE(PG8_SB(1, 0), b3, voffB); PG8_STAGE(PG8_SB(1, 1), b3 + hstep, voffB); PG8_STAGE(PG8_SA(1, 0), a3, voffA);
            PG8_WAIT_V(8); PG8_WAIT_L(0); PG8_BAR; PG8_MMA(1, 0, At, B0); PG8_MMA(1, 1, At, B1); PG8_BAR; PG8_SCHED;
            } else {
            PG8_LDB(B0, 0, 0); PG8_SCHED; PG8_LDA(At, 0, 0); PG8_STAGE(PG8_SA(1, 1), a1 + hstep, voffA);
            PG8_WAIT_L(8); PG8_BAR; PG8_WAIT_L(0); PG8_MMA(0, 0, At, B0); PG8_BAR; PG8_SCHED;
            PG8_LDB(B1, 0, 1); PG8_STAGE(PG8_SB(0, 0), b2, voffB);
            PG8_BAR; PG8_WAIT_L(0); PG8_MMA(0, 1, At, B1); PG8_BAR;
            PG8_LDA(At, 0, 1); PG8_STAGE(PG8_SA(0, 0), a2, voffA);
            PG8_BAR; PG8_WAIT_L(0); PG8_MMA(1, 0, At, B0); PG8_BAR; PG8_SCHED;
            PG8_STAGE(PG8_SB(0, 1), b2 + hstep, voffB);
            PG8_WAIT_V(6); PG8_BAR; PG8_MMA(1, 1, At, B1); PG8_BAR;
            PG8_LDB(B0, 1, 0); PG8_SCHED; PG8_LDA(At, 1, 0); PG8_STAGE(PG8_SA(0, 1), a2 + hstep, voffA);
            PG8_WAIT_L(8); PG8_BAR; PG8_WAIT_L(0); PG8_MMA(0, 0, At, B0); PG8_BAR; PG8_SCHED;
            PG8_LDB(B1, 1, 1); PG8_STAGE(PG8_SB(1, 0), b3, voffB);
            PG8_BAR; PG8_WAIT_L(0); PG8_MMA(0, 1, At, B1); PG8_BAR;
            PG8_LDA(At, 1, 1); PG8_STAGE(PG8_SA(1, 0), a3, voffA);
            PG8_BAR; PG8_WAIT_L(0); PG8_MMA(1, 0, At, B0); PG8_BAR; PG8_SCHED;
            PG8_STAGE(PG8_SB(1, 1), b3 + hstep, voffB);
            PG8_WAIT_V(6); PG8_BAR; PG8_MMA(1, 1, At, B1); PG8_BAR;
            }
        }
        if constexpr (ALIGN_EPI) { if (wr == 0) PG8_BAR; }
        if constexpr (!Epi::AFTER_DRAIN) { E(acc, cur, wr, wc, fr, fq); S.done(cur); }
        if (!has_next) break;
        if (!cur.keep) {
#pragma unroll
        for (int a = 0; a < 2; ++a)
#pragma unroll
            for (int b = 0; b < 2; ++b)
#pragma unroll
                for (int m = 0; m < 4; ++m)
#pragma unroll
                    for (int n = 0; n < 2; ++n) acc[a][b][m][n] = (f32x4){0.f, 0.f, 0.f, 0.f};
        }
        cur = nxt; cA = nA; cB = nB; nt = cur.nt; ++ui;
        if constexpr (ALIGN_EPI) { if (wr == 1) PG8_BAR; }
    }
    PG8_WAIT_V(0);
    if constexpr (!ALIGN_EPI) { if (wr == 0) PG8_BAR; }
    PG8_BAR;
    if constexpr (Epi::AFTER_DRAIN) { E.fused(acc, cur, wr, wc, fr, fq, lds, wid, lane); S.done(cur); }
#undef PG8_SA
#undef PG8_SB
#undef PG8_STAGE
#undef PG8_LDA
#undef PG8_LDB
#undef PG8_MMA
#undef PG8_WAIT_V
#undef PG8_WAIT_L
#undef PG8_BAR
#undef PG8_SCHED
}
}

#define GAS __attribute__((address_space(1)))
#define LAS __attribute__((address_space(3)))
typedef GAS unsigned gu32;
#define RLX_AGENT __ATOMIC_RELAXED, __HIP_MEMORY_SCOPE_AGENT
#define LDS_WAIT() asm volatile("s_waitcnt lgkmcnt(0)" ::: "memory")
#define VM_WAIT() asm volatile("s_waitcnt vmcnt(0)" ::: "memory")
#define XB_TMO      128
#define XB_XCNT(j)  (256  + 64 * (j))
#define XB_XSUB(j)  (1280 + 64 * (j))
#define XB_XGEN(j)  (2304 + 64 * (j))
#define XB_TOP      3328
#define XB_TOPGEN   3392
#define XCD_BAR_WORDS 3456
#define XB_SPIN_CAP (1u << 20)
__device__ __forceinline__ unsigned xb_ld(unsigned* p)              { return __hip_atomic_load(p, __ATOMIC_RELAXED, __HIP_MEMORY_SCOPE_AGENT); }
__device__ __forceinline__ unsigned xb_add(unsigned* p, unsigned v) { return __hip_atomic_fetch_add(p, v, __ATOMIC_RELAXED, __HIP_MEMORY_SCOPE_AGENT); }
__device__ __forceinline__ unsigned xb_xcc_id() { return (unsigned)__builtin_amdgcn_s_getreg((3 << 11) | 20) & 0xFu; }
#define XB_SPIN(cond, bar) do { unsigned _sp = 0; while (cond) { __builtin_amdgcn_s_sleep(1); \
    if ((++_sp & 255u) == 0u) { if (xb_ld(&(bar)[XB_TMO])) break; if (_sp > XB_SPIN_CAP) { atomicAdd(&(bar)[XB_TMO], 1u); break; } } } } while (0)
struct XcdBarrier { unsigned* bar; unsigned x; volatile LAS unsigned* st; };
__device__ __forceinline__ XcdBarrier xcd_barrier_post(unsigned* bar, volatile LAS unsigned* st) {
    XcdBarrier b; b.bar = bar; b.x = xb_xcc_id(); b.st = st;
    if (threadIdx.x == 0) (void)xb_add(&bar[XB_XCNT(b.x)], 1u);
    return b;
}
__device__ __forceinline__ void xcd_barrier_complete(unsigned* bar, unsigned x, unsigned& nloc, unsigned& nx) {
    const unsigned G = gridDim.x * gridDim.y * gridDim.z;
    unsigned sum, cnt, mine, sp = 0u;
    for (;;) {
        sum = 0u; cnt = 0u; mine = 0u;
#pragma unroll
        for (unsigned j = 0; j < 16; ++j) { const unsigned c = xb_ld(&bar[XB_XCNT(j)]); sum += c; cnt += (c > 0u) ? 1u : 0u; mine = (j == x) ? c : mine; }
        if (sum == G) break;
        __builtin_amdgcn_s_sleep(1);
        if ((++sp & 255u) == 0u) { if (xb_ld(&bar[XB_TMO])) break; if (sp > XB_SPIN_CAP) { atomicAdd(&bar[XB_TMO], 1u); break; } }
    }
    nloc = mine > 0u ? mine : 1u; nx = cnt > 0u ? cnt : 1u;
}
__device__ __forceinline__ void xcd_barrier(const XcdBarrier& b) {
    asm volatile("s_waitcnt vmcnt(0)" ::: "memory");
    __syncthreads();
    if (threadIdx.x == 0) {
        unsigned* bar = b.bar;
        __builtin_amdgcn_s_waitcnt(0);
        unsigned nloc = b.st[0], nx = b.st[1];
        if (nloc == 0u) { xcd_barrier_complete(bar, b.x, nloc, nx); b.st[0] = nloc; b.st[1] = nx; }
        const unsigned old = xb_add(&bar[XB_XSUB(b.x)], 1u);
        const unsigned gen = old / nloc;
        if (old + 1u == (gen + 1u) * nloc) {
            __builtin_amdgcn_fence(__ATOMIC_RELEASE, "agent");
            asm volatile("s_waitcnt vmcnt(0)" ::: "memory");
            const unsigned og = xb_add(&bar[XB_TOP], 1u);
            const unsigned tg = og / nx;
            if (og + 1u == (tg + 1u) * nx) xb_add(&bar[XB_TOPGEN], 1u);
            else XB_SPIN(xb_ld(&bar[XB_TOPGEN]) == tg, bar);
            __builtin_amdgcn_fence(__ATOMIC_ACQUIRE, "agent");
            xb_add(&bar[XB_XGEN(b.x)], 1u);
            asm volatile("s_waitcnt vmcnt(0)" ::: "memory");
        } else {
            XB_SPIN(xb_ld(&bar[XB_XGEN(b.x)]) == gen, bar);
            __builtin_amdgcn_fence(__ATOMIC_ACQUIRE, "agent");
            asm volatile("s_waitcnt vmcnt(0)" ::: "memory");
        }
    }
    __syncthreads();
}

constexpr int NWAVES = 8;
constexpr int RING_OFF = 0, RING_BYTES = 131072;
constexpr int LDSCTL_OFF = RING_BYTES, MISC_OFF = LDSCTL_OFF + 320;
constexpr int LDS_BYTES = 147456;
constexpr int CW_TMO = 0, CW_CODE = 1, CW_BAR = 4096, CW_QUEUE = 8192, CW_MKV = 10240, CW_TIME = 12288, CW_SEAM = 16384;
constexpr size_t CTL_ZERO_BYTES = 64 * 1024;

struct Frame {
    LAS unsigned char* lds; volatile LAS unsigned* MISC; unsigned* ctl;
    int tid, lane, wave, vcu, G;
    unsigned long long tprev;
    Bufs B;
};

__device__ __forceinline__ void p0_transpose_item(const Bufs& B, int kind, int N, size_t dst_off, LAS float* scr, int item, int lane) {
    const int nblk = N / 32, kb = item / nblk, nb = item % nblk, k0 = 64 * kb, n0 = 32 * nb;
#pragma unroll
    for (int h = 0; h < 2; ++h) { float tv[16];
#pragma unroll
        for (int i = 0; i < 16; ++i) tv[i] = wsrc(B, kind, k0 + 2 * (16 * h + i) + (lane >> 5), n0 + (lane & 31));
#pragma unroll
        for (int i = 0; i < 16; ++i) scr[(2 * (16 * h + i) + (lane >> 5)) * 33 + (lane & 31)] = tv[i]; }
    LDS_WAIT(); asm volatile("" ::: "memory");
    const int c = lane & 7; bf16* WT = WSP(bf16, dst_off);
#pragma unroll
    for (int j = 0; j < 4; ++j) { const int n = (lane >> 3) + 8 * j; const LAS float* s = scr + (8 * c) * 33 + n;
        v4u o; o.x = pk2(s[0 * 33], s[1 * 33]); o.y = pk2(s[2 * 33], s[3 * 33]); o.z = pk2(s[4 * 33], s[5 * 33]); o.w = pk2(s[6 * 33], s[7 * 33]);
        *(v4u*)(WT + (size_t)(n0 + n) * 1024 + k0 + 8 * c) = o; }
    LDS_WAIT(); asm volatile("" ::: "memory");
}
__device__ __forceinline__ float wave_sum(float v) {
#pragma unroll
    for (int o = 1; o < 64; o <<= 1) v += __shfl_xor(v, o);
    return v;
}
__device__ __forceinline__ void ln_in_rows(const Bufs& B, int gw, int NGW, int lane) {
    f32x4 v[4], nx[4];
    if (gw < M) { const f32x4* xr = (const f32x4*)(B.x + (size_t)gw * D) + lane;
#pragma unroll
        for (int j = 0; j < 4; ++j) v[j] = __builtin_nontemporal_load(xr + 64 * j); }
    f32x4 g[4], b[4];
#pragma unroll
    for (int j = 0; j < 4; ++j) { g[j] = *((const f32x4*)B.ln_in_g + lane + 64 * j); b[j] = *((const f32x4*)B.ln_in_b + lane + 64 * j); }
    for (int row = gw; row < M; row += NGW) {
        const int nr = row + NGW;
        if (nr < M) { const f32x4* xr = (const f32x4*)(B.x + (size_t)nr * D) + lane;
#pragma unroll
            for (int j = 0; j < 4; ++j) nx[j] = __builtin_nontemporal_load(xr + 64 * j); }
        float s = 0.f;
#pragma unroll
        for (int j = 0; j < 4; ++j) s += (v[j].x + v[j].y) + (v[j].z + v[j].w);
        const float mean = wave_sum(s) * (1.f / D); float s2 = 0.f;
#pragma unroll
        for (int j = 0; j < 4; ++j) { v[j] = v[j] - mean; s2 += (v[j].x * v[j].x + v[j].y * v[j].y) + (v[j].z * v[j].z + v[j].w * v[j].w); }
        const float rstd = rsqrtf(wave_sum(s2) * (1.f / D) + LN_EPS);
        if (lane == 0) { float* st = WSP(float, WS_STATS) + (size_t)row * 2; st[0] = mean; st[1] = rstd; }
        unsigned long long* o8 = (unsigned long long*)(WSP(bf16, WS_XN) + (size_t)row * D) + lane;
#pragma unroll
        for (int j = 0; j < 4; ++j) { const f32x4 y = v[j] * rstd * g[j] + b[j];
            o8[64 * j] = (unsigned long long)pk2(y.x, y.y) | ((unsigned long long)pk2(y.z, y.w) << 32); }
#pragma unroll
        for (int j = 0; j < 4; ++j) v[j] = nx[j];
    }
}
__device__ __forceinline__ void p0_prologue(Frame& F) {
    const Bufs& B = F.B;
    LAS float* scr = (LAS float*)(F.lds + RING_OFF + F.wave * 16384);
    const int gw = F.vcu * NWAVES + F.wave, NGW = F.G * NWAVES;
    constexpr int I0 = 16 * (NPOS / 32), I2 = 16 * 32;
    constexpr int NITEMS = I0 + 4 * I2;
    for (int it = gw; it < NITEMS; it += NGW) {
        int r = it;
        if (r < I0) { p0_transpose_item(B, 0, NPOS, WS_WIN, scr, r, (int)(threadIdx.x & 63u)); continue; } r -= I0;
        if (r < I2) { p0_transpose_item(B, 2, 1024, WS_WMEM, scr, r, (int)(threadIdx.x & 63u)); continue; } r -= I2;
        if (r < I2) { p0_transpose_item(B, 3, 1024, WS_WAB, scr, r, (int)(threadIdx.x & 63u)); continue; } r -= I2;
        if (r < I2) { p0_transpose_item(B, 4, 1024, WS_WC, scr, r, (int)(threadIdx.x & 63u)); continue; } r -= I2;
        p0_transpose_item(B, 5, 1024, WS_WOUT, scr, r, (int)(threadIdx.x & 63u));
    }
    ln_in_rows(B, gw, NGW, (int)(threadIdx.x & 63u));
    const int gid = gw * 64 + (int)(threadIdx.x & 63u), nth = NGW * 64;
    for (int i = gid; i < MM * D / 4; i += nth) { const f32x4 v = __builtin_nontemporal_load((const f32x4*)B.mem + i); ((unsigned long long*)WSP(bf16, WS_MEMB))[i] = (unsigned long long)pk2(v.x, v.y) | ((unsigned long long)pk2(v.z, v.w) << 32); }
    for (int i = gid; i < SEQ * 8; i += nth) { const int pos = i >> 3, f = i & 7;
        const float inv = powf(500000.0f, -(float)f * 0.125f); const float ang = (float)pos * inv;
        float* t64 = WSP(float, WS_TAB) + pos * 16; t64[f] = cosf(ang); t64[8 + f] = sinf(ang);
        { _Float16* th = WSP(_Float16, WS_TABH) + pos * 16; th[f] = (_Float16)cosf(ang); th[8 + f] = (_Float16)sinf(ang); }
        if ((f & 1) == 0) { float* t32 = WSP(float, WS_TAB32) + pos * 8; t32[f >> 1] = cosf(ang); t32[4 + (f >> 1)] = sinf(ang); } }
    if (gid == 0) { float a = 0.f, b = 0.f; for (int i = 0; i < 64; ++i) { a += B.diff_lambda[i] * B.diff_lambda[64 + i]; b += B.diff_lambda[128 + i] * B.diff_lambda[192 + i]; }
        *WSP(float, WS_LAM) = expf(a) - expf(b) + LAM_INIT; }
}

struct SchedOne {
    int pm, pn; const char* MEMB; const char* WMEM;
    __device__ __forceinline__ bool next(int i, pg8::Unit& u) const {
        if (i > 0) return false;
        u.pm = pm; u.pn = pn; u.A = MEMB + (size_t)pm * pg8::TSTEP; u.B = WMEM + (size_t)pn * pg8::TSTEP; u.nt = 16; u.kind = 1; u.keep = 0; return true;
    }
    __device__ __forceinline__ void a_ready(const pg8::Unit&) const {}
    __device__ __forceinline__ void done(const pg8::Unit&) const {}
};
struct SchedIn {
    pg8::TileOrder T; int G, c; const char* XN; const char* WIN; const char* MEMB; const char* WMEM;
    __device__ __forceinline__ bool next(int i, pg8::Unit& u) const {
        const int L = i * G + c;
        if (L < T.nwg) { T.tile(L, u.pm, u.pn); u.A = XN + (size_t)u.pm * pg8::TSTEP; u.B = WIN + (size_t)u.pn * pg8::TSTEP; u.nt = 16; u.kind = 0; u.keep = 0; return true; }
        return false;
    }
    __device__ __forceinline__ void a_ready(const pg8::Unit&) const {}
    __device__ __forceinline__ void done(const pg8::Unit&) const {}
};
template <int KIND> __device__ __forceinline__ void epi_in_loops(const Bufs& B, const pg8::f32x4 (&acc)[2][2][4][2], int row0, int c0, const LAS unsigned char* tl = nullptr) {
    constexpr bool ROPE = (KIND == K_AQ || KIND == K_BQ || KIND == K_BK);
    typedef _Float16 f16x4_ __attribute__((ext_vector_type(4)));
#pragma unroll
    for (int ai = 0; ai < 2; ++ai)
#pragma unroll
        for (int m = 0; m < 4; ++m)
#pragma unroll
            for (int bj = 0; bj < 2; ++bj) {
                float v[8] = {acc[ai][bj][m][0][0], acc[ai][bj][m][0][1], acc[ai][bj][m][0][2], acc[ai][bj][m][0][3], acc[ai][bj][m][1][0], acc[ai][bj][m][1][1], acc[ai][bj][m][1][2], acc[ai][bj][m][1][3]};
                const int row = row0 + ai * 128 + m * 16, c = c0 + bj * 128;
                if constexpr (KIND == 100) store8(WSP(bf16, WS_MKV) + (size_t)row * 1024 + c, v);
                else if constexpr (ROPE) {
                    const LAS unsigned char* tr = tl + (row & 255) * 32 + (((c & 63) >> 3) & 1) * 8;
                    const f16x4_ ch = *(const LAS f16x4_*)tr, sh = *(const LAS f16x4_*)(tr + 16);
                    emit8k<KIND>(B, row, c, v, (f32x4){(float)ch[0], (float)ch[1], (float)ch[2], (float)ch[3]}, (f32x4){(float)sh[0], (float)sh[1], (float)sh[2], (float)sh[3]});
                } else emit8k<KIND>(B, row, c, v);
            }
}
struct EpiIn {
    static constexpr bool PERM = true, AFTER_DRAIN = false; Bufs B; LAS unsigned char* tl;
    __device__ __forceinline__ void pre(const pg8::Unit& u, int tid) const {
        if (u.kind == 1 || tl == nullptr) return;
        const int k = kind_of_tile(u.pn);
        if (k == K_AQ || k == K_BQ || k == K_BK) {
            const int w = __builtin_amdgcn_readfirstlane(tid >> 6);
            __builtin_amdgcn_global_load_lds((const unsigned*)((const char*)(WSP(const _Float16, WS_TABH) + (size_t)((u.pm * 256) & (SEQ - 1)) * 16) + tid * 16), (LAS unsigned*)(tl + w * 1024), 16, 0, 0);
        }
    }
    __device__ __forceinline__ void operator()(const pg8::f32x4 (&acc)[2][2][4][2], const pg8::Unit& u, int wr, int wc, int fr, int fq) const {
        const int row0 = u.pm * 256 + wr * 64 + fr, cw = wc * 32 + 8 * fq;
        if (u.kind == 1) { epi_in_loops<100>(B, acc, row0, u.pn * 256 + cw); return; }
        const int c0 = (u.pn < 16 ? (u.pn & 1) * 256 : (u.pn < 18 ? 0 : (u.pn - 18) * 256)) + cw;
        switch (kind_of_tile(u.pn)) {
        case K_AQ: epi_in_loops<K_AQ>(B, acc, row0, c0, tl); break;  case K_AG: epi_in_loops<K_AG>(B, acc, row0, c0); break;
        case K_BQ: epi_in_loops<K_BQ>(B, acc, row0, c0, tl); break;  case K_BK: epi_in_loops<K_BK>(B, acc, row0, c0, tl); break;
        case K_BV: epi_in_loops<K_BV>(B, acc, row0, c0); break;  case K_BG: epi_in_loops<K_BG>(B, acc, row0, c0); break;
        case K_CQ: epi_in_loops<K_CQ>(B, acc, row0, c0); break;  case K_CG: epi_in_loops<K_CG>(B, acc, row0, c0); break;
        case K_IQ: epi_in_loops<K_IQ>(B, acc, row0, c0); break;  case K_MG: epi_in_loops<K_MG>(B, acc, row0, c0); break;  default:   epi_in_loops<K_MISC>(B, acc, row0, c0); break;
        }
    }
};

#ifndef PROBE_DRY
#define PROBE_DRY 0
#endif
#ifndef PROBE_DMODE
#define PROBE_DMODE 1
#endif
#ifndef FAST_A
#define FAST_A 1
#endif
#ifndef FAST_B
#define FAST_B 1
#endif
#ifndef FAST_C
#define FAST_C 1
#endif
#ifndef TIMING_SEL
#define TIMING_SEL -1
#endif
#define TIMING (TIMING_SEL >= 0)
#define TST(k) do { if (TIMING && threadIdx.x == 0) { const unsigned now_ = (unsigned)__builtin_amdgcn_s_memrealtime(); F.MISC[16 + (k)] += now_ - F.MISC[14]; F.MISC[14] = now_; } } while (0)
namespace att {
typedef short bf16x8 __attribute__((ext_vector_type(8)));
typedef short v4i16_t __attribute__((ext_vector_type(4)));
typedef float f32x16 __attribute__((ext_vector_type(16)));
constexpr int L_K = 0, L_V = 32768, L_MASK = 131072 + 1024, L_X = 65536, L_NG = 141312;
constexpr float NEG_BIG = -1.0e30f;

__device__ __forceinline__ float hswap_max(float v) { auto rr = __builtin_amdgcn_permlane32_swap(__float_as_uint(v), __float_as_uint(v), false, false); return fmaxf(__uint_as_float(rr[0]), __uint_as_float(rr[1])); }
__device__ __forceinline__ float hswap_sum(float v) { auto rr = __builtin_amdgcn_permlane32_swap(__float_as_uint(v), __float_as_uint(v), false, false); return __uint_as_float(rr[0]) + __uint_as_float(rr[1]); }
__device__ __forceinline__ unsigned cvtpk(float lo, float hi) { typedef float f2 __attribute__((ext_vector_type(2))); typedef __bf16 b2 __attribute__((ext_vector_type(2))); f2 v = {lo, hi}; b2 b = __builtin_convertvector(v, b2); return __builtin_bit_cast(unsigned, b); }

template <int DQK, int DV> struct WState { bf16x8 qf[DQK / 16]; f32x16 o[DV / 32]; float m, l; };

template <int KPB> __device__ __forceinline__ int ksw(int row) { return KPB == 128 ? ((row >> 1) & 7) : (row & 15); }
template <int KPB, int DV> struct Stage {
    static constexpr int NK = KPB / 128, NV = DV / 64;
    v4u kr[NK], vr[NV];
    __device__ __forceinline__ void load(const char* kg, size_t kpitch, const char* vg, size_t vpitch, int key0, int tid) {
#pragma unroll
        for (int i = 0; i < NK; ++i) { const int idx = tid + 512 * i, key = idx / (KPB / 16), ch = idx % (KPB / 16); kr[i] = *(const v4u*)(kg + (size_t)(key0 + key) * kpitch + ch * 16); }
#pragma unroll
        for (int i = 0; i < NV; ++i) { const int idx = tid + 512 * i, key = idx / (DV / 8), ch = idx % (DV / 8); vr[i] = *(const v4u*)(vg + (size_t)(key0 + key) * vpitch + ch * 16); }
    }
    __device__ __forceinline__ void store(LAS unsigned char* lds, int buf, int tid) const {
#pragma unroll
        for (int i = 0; i < NK; ++i) { const int idx = tid + 512 * i, key = idx / (KPB / 16), ch = idx % (KPB / 16); *(LAS v4u*)(lds + L_K + buf * 16384 + key * KPB + ((ch ^ ksw<KPB>(key)) << 4)) = kr[i]; }
#pragma unroll
        for (int i = 0; i < NV; ++i) { const int idx = tid + 512 * i, key = idx / (DV / 8), ch = idx % (DV / 8); *(LAS v4u*)(lds + L_V + buf * 16384 + (ch >> 2) * 4096 + key * 64 + (ch & 3) * 16) = vr[i]; }
    }
};

template <int DQK, int DV, int KPB, bool MASKED>
__device__ __forceinline__ void tile_compute(WState<DQK, DV>& W, LAS unsigned char* lds, int buf, int kc0, int lane, const LAS unsigned* mrow  , int koff = -1, int voff = -1) {
    const int r32 = lane & 31, hi = lane >> 5;
    const LAS unsigned char* kb = lds + (koff >= 0 ? koff : L_K + buf * 16384);
    const LAS unsigned char* vb = lds + (voff >= 0 ? voff : L_V + buf * 16384) + ((lane >> 4) & 1) * 32 + (lane & 3) * 8 + (4 * hi + ((lane & 15) >> 2)) * 64;
#pragma unroll
    for (int kh = 0; kh < 2; ++kh) {
        const int row = 32 * kh + r32;
        f32x16 s = {};
#pragma unroll
        for (int ks = 0; ks < DQK / 16; ++ks) {
            const bf16x8 kf = *(const LAS bf16x8*)(kb + row * KPB + (((kc0 + 2 * ks + hi) ^ ksw<KPB>(row)) << 4));
            s = __builtin_amdgcn_mfma_f32_32x32x16_bf16(kf, W.qf[ks], s, 0, 0, 0);
        }
        if constexpr (MASKED) {
            const unsigned wsh = mrow[kh] >> (4 * hi);
#pragma unroll
            for (int r = 0; r < 16; ++r) { const unsigned mm = (unsigned)__builtin_amdgcn_sbfe((int)wsh, (r & 3) + 8 * (r >> 2), 1); s[r] = __uint_as_float((__float_as_uint(s[r]) & mm) | (0xFF800000u & ~mm)); }
        }
        float mx = s[0];
#pragma unroll
        for (int r = 1; r < 16; ++r) mx = fmaxf(mx, s[r]);
        mx = hswap_max(mx);
        const float mn = fmaxf(W.m, mx), alpha = __builtin_amdgcn_exp2f(W.m - mn);
        W.m = mn;
        float ps = 0.f;
#pragma unroll
        for (int r = 0; r < 16; ++r) { s[r] = __builtin_amdgcn_exp2f(s[r] - mn); ps += s[r]; }
        W.l = W.l * alpha + ps;
        if (__any(alpha != 1.0f)) {
#pragma unroll
            for (int dt = 0; dt < DV / 32; ++dt)
#pragma unroll
                for (int r = 0; r < 16; ++r) W.o[dt][r] *= alpha;
        }
        v4u pw0, pw1;
        pw0.x = cvtpk(s[0], s[1]); pw0.y = cvtpk(s[2], s[3]); pw0.z = cvtpk(s[4], s[5]); pw0.w = cvtpk(s[6], s[7]);
        pw1.x = cvtpk(s[8], s[9]); pw1.y = cvtpk(s[10], s[11]); pw1.z = cvtpk(s[12], s[13]); pw1.w = cvtpk(s[14], s[15]);
        const bf16x8 pf0 = __builtin_bit_cast(bf16x8, pw0), pf1 = __builtin_bit_cast(bf16x8, pw1);
#pragma unroll
        for (int dt = 0; dt < DV / 32; ++dt) {
#pragma unroll
            for (int sidx = 0; sidx < 2; ++sidx) {
                const LAS unsigned char* p = vb + dt * 4096 + (32 * kh + 16 * sidx) * 64;
                const v4i16_t lo = __builtin_amdgcn_ds_read_tr16_b64_v4i16((LAS v4i16_t*)p);
                const v4i16_t hh = __builtin_amdgcn_ds_read_tr16_b64_v4i16((LAS v4i16_t*)(p + 512));
                const bf16x8 vf = (bf16x8){lo[0], lo[1], lo[2], lo[3], hh[0], hh[1], hh[2], hh[3]};
                W.o[dt] = __builtin_amdgcn_mfma_f32_32x32x16_bf16(vf, sidx == 0 ? pf0 : pf1, W.o[dt], 0, 0, 0);
            }
        }
    }
}

template <int DQK, int DV, int KPB, bool MASKED>
__device__ __forceinline__ void tile_loop_simple(WState<DQK, DV>& W, LAS unsigned char* lds, const char* kg, size_t kpitch, const char* vg, size_t vpitch, int nT, int my_nt, int kc0, int tid, int lane, const LAS unsigned* mq) {
    Stage<KPB, DV> st;
    st.load(kg, kpitch, vg, vpitch, 0, tid); st.store(lds, 0, tid);
    __syncthreads();
    for (int t = 0; t < nT; ++t) {
        if (t + 1 < nT) st.load(kg, kpitch, vg, vpitch, 64 * (t + 1), tid);
        if (t < my_nt) tile_compute<DQK, DV, KPB, MASKED>(W, lds, t & 1, kc0, lane, MASKED ? mq + 2 * t : mq);
        if (t + 1 < nT) st.store(lds, (t + 1) & 1, tid);
        __syncthreads();
    }
}
template <int KPB> struct StageK {
    static constexpr int NK = KPB / 128; v4u kr[NK];
    __device__ __forceinline__ void load(const char* kg, size_t kpitch, int key0, int tid) {
#pragma unroll
        for (int i = 0; i < NK; ++i) { const int idx = tid + 512 * i, key = idx / (KPB / 16), ch = idx % (KPB / 16); kr[i] = *(const v4u*)(kg + (size_t)(key0 + key) * kpitch + ch * 16); }
    }
    __device__ __forceinline__ void store(LAS unsigned char* lds, int slot, int tid) const {
#pragma unroll
        for (int i = 0; i < NK; ++i) { const int idx = tid + 512 * i, key = idx / (KPB / 16), ch = idx % (KPB / 16); *(LAS v4u*)(lds + L_K + slot * 16384 + key * KPB + ((ch ^ ksw<KPB>(key)) << 4)) = kr[i]; }
    }
};
template <int DV> struct StageV {
    static constexpr int NV = DV / 64; v4u vr[NV];
    __device__ __forceinline__ void load(const char* vg, size_t vpitch, int key0, int tid) {
#pragma unroll
        for (int i = 0; i < NV; ++i) { const int idx = tid + 512 * i, key = idx / (DV / 8), ch = idx % (DV / 8); vr[i] = *(const v4u*)(vg + (size_t)(key0 + key) * vpitch + ch * 16); }
    }
    __device__ __forceinline__ void store(LAS unsigned char* lds, int slot, int tid) const { store_off(lds, slot * 16384, tid); }
    __device__ __forceinline__ void store_off(LAS unsigned char* lds, int off, int tid) const {
#pragma unroll
        for (int i = 0; i < NV; ++i) { const int idx = tid + 512 * i, key = idx / (DV / 8), ch = idx % (DV / 8); *(LAS v4u*)(lds + L_V + off + (ch >> 2) * 4096 + key * 64 + (ch & 3) * 16) = vr[i]; }
    }
};
#define SBAR() __builtin_amdgcn_sched_barrier(0)
template <int DQK, int KPB> __device__ __forceinline__ void k_frags(bf16x8 (&kf)[DQK / 16], const LAS unsigned char* kb, int kc0, int r32, int hi, int kh) {
    const int row = 32 * kh + r32;
#pragma unroll
    for (int ks = 0; ks < DQK / 16; ++ks) kf[ks] = *(const LAS bf16x8*)(kb + row * KPB + (((kc0 + 2 * ks + hi) ^ ksw<KPB>(row)) << 4));
}
template <int DQK, int KPB> __device__ __forceinline__ void qk_tile(f32x16 (&s)[2], const bf16x8* qf, const LAS unsigned char* kb, int kc0, int r32, int hi) {
    bf16x8 kf0[DQK / 16], kf1[DQK / 16]; k_frags<DQK, KPB>(kf0, kb, kc0, r32, hi, 0); k_frags<DQK, KPB>(kf1, kb, kc0, r32, hi, 1);
    f32x16 a = {}, b = {};
#pragma unroll
    for (int ks = 0; ks < DQK / 16; ++ks) a = __builtin_amdgcn_mfma_f32_32x32x16_bf16(kf0[ks], qf[ks], a, 0, 0, 0);
#pragma unroll
    for (int ks = 0; ks < DQK / 16; ++ks) b = __builtin_amdgcn_mfma_f32_32x32x16_bf16(kf1[ks], qf[ks], b, 0, 0, 0);
    s[0] = a; s[1] = b;
}
template <int DQK, int DV, int KPB, bool MASKED> __device__ __forceinline__ void step_sm(WState<DQK, DV>& W, f32x16 (&sc)[2], f32x16 (&sn)[2], bf16x8 (&pf)[4], const LAS unsigned char* kb_next, int kc0, int lane, const LAS unsigned* mrow) {
    const int r32 = lane & 31, hi = lane >> 5;
    bf16x8 kf0[DQK / 16]; k_frags<DQK, KPB>(kf0, kb_next, kc0, r32, hi, 0);
    if constexpr (MASKED) {
#pragma unroll
        for (int kh = 0; kh < 2; ++kh) { const unsigned wsh = mrow[kh] >> (4 * hi);
#pragma unroll
            for (int r = 0; r < 16; ++r) { const unsigned mm = (unsigned)__builtin_amdgcn_sbfe((int)wsh, (r & 3) + 8 * (r >> 2), 1); sc[kh][r] = __uint_as_float((__float_as_uint(sc[kh][r]) & mm) | (0xFF800000u & ~mm)); } }
    }
    float mx = fmaxf(sc[0][0], sc[1][0]);
#pragma unroll
    for (int r = 1; r < 16; ++r) mx = fmaxf(fmaxf(mx, sc[0][r]), sc[1][r]);
    mx = hswap_max(mx);
    const float mn = (mx > W.m + 8.0f) ? mx : W.m, alpha = __builtin_amdgcn_exp2f(W.m - mn);
    W.m = mn;
    if (__any(alpha != 1.0f)) {
#pragma unroll
        for (int dt = 0; dt < DV / 32; ++dt)
#pragma unroll
            for (int r = 0; r < 16; ++r) W.o[dt][r] *= alpha;
    }
    SBAR();
    float mn_ = mn; asm volatile("" : "+v"(kf0[0]), "+v"(mn_));
    float ps0 = 0.f, ps1 = 0.f;
    { f32x16 a = {}, b = {};
#pragma unroll
      for (int ks = 0; ks < DQK / 16; ++ks) a = __builtin_amdgcn_mfma_f32_32x32x16_bf16(kf0[ks], W.qf[ks], a, 0, 0, 0);
      k_frags<DQK, KPB>(kf0, kb_next, kc0, r32, hi, 1);
#pragma unroll
      for (int ks = 0; ks < DQK / 16; ++ks) b = __builtin_amdgcn_mfma_f32_32x32x16_bf16(kf0[ks], W.qf[ks], b, 0, 0, 0);
      sn[0] = a; sn[1] = b; }
#pragma unroll
    for (int r = 0; r < 16; ++r) { sc[0][r] = __builtin_amdgcn_exp2f(sc[0][r] - mn_); ps0 += sc[0][r]; sc[1][r] = __builtin_amdgcn_exp2f(sc[1][r] - mn_); ps1 += sc[1][r]; }
#pragma unroll
    for (int i = 0; i < 2 * (DQK / 16); ++i) { __builtin_amdgcn_sched_group_barrier(0x008, 1, 0); __builtin_amdgcn_sched_group_barrier(0x002, (96 + 2 * (DQK / 16) - 1) / (2 * (DQK / 16)), 0); }
    SBAR();
    W.l = W.l * alpha + (ps0 + ps1);
#pragma unroll
    for (int kh = 0; kh < 2; ++kh) { v4u a, b;
        a.x = cvtpk(sc[kh][0], sc[kh][1]); a.y = cvtpk(sc[kh][2], sc[kh][3]); a.z = cvtpk(sc[kh][4], sc[kh][5]); a.w = cvtpk(sc[kh][6], sc[kh][7]);
        b.x = cvtpk(sc[kh][8], sc[kh][9]); b.y = cvtpk(sc[kh][10], sc[kh][11]); b.z = cvtpk(sc[kh][12], sc[kh][13]); b.w = cvtpk(sc[kh][14], sc[kh][15]);
        pf[2 * kh] = __builtin_bit_cast(bf16x8, a); pf[2 * kh + 1] = __builtin_bit_cast(bf16x8, b); }
}
template <int DQK, int DV> __device__ __forceinline__ void step_pv(WState<DQK, DV>& W, const bf16x8 (&pf)[4], const LAS unsigned char* vbase, int lane) {
    const int hi = lane >> 5;
    const LAS unsigned char* vb = vbase + ((lane >> 4) & 1) * 32 + (lane & 3) * 8 + (4 * hi + ((lane & 15) >> 2)) * 64;
    if constexpr (DV <= 64) {
        v4i16_t vl[2][4], vh[2][4];
#pragma unroll
        for (int k4 = 0; k4 < 4; ++k4) { vl[0][k4] = __builtin_amdgcn_ds_read_tr16_b64_v4i16((LAS v4i16_t*)(vb + (16 * k4) * 64)); vh[0][k4] = __builtin_amdgcn_ds_read_tr16_b64_v4i16((LAS v4i16_t*)(vb + (16 * k4) * 64 + 512)); }
#pragma unroll
        for (int dt = 0; dt < DV / 32; ++dt) {
            if (dt + 1 < DV / 32) {
#pragma unroll
                for (int k4 = 0; k4 < 4; ++k4) { vl[(dt + 1) & 1][k4] = __builtin_amdgcn_ds_read_tr16_b64_v4i16((LAS v4i16_t*)(vb + (dt + 1) * 4096 + (16 * k4) * 64)); vh[(dt + 1) & 1][k4] = __builtin_amdgcn_ds_read_tr16_b64_v4i16((LAS v4i16_t*)(vb + (dt + 1) * 4096 + (16 * k4) * 64 + 512)); }
            }
            SBAR();
#pragma unroll
            for (int k4 = 0; k4 < 4; ++k4) { const v4i16_t lo = vl[dt & 1][k4], hh = vh[dt & 1][k4];
                const bf16x8 vf = (bf16x8){lo[0], lo[1], lo[2], lo[3], hh[0], hh[1], hh[2], hh[3]};
                W.o[dt] = __builtin_amdgcn_mfma_f32_32x32x16_bf16(vf, pf[k4], W.o[dt], 0, 0, 0); }
            SBAR();
        }
    } else {
#pragma unroll
        for (int dt = 0; dt < DV / 32; ++dt) {
            v4i16_t vl[4], vh[4];
#pragma unroll
            for (int k4 = 0; k4 < 4; ++k4) { vl[k4] = __builtin_amdgcn_ds_read_tr16_b64_v4i16((LAS v4i16_t*)(vb + dt * 4096 + (16 * k4) * 64)); vh[k4] = __builtin_amdgcn_ds_read_tr16_b64_v4i16((LAS v4i16_t*)(vb + dt * 4096 + (16 * k4) * 64 + 512)); }
            SBAR();
#pragma unroll
            for (int k4 = 0; k4 < 4; ++k4) { const v4i16_t lo = vl[k4], hh = vh[k4];
                const bf16x8 vf = (bf16x8){lo[0], lo[1], lo[2], lo[3], hh[0], hh[1], hh[2], hh[3]};
                W.o[dt] = __builtin_amdgcn_mfma_f32_32x32x16_bf16(vf, pf[k4], W.o[dt], 0, 0, 0); }
            SBAR();
        }
    }
}
template <int DQK, int DV, int KPB, bool MASKED>
__device__ __forceinline__ void tile_loop(WState<DQK, DV>& W, LAS unsigned char* lds, const char* kg, size_t kpitch, const char* vg, size_t vpitch, int nT, int my_nt, int kc0, int tid, int lane, const LAS unsigned* mq, int mode = 0) {
    const int r32 = lane & 31, hi = lane >> 5;
    const bool lag = __builtin_amdgcn_readfirstlane(tid) >= 256;
    StageK<KPB> sk; StageV<DV> sv;
    sk.load(kg, kpitch, 0, tid); sv.load(vg, vpitch, 0, tid); sk.store(lds, 0, tid); sv.store(lds, 0, tid);
    if (nT > 1) { sk.load(kg, kpitch, 64, tid); sk.store(lds, 1, tid); }
    __syncthreads();
    f32x16 sc[2], sn[2]; bf16x8 pf[4];
    qk_tile<DQK, KPB>(sc, W.qf, lds + L_K, kc0, r32, hi);
    __syncthreads();
    volatile LAS unsigned* mstat = (volatile LAS unsigned*)(lds + MISC_OFF + 64);
    const bool tw = TIMING && (tid == 0);
    int vs_prev = 0, vs_cur = 0, vs_next = 16384;
    for (int t = 0; t < nT; ++t) {
        if (t + 2 < nT && mode != 3) sk.load(kg, kpitch, 64 * (t + 2), tid);
        if (t + 1 < nT && mode != 3) sv.load(vg, vpitch, 64 * (t + 1), tid);
        if (mode != 2 && t < my_nt) {
            if (lag && t > 0) step_pv<DQK, DV>(W, pf, lds + L_V + vs_prev, lane);
            step_sm<DQK, DV, KPB, MASKED>(W, sc, sn, pf, lds + L_K + ((t + 1) & 1) * 16384, kc0, lane, MASKED ? mq + 2 * t : mq);
            if (!lag) step_pv<DQK, DV>(W, pf, lds + L_V + vs_cur, lane);
#pragma unroll
            for (int r = 0; r < 16; ++r) { sc[0][r] = sn[0][r]; sc[1][r] = sn[1][r]; }
        }
        if (t + 2 < nT && mode != 3) sk.store(lds, t & 1, tid);
        if (t + 1 < nT && mode != 3) sv.store_off(lds, vs_next, tid);
        asm volatile("s_waitcnt vmcnt(0) lgkmcnt(0)" ::: "memory");
        __syncthreads();
        vs_prev = vs_cur; vs_cur = vs_next; vs_next = (vs_next == 32768) ? 0 : vs_next + 16384;
    }
    if (lag && mode != 2 && my_nt > 0) step_pv<DQK, DV>(W, pf, lds + L_V + vs_prev, lane);
    __syncthreads();
}
template <int DQK, int DV> __device__ __forceinline__ void wstate_init(WState<DQK, DV>& W, const bf16* qrow  , int hi) {
#pragma unroll
    for (int ks = 0; ks < DQK / 16; ++ks) W.qf[ks] = *(const bf16x8*)(qrow + 16 * ks + 8 * hi);
#pragma unroll
    for (int dt = 0; dt < DV / 32; ++dt) W.o[dt] = (f32x16){};
    W.m = NEG_BIG; W.l = 0.f;
}

__device__ __forceinline__ unsigned skey(float score, int idx) {
    const unsigned b = __float_as_uint(score); const unsigned k = b ^ ((unsigned)((int)b >> 31) | 0x80000000u);
    return ((k >> 1) & 0x7FFFF800u) | (unsigned)(2047 - idx);
}
__device__ __forceinline__ unsigned dpp_u(unsigned v, int ctrl_sel) {
    switch (ctrl_sel) {
    case 0: return (unsigned)__builtin_amdgcn_update_dpp(0, (int)v, 0xB1, 0xF, 0xF, true);
    case 1: return (unsigned)__builtin_amdgcn_update_dpp(0, (int)v, 0x4E, 0xF, 0xF, true);
    case 2: return (unsigned)__builtin_amdgcn_update_dpp(0, (int)v, 0x141, 0xF, 0xF, true);
    default: return (unsigned)__builtin_amdgcn_update_dpp(0, (int)v, 0x140, 0xF, 0xF, true);
    }
}
__device__ __forceinline__ unsigned half_sum(unsigned v, int hi) {
#pragma unroll
    for (int s = 0; s < 4; ++s) v += dpp_u(v, s);
    const unsigned s0 = (unsigned)__builtin_amdgcn_readlane((int)v, 0) + (unsigned)__builtin_amdgcn_readlane((int)v, 16), s1 = (unsigned)__builtin_amdgcn_readlane((int)v, 32) + (unsigned)__builtin_amdgcn_readlane((int)v, 48);
    return hi ? s1 : s0;
}
__device__ __forceinline__ float half_sumf(float v, int hi) {
#pragma unroll
    for (int s = 0; s < 4; ++s) v += __uint_as_float(dpp_u(__float_as_uint(v), s));
    const float s0 = __uint_as_float((unsigned)__builtin_amdgcn_readlane((int)__float_as_uint(v), 0)) + __uint_as_float((unsigned)__builtin_amdgcn_readlane((int)__float_as_uint(v), 16));
    const float s1 = __uint_as_float((unsigned)__builtin_amdgcn_readlane((int)__float_as_uint(v), 32)) + __uint_as_float((unsigned)__builtin_amdgcn_readlane((int)__float_as_uint(v), 48));
    return hi ? s1 : s0;
}
__device__ __forceinline__ unsigned half_max(unsigned v, int hi) {
#pragma unroll
    for (int s = 0; s < 4; ++s) { const unsigned o = dpp_u(v, s); v = v > o ? v : o; }
    const unsigned a0 = (unsigned)__builtin_amdgcn_readlane((int)v, 0), a1 = (unsigned)__builtin_amdgcn_readlane((int)v, 16), b0 = (unsigned)__builtin_amdgcn_readlane((int)v, 32), b1 = (unsigned)__builtin_amdgcn_readlane((int)v, 48);
    const unsigned s0 = a0 > a1 ? a0 : a1, s1 = b0 > b1 ? b0 : b1;
    return hi ? s1 : s0;
}
__device__ __forceinline__ float unskey(unsigned k31) { const unsigned k = k31 << 1; const unsigned b = (k & 0x80000000u) ? (k ^ 0x80000000u) : ~k; return __uint_as_float(b); }
__device__ __forceinline__ unsigned skey_f(float f) { const unsigned b = __float_as_uint(f); return ((b ^ ((unsigned)((int)b >> 31) | 0x80000000u)) >> 1) & 0x7FFFF800u; }
__device__ __forceinline__ void indexer_pass(const Bufs& B, const int S, const LAS unsigned char* ikl, LAS unsigned* masks, size_t rowb, int t0, int w, int lane, int ntl, int limit, bf16x8 a0, bf16x8 a1) {
    const int r32 = lane & 31, hi = lane >> 5;
    volatile LAS unsigned* mstat = (volatile LAS unsigned*)(ikl + MISC_OFF + 64);
    unsigned long long tstart_ = 0; if (TIMING && w == 0) tstart_ = __builtin_amdgcn_s_memrealtime();
    float wt[8];
    { const float* iwp = WSP(const float, WS_IW) + (rowb + t0 + 4 * w + 2 * hi + S) * 8;
      const f32x4 v0 = *(const f32x4*)iwp, v1 = *(const f32x4*)(iwp + 4); wt[0] = v0.x; wt[1] = v0.y; wt[2] = v0.z; wt[3] = v0.w; wt[4] = v1.x; wt[5] = v1.y; wt[6] = v1.z; wt[7] = v1.w; }
    const int sw = (r32 >> 2) & 3;
    const LAS unsigned char* p0 = ikl + r32 * 64 + ((hi ^ sw) << 4);
    const LAS unsigned char* p1 = ikl + r32 * 64 + (((2 + hi) ^ sw) << 4);
    unsigned key[64]; unsigned kmax = 0u, kmin = 0xFFFFFFFFu; float sm1 = 0.f, sm2 = 0.f;
#pragma unroll
    for (int tb = 0; tb < 16; ++tb) {
        if (4 * tb < ntl) {
#pragma unroll
            for (int tt = 0; tt < 4; ++tt) { const int t = 4 * tb + tt;
                const bf16x8 b0 = *(const LAS bf16x8*)(p0 + t * 2048), b1 = *(const LAS bf16x8*)(p1 + t * 2048);
                f32x16 acc = {};
                acc = __builtin_amdgcn_mfma_f32_32x32x16_bf16(a0, b0, acc, 0, 0, 0);
                acc = __builtin_amdgcn_mfma_f32_32x32x16_bf16(a1, b1, acc, 0, 0, 0);
                float s0 = 0.f;
#pragma unroll
                for (int h = 0; h < 8; ++h) { const int ai = __float_as_int(acc[h]); s0 += wt[h] * __int_as_float(ai > 0 ? ai : 0); }
                const unsigned k = skey(s0, 32 * t + r32);
                if (tt < 2) { key[t] = k; kmax = kmax > k ? kmax : k; kmin = kmin < k ? kmin : k; sm1 += s0; sm2 = fmaf(s0, s0, sm2); }
                else { const bool valid = t < ntl; const float sv_ = valid ? s0 : 0.f; sm1 += sv_; sm2 = fmaf(sv_, sv_, sm2); key[t] = valid ? k : 0u; const unsigned kx = valid ? k : 0u, kn = valid ? k : 0xFFFFFFFFu; kmax = kmax > kx ? kmax : kx; kmin = kmin < kn ? kmin : kn; }
            }
        } else {
#pragma unroll
            for (int tt = 0; tt < 4; ++tt) key[4 * tb + tt] = 0u;
        }
    }
    unsigned long long ti0_ = 0; if (TIMING && w == 0) { ti0_ = __builtin_amdgcn_s_memrealtime(); if (lane == 0) mstat[8] += (unsigned)(ti0_ - tstart_); }
    unsigned tau = 1u;
    if (limit > 256) {
        kmax = half_max(kmax, hi); kmin = ~half_max(~kmin, hi);
        unsigned lo = kmin & ~0x7FFu, hb = kmax + 1u; float lof = unskey(lo), hbf = unskey(kmax); bool dn = false;
        float flo = (float)limit - 256.5f, fhb = -256.5f; int lastside = 0;
        const float invn = __builtin_amdgcn_rcpf((float)limit), mu = half_sumf(sm1, hi) * invn, var = fmaxf(half_sumf(sm2, hi) * invn - mu * mu, 1e-30f), sg = __builtin_amdgcn_sqrtf(var);
        const float pq = 256.5f * invn, zq = __builtin_amdgcn_logf((1.f - pq) * __builtin_amdgcn_rcpf(pq)) * 0.40726f;
        const float tau0 = fmaf(zq, sg, mu), idens = sg * __builtin_amdgcn_rcpf((float)limit * 1.702f * pq * (1.f - pq));
        float tprev = tau0;
        for (int it = 0; it < 64; ++it) {
            if (!dn && hb - lo <= 1u) { tau = lo; dn = true; }
            if (__all(dn)) break;
            if (TIMING && w == 0 && lane == 0) mstat[11] += 100u;
            unsigned mid = skey_f((lof * fhb - hbf * flo) * __builtin_amdgcn_rcpf(fhb - flo));
            if (it < 2) { const float tg = it == 0 ? tau0 : fmaf(lastside == 1 ? flo : fhb, idens, tprev); tprev = tg; const unsigned mg = skey_f(tg); mid = ((mg > lo) & (mg < hb)) ? mg : mid; }
            { const unsigned m2 = skey_f(0.5f * (lof + hbf)); const bool bad = (mid <= lo) | (mid >= hb); mid = bad ? m2 : mid; const bool bad2 = (mid <= lo) | (mid >= hb); mid = bad2 ? lo + ((hb - lo) >> 1) : mid; }
            const unsigned mm1 = mid - 1u;
            unsigned c0 = 0, c1 = 0, c2 = 0, c3 = 0;
#pragma unroll
            for (int tb = 0; tb < 4; ++tb) {
                if (16 * tb < ntl) {
                    unsigned a0_ = 0, a1_ = 0;
#pragma unroll
                    for (int tt = 0; tt < 16; tt += 2) { a0_ = __builtin_amdgcn_alignbit(a0_, mm1 - key[16 * tb + tt], 31); a1_ = __builtin_amdgcn_alignbit(a1_, mm1 - key[16 * tb + tt + 1], 31); }
                    if (tb & 1) { c1 += __builtin_popcount(a0_); c3 += __builtin_popcount(a1_); } else { c0 += __builtin_popcount(a0_); c2 += __builtin_popcount(a1_); }
                }
            }
            const unsigned c = half_sum((c0 + c1) + (c2 + c3), hi);
            if (!dn) {
                if (c == 256u) { tau = mid; dn = true; }
                else if (c > 256u) { lo = mid; lof = unskey(mid); flo = (float)c - 256.5f; if (lastside == 1) fhb *= 0.5f; lastside = 1; }
                else { hb = mid; hbf = unskey(mid); fhb = (float)c - 256.5f; if (lastside == 2) flo *= 0.5f; lastside = 2; }
            }
        }
    }
    unsigned long long ti1_ = 0; if (TIMING && w == 0) { ti1_ = __builtin_amdgcn_s_memrealtime(); if (lane == 0) mstat[9] += (unsigned)(ti1_ - ti0_); }
    LAS unsigned* mb = (r32 == 0) ? masks + (4 * w + 2 * hi + S) * 64 : masks + 2048 + lane;
#pragma unroll
    for (int tb = 0; tb < 4; ++tb) {
        if (16 * tb < ntl) {
#pragma unroll
            for (int tt = 0; tt < 16; ++tt) { const int t = 16 * tb + tt;
                const unsigned long long m0 = __ballot(key[t] >= tau);
                mb[t] = hi ? (unsigned)(m0 >> 32) : (unsigned)m0; }
        }
    }
    if (TIMING && w == 0) { const unsigned long long ti2_ = __builtin_amdgcn_s_memrealtime(); if (lane == 0) mstat[10] += (unsigned)(ti2_ - ti1_); }
}
__device__ __forceinline__ void gather8(float (&v)[8], const f32x16& o, int gp) {
#pragma unroll
    for (int i = 0; i < 4; ++i) { auto rr = __builtin_amdgcn_permlane32_swap(__float_as_uint(o[8 * gp + i]), __float_as_uint(o[8 * gp + 4 + i]), false, false); v[i] = __uint_as_float(rr[0]); v[4 + i] = __uint_as_float(rr[1]); }
}
__device__ __forceinline__ v4u pack8(const float (&v)[8]) { v4u o; o.x = cvtpk(v[0], v[1]); o.y = cvtpk(v[2], v[3]); o.z = cvtpk(v[4], v[5]); o.w = cvtpk(v[6], v[7]); return o; }
__device__ __forceinline__ void unpack8(float (&g)[8], v4u w) { g[0] = bf2f(w.x & 0xffffu); g[1] = bf2f(w.x >> 16); g[2] = bf2f(w.y & 0xffffu); g[3] = bf2f(w.y >> 16); g[4] = bf2f(w.z & 0xffffu); g[5] = bf2f(w.z >> 16); g[6] = bf2f(w.w & 0xffffu); g[7] = bf2f(w.w >> 16); }
__device__ __forceinline__ void unit_A(Frame& F, int b, int qb32, int dmode) {
    const bool dry = dmode != 0;
    const Bufs& B = F.B; int tid_ = F.tid; asm volatile("" : "+v"(tid_)); const int tid = tid_, lane = tid & 63, w = F.wave, r32 = lane & 31, hi = lane >> 5;
    const int t0 = qb32 * 32, limit = ((t0 >> 6) + 1) << 6, ntl = limit >> 5;
    const size_t rowb = (size_t)b * SEQ;
    LAS unsigned* masks = (LAS unsigned*)(F.lds + L_MASK);
    {
        { const char* src = (const char*)(WSP(const bf16, WS_IK) + rowb * 32);
          const int P0 = w * 1024 + lane * 16, key0 = P0 >> 6, slot = (P0 >> 4) & 3;
#pragma unroll 1
          for (int s0 = 0; s0 < limit * 64; s0 += 8192) {
              const int key = key0 + (s0 >> 6);
              __builtin_amdgcn_global_load_lds((const unsigned*)(src + (size_t)key * 64 + ((slot ^ ((key >> 2) & 3)) << 4)), (LAS unsigned*)(F.lds + s0 + w * 1024), 16, 0, 0);
          } }
        asm volatile("s_waitcnt vmcnt(0)" ::: "memory");
        __syncthreads();
        TST(1);
        if (dmode != 3) {
#pragma unroll 1
        for (int sl = 0; sl < 2; ++sl) {
            const int rho = r32, qa = 2 * ((rho >> 2) & 1) + ((rho >> 4) ^ sl), ha = 4 * ((rho >> 3) & 1) + (rho & 3);
            const bf16* iqp = WSP(const bf16, WS_IQ) + (rowb + t0 + 4 * w + qa) * 256 + ha * 32 + 8 * hi;
            const bf16x8 a0 = *(const bf16x8*)iqp, a1 = *(const bf16x8*)(iqp + 16);
            indexer_pass(B, sl, F.lds, masks, rowb, t0, w, lane, ntl, limit, a0, a1);
        }
        }
    }
    __syncthreads();
    TST(2);
    {
        const int ql = 4 * w + (r32 >> 3), head = r32 & 7; const size_t row = rowb + t0 + ql;
        bf16* qrow = WSP(bf16, WS_QAB) + row * 1024 + head * 64;
        WState<64, 64> W; wstate_init<64, 64>(W, qrow, hi);
        const int nT = limit >> 6;
        __builtin_amdgcn_global_load_lds((const unsigned*)(WSP(const bf16, WS_AG) + row * 512 + head * 64), (LAS unsigned*)(F.lds + 98304 + w * 256), 4, 0, 0);
        tile_loop<64, 64, 128, true>(W, F.lds, (const char*)(WSP(const bf16, WS_AK) + rowb * 64), 128, (const char*)(WSP(const bf16, WS_AV) + rowb * 64), 128, dmode == 2 ? 1 : nT, dmode == 2 ? 1 : nT, 0, tid, lane, masks + ql * 64);
        TST(3);
        const float inv = 1.f / hswap_sum(W.l);
        const bf16* grow = WSP(const bf16, WS_AG) + row * 512 + head * 64;
        v4u gw[4];
#pragma unroll
        for (int q = 0; q < 4; ++q) gw[q] = *(const v4u*)(grow + 16 * q + 8 * hi);
#pragma unroll
        for (int dt = 0; dt < 2; ++dt)
#pragma unroll
            for (int gp = 0; gp < 2; ++gp) { const int d0 = 32 * dt + 16 * gp + 8 * hi;
                float v[8], g[8]; gather8(v, W.o[dt], gp); unpack8(g, gw[2 * dt + gp]);
#pragma unroll
                for (int i = 0; i < 8; ++i) v[i] = v[i] * inv * g[i];
                if (!dry) *(v4u*)(qrow + d0) = pack8(v); }
    }
    __syncthreads();
    TST(4);
}

__device__ __forceinline__ void unit_B(Frame& F, int b, int h, int qb128, int dmode) {
    const bool dry = dmode != 0;
    const Bufs& B = F.B; int tid_ = F.tid; asm volatile("" : "+v"(tid_)); const int tid = tid_, lane = tid & 63, w = F.wave, r32 = lane & 31, hi = lane >> 5;
    const int qb = w >> 1, c = w & 1, t0 = qb128 * 128 + qb * 32;
    const size_t rowb = (size_t)b * SEQ, row = rowb + t0 + r32;
    const int nT = 2 * qb128 + 2, my_nt = ((t0 >> 6) + 1);
    bf16* qrow = WSP(bf16, WS_QAB) + row * 1024 + 512 + h * 128;
    WState<64, 128> W; wstate_init<64, 128>(W, qrow + c * 64, hi);
    tile_loop<64, 128, 256, false>(W, F.lds, (const char*)(WSP(const bf16, WS_BK) + rowb * 512 + h * 128), 1024, (const char*)(WSP(const bf16, WS_BV) + rowb * 512 + h * 128), 1024, nT, my_nt, c * 8, tid, lane, nullptr, dmode);
    TST(5);
    const float inv = 1.f / hswap_sum(W.l);
    LAS float* X = (LAS float*)(F.lds + L_X) + qb * 4096 + lane;
    const bf16* grow = WSP(const bf16, WS_BG) + row * 512 + h * 128;
    v4u gpre[8];
    if (c == 0) {
#pragma unroll
        for (int q = 0; q < 8; ++q) gpre[q] = *(const v4u*)(grow + 16 * q + 8 * hi);
    }
    if (c == 1) {
#pragma unroll
        for (int dt = 0; dt < 4; ++dt)
#pragma unroll
            for (int r = 0; r < 16; ++r) X[(dt * 16 + r) * 64] = W.o[dt][r] * inv;
    }
    __syncthreads();
    if (c == 0) {
        const float lam = *(const LAS float*)(F.lds + L_NG + 512);
        float ss = 0.f;
#pragma unroll
        for (int dt = 0; dt < 4; ++dt)
#pragma unroll
            for (int r = 0; r < 16; ++r) { const float v = W.o[dt][r] * inv - lam * X[(dt * 16 + r) * 64]; W.o[dt][r] = v; ss += v * v; }
        ss = hswap_sum(ss);
        const float rn = rsqrtf(ss * (1.f / 128.f) + LN_EPS) * (1.f - LAM_INIT);
#pragma unroll
        for (int dt = 0; dt < 4; ++dt)
#pragma unroll
            for (int gp = 0; gp < 2; ++gp) { const int d0 = 32 * dt + 16 * gp + 8 * hi;
                float v[8], g[8]; gather8(v, W.o[dt], gp); unpack8(g, gpre[2 * dt + gp]);
                const f32x4 n0 = *(const LAS f32x4*)(F.lds + L_NG + d0 * 4), n1 = *(const LAS f32x4*)(F.lds + L_NG + d0 * 4 + 16);
#pragma unroll
                for (int i = 0; i < 8; ++i) v[i] = v[i] * rn * (i < 4 ? n0[i] : n1[i - 4]) * g[i];
                if (!dry) *(v4u*)(qrow + d0) = pack8(v); }
    }
    __syncthreads();
    TST(6);
}

__device__ __forceinline__ void unit_C(Frame& F, int b, int h, int qb256, bool dry) {
    const Bufs& B = F.B; int tid_ = F.tid; asm volatile("" : "+v"(tid_)); const int tid = tid_, lane = tid & 63, w = F.wave, r32 = lane & 31, hi = lane >> 5;
    const size_t row = (size_t)b * SEQ + qb256 * 256 + w * 32 + r32;
    bf16* qrow = WSP(bf16, WS_QC) + row * 1024 + h * 128;
    WState<128, 128> W; wstate_init<128, 128>(W, qrow, hi);
    const char* kv = (const char*)(WSP(const bf16, WS_MKV) + (size_t)b * MEM_LEN * 1024 + h * 128);
    __builtin_amdgcn_global_load_lds((const unsigned*)(qrow + 512 + hi * 64), (LAS unsigned*)(F.lds + L_MASK + w * 256), 4, 0, 0);
    { v4u kr[8], vr[8];
#pragma unroll
      for (int i = 0; i < 8; ++i) { const int idx = tid + 512 * i, key = idx >> 4, ch = idx & 15; kr[i] = *(const v4u*)(kv + (size_t)key * 2048 + ch * 16); vr[i] = *(const v4u*)(kv + 1024 + (size_t)key * 2048 + ch * 16); }
#pragma unroll
      for (int i = 0; i < 8; ++i) { const int idx = tid + 512 * i, key = idx >> 4, ch = idx & 15, t = key >> 6, k64 = key & 63;
          *(LAS v4u*)(F.lds + t * 16384 + k64 * 256 + ((ch ^ ksw<256>(k64)) << 4)) = kr[i];
          *(LAS v4u*)(F.lds + 65536 + t * 16384 + (ch >> 2) * 4096 + k64 * 64 + (ch & 3) * 16) = vr[i]; } }
    __syncthreads();
    { f32x16 sc[2], sn[2]; bf16x8 pf[4];
      qk_tile<128, 256>(sc, W.qf, F.lds, 0, r32, hi);
#pragma unroll 1
      for (int t = 0; t < 4; ++t) {
          step_sm<128, 128, 256, false>(W, sc, sn, pf, F.lds + ((t + 1) & 3) * 16384, 0, lane, nullptr);
          step_pv<128, 128>(W, pf, F.lds + 65536 + t * 16384, lane);
#pragma unroll
          for (int r = 0; r < 16; ++r) { sc[0][r] = sn[0][r]; sc[1][r] = sn[1][r]; }
      } }
    const float inv = 1.f / hswap_sum(W.l);
    const bf16* grow = qrow + 512;
    v4u gwc[8];
#pragma unroll
    for (int q = 0; q < 8; ++q) gwc[q] = *(const v4u*)(grow + 16 * q + 8 * hi);
#pragma unroll
    for (int dt = 0; dt < 4; ++dt)
#pragma unroll
        for (int gp = 0; gp < 2; ++gp) { const int d0 = 32 * dt + 16 * gp + 8 * hi;
            float v[8], g[8]; gather8(v, W.o[dt], gp); unpack8(g, gwc[2 * dt + gp]);
#pragma unroll
            for (int i = 0; i < 8; ++i) v[i] = v[i] * inv * g[i];
            if (!dry) *(v4u*)(qrow + d0) = pack8(v); }
    __syncthreads();
    TST(7);
}

__device__ __forceinline__ void unit_MKV(Frame& F, int b, int pn) {
    const Bufs& B = F.B;
    SchedOne S; S.pm = b; S.pn = pn; S.MEMB = (const char*)(B.ws + WS_MEMB); S.WMEM = (const char*)(B.ws + WS_WMEM);
    EpiIn E{B, nullptr};
    pg8::gemm_phase<EpiIn, SchedOne, true, true>(F.lds + RING_OFF, S, E);
    asm volatile("s_waitcnt vmcnt(0)" ::: "memory");
    __syncthreads();
    if (F.tid == 0) { __builtin_amdgcn_fence(__ATOMIC_RELEASE, "agent"); asm volatile("s_waitcnt vmcnt(0)" ::: "memory"); __hip_atomic_fetch_add(F.ctl + CW_MKV + 64 * b, 1u, __ATOMIC_RELAXED, __HIP_MEMORY_SCOPE_AGENT); }
    __syncthreads();
}
__device__ __forceinline__ void wait_MKV(Frame& F, int b) {
    if (F.tid == 0) {
        unsigned sp = 0;
        while (__hip_atomic_load(F.ctl + CW_MKV + 64 * b, __ATOMIC_RELAXED, __HIP_MEMORY_SCOPE_AGENT) < 4u) { __builtin_amdgcn_s_sleep(2); if (++sp > (1u << 22)) break; }
        __builtin_amdgcn_fence(__ATOMIC_ACQUIRE, "agent"); asm volatile("s_waitcnt vmcnt(0)" ::: "memory");
    }
    __syncthreads();
}
constexpr int QUNITS = 328;
__device__ __forceinline__ void attn_phase(Frame& F, unsigned* qctr) {
    const int q0 = (int)(xb_xcc_id() & 7u);
    if (F.tid < 128) ((LAS float*)(F.lds + L_NG))[F.tid] = F.B.diff_norm_g[F.tid];
    if (F.tid == 128) ((LAS float*)(F.lds + L_NG))[128] = *(const float*)(F.B.ws + WS_LAM);
    if (TIMING && threadIdx.x == 0) F.MISC[14] = (unsigned)__builtin_amdgcn_s_memrealtime();
    for (int k = 0; k < 8; ++k) {
        const int q = (q0 + k) & 7;
        for (;;) {
            __syncthreads();
            if (F.tid == 0) F.MISC[0] = atomicAdd(qctr + 64 * q, 1u);
            __syncthreads();
            int pos = (int)F.MISC[0]; int dmode = 0;
            TST(0);
#if PROBE_DRY
            if (pos < 128) { dmode = PROBE_DMODE; pos = ((pos >> 2) << 3) + (pos & 3) + (PROBE_DRY == 1 ? 0 : 4); } else pos -= 128;
#endif
            if (pos >= QUNITS) break;
            if (pos < 8) { unit_MKV(F, q + 8 * (pos >> 2), pos & 3); continue; }
            pos -= 8;
            if (pos < 256) {
                const int b = q + 8 * (pos >> 7), p = pos & 127, L = 15 - (p >> 3), r = p & 7;
                if (r < 4) unit_A(F, b, 4 * L + 3 - r, dmode);
                else unit_B(F, b, r - 4, L, dmode);
            } else { const int c = pos - 256, b = q + 8 * (c >> 5), cc = c & 31; wait_MKV(F, b); unit_C(F, b, cc & 3, cc >> 2, false); }
        }
    }
    if (TIMING) { __syncthreads(); if (F.tid < 16) atomicAdd(F.ctl + CW_TIME + F.tid, F.MISC[16 + F.tid]); }
}
}
constexpr size_t WS_SCR = WS_XN;
struct SchedMerge {
    pg8::TileOrder T; int G, c; const char *QAB, *QC, *WAB, *WC;
    __device__ __forceinline__ bool next(int i, pg8::Unit& u) const {
        const int ti = i / 3, br = i - ti * 3, L = ti * G + c;
        if (L >= T.nwg) return false;
        T.tile(L, u.pm, u.pn); u.kind = br; u.nt = 8; u.keep = br < 2 ? 1 : 0;
        if (br == 0) { u.A = QAB + (size_t)u.pm * pg8::TSTEP; u.B = WAB + (size_t)u.pn * pg8::TSTEP; }
        else if (br == 1) { u.A = QAB + (size_t)u.pm * pg8::TSTEP + 1024; u.B = WAB + (size_t)u.pn * pg8::TSTEP + 1024; }
        else { u.A = QC + (size_t)u.pm * pg8::TSTEP; u.B = WC + (size_t)u.pn * pg8::TSTEP; }
        return true;
    }
    __device__ __forceinline__ void a_ready(const pg8::Unit&) const {}
    __device__ __forceinline__ void done(const pg8::Unit&) const {}
};
struct EpiMerge {
    static constexpr bool PERM = true, AFTER_DRAIN = false; bf16* merged; const unsigned char* ws_;
    __device__ __forceinline__ void pre(const pg8::Unit&, int) const {}
    __device__ __forceinline__ static void ld_u8(pg8::f32x4& a, pg8::f32x4& b, const unsigned char* p) {
        const uint2 gw = *(const uint2*)p; const float s = 1.f / 255.f;
        a = (pg8::f32x4){fmaxf((float)(gw.x & 255u), 1.f), fmaxf((float)((gw.x >> 8) & 255u), 1.f), fmaxf((float)((gw.x >> 16) & 255u), 1.f), fmaxf((float)(gw.x >> 24), 1.f)} * s;
        b = (pg8::f32x4){fmaxf((float)(gw.y & 255u), 1.f), fmaxf((float)((gw.y >> 8) & 255u), 1.f), fmaxf((float)((gw.y >> 16) & 255u), 1.f), fmaxf((float)(gw.y >> 24), 1.f)} * s;
    }
    __device__ __forceinline__ static void ld_bf(pg8::f32x4& a, pg8::f32x4& b, const bf16* p) {
        const v4u gw = *(const v4u*)p;
        a = (pg8::f32x4){bf2f(gw.x & 0xffffu), bf2f(gw.x >> 16), bf2f(gw.y & 0xffffu), bf2f(gw.y >> 16)}; b = (pg8::f32x4){bf2f(gw.z & 0xffffu), bf2f(gw.z >> 16), bf2f(gw.w & 0xffffu), bf2f(gw.w >> 16)};
    }
    __device__ __forceinline__ static pg8::f32x4 rcp4(pg8::f32x4 v) { return (pg8::f32x4){__builtin_amdgcn_rcpf(v[0]), __builtin_amdgcn_rcpf(v[1]), __builtin_amdgcn_rcpf(v[2]), __builtin_amdgcn_rcpf(v[3])}; }
    __device__ __forceinline__ static void cv_u8(pg8::f32x4& a, pg8::f32x4& b, uint2 gw) {
        const float s = 1.f / 255.f;
        a = (pg8::f32x4){(float)(gw.x & 255u), (float)((gw.x >> 8) & 255u), (float)((gw.x >> 16) & 255u), (float)(gw.x >> 24)} * s;
        b = (pg8::f32x4){(float)(gw.y & 255u), (float)((gw.y >> 8) & 255u), (float)((gw.y >> 16) & 255u), (float)(gw.y >> 24)} * s;
    }
    __device__ __forceinline__ static void cv_bf(pg8::f32x4& a, pg8::f32x4& b, v4u gw) {
        a = (pg8::f32x4){bf2f(gw.x & 0xffffu), bf2f(gw.x >> 16), bf2f(gw.y & 0xffffu), bf2f(gw.y >> 16)}; b = (pg8::f32x4){bf2f(gw.z & 0xffffu), bf2f(gw.z >> 16), bf2f(gw.w & 0xffffu), bf2f(gw.w >> 16)};
    }
    __device__ __forceinline__ void operator()(pg8::f32x4 (&acc)[2][2][4][2], const pg8::Unit& u, int wr, int wc, int fr, int fq) const {
        const int row0 = u.pm * 256 + wr * 64 + fr, col0 = u.pn * 256 + wc * 32 + 8 * fq;
        const size_t rt = (size_t)u.pm * 256, lo = (size_t)(wr * 64 + fr) * 1024 + col0;
        const int wv = wr * 4 + wc, ln = fq * 16 + fr;
        const size_t tA = ((size_t)(u.pm * 4 + u.pn) * 8 + wv) * 8192, tB = ((size_t)(u.pm * 4 + u.pn) * 8 + wv) * 16384;
        const __amdgpu_buffer_rsrc_t rA = __builtin_amdgcn_make_buffer_rsrc((void*)(ws_ + WS_GA + tA), 0, 8192, 0x00020000);
        const __amdgpu_buffer_rsrc_t rC = __builtin_amdgcn_make_buffer_rsrc((void*)(rt < GC_SPLIT ? ws_ + WS_GC + tA : ws_ + WS_GC2 + (tA - (size_t)GC_SPLIT * 1024)), 0, 8192, 0x00020000);
        const __amdgpu_buffer_rsrc_t rB = __builtin_amdgcn_make_buffer_rsrc((void*)(ws_ + WS_GB + tB), 0, 16384, 0x00020000);
        const int vl = ln * 16;
#define LD8P(r, p) __builtin_amdgcn_raw_buffer_load_b128(r, vl, (p) * 1024, 2)
#define LD16(ix) __builtin_amdgcn_raw_buffer_load_b128(rB, vl, (ix) * 1024, 2)
#define OFS(ix) ((((((ix) >> 3) & 1) * 128 + ((ix) & 3) * 16) * 1024) + (((ix) >> 2) & 1) * 128)
#pragma unroll
        for (int h = 0; h < 2; ++h) {
            uint2 q8[8]; v4u q16[8];
            if (u.kind == 0) {
#pragma unroll
                for (int j = 0; j < 4; ++j) { const v4u t_ = LD8P(rA, h * 4 + j); q8[2 * j] = make_uint2(t_.x, t_.y); q8[2 * j + 1] = make_uint2(t_.z, t_.w); }
#pragma unroll
                for (int j = 0; j < 8; ++j) q16[j] = LD16(h * 8 + j);
#pragma unroll
                for (int j = 0; j < 8; ++j) { const int ix = h * 8 + j; pg8::f32x4 na, nb, da, db; cv_u8(na, nb, q8[j]); cv_bf(da, db, q16[j]);
                    acc[ix >> 3][(ix >> 2) & 1][ix & 3][0] *= na * rcp4(da); acc[ix >> 3][(ix >> 2) & 1][ix & 3][1] *= nb * rcp4(db); }
            } else if (u.kind == 1) {
#pragma unroll
                for (int j = 0; j < 4; ++j) { const v4u t_ = LD8P(rC, h * 4 + j); q8[2 * j] = make_uint2(t_.x, t_.y); q8[2 * j + 1] = make_uint2(t_.z, t_.w); }
#pragma unroll
                for (int j = 0; j < 8; ++j) q16[j] = LD16(h * 8 + j);
#pragma unroll
                for (int j = 0; j < 8; ++j) { const int ix = h * 8 + j; pg8::f32x4 na, nb, da, db; cv_bf(na, nb, q16[j]); cv_u8(da, db, q8[j]);
                    acc[ix >> 3][(ix >> 2) & 1][ix & 3][0] *= na * rcp4(da); acc[ix >> 3][(ix >> 2) & 1][ix & 3][1] *= nb * rcp4(db); }
            } else {
#pragma unroll
                for (int j = 0; j < 4; ++j) { const v4u t_ = LD8P(rC, h * 4 + j); q8[2 * j] = make_uint2(t_.x, t_.y); q8[2 * j + 1] = make_uint2(t_.z, t_.w); }
#pragma unroll
                for (int j = 0; j < 8; ++j) { const int ix = h * 8 + j; pg8::f32x4 na, nb; cv_u8(na, nb, q8[j]); const int ai = ix >> 3, bj = (ix >> 2) & 1, m = ix & 3;
                    const pg8::f32x4 t0 = acc[ai][bj][m][0] * na, t1 = acc[ai][bj][m][1] * nb; float v[8] = {t0[0], t0[1], t0[2], t0[3], t1[0], t1[1], t1[2], t1[3]};
                    store8c(merged + (size_t)(row0 + ai * 128 + m * 16) * 1024 + col0 + bj * 128, v); }
            }
            asm volatile("" ::: "memory");
        }
#undef LD8P
#undef LD16
#undef OFS
    }
};
struct SchedOut {
    pg8::TileOrder T; int G, c; const char *MG, *WO;
    __device__ __forceinline__ bool next(int i, pg8::Unit& u) const {
        const int L = i * G + c; if (L >= T.nwg) return false;
        T.tile(L, u.pm, u.pn); u.A = MG + (size_t)u.pm * pg8::TSTEP; u.B = WO + (size_t)u.pn * pg8::TSTEP; u.nt = 16; u.kind = 0; u.keep = 0; return true;
    }
    __device__ __forceinline__ void a_ready(const pg8::Unit&) const {}
    __device__ __forceinline__ void done(const pg8::Unit&) const {}
};
struct EpiOutF {
    static constexpr bool PERM = true, AFTER_DRAIN = false; bf16* Y;
    __device__ __forceinline__ void pre(const pg8::Unit&, int) const {}
    __device__ __forceinline__ void operator()(const pg8::f32x4 (&acc)[2][2][4][2], const pg8::Unit& u, int wr, int wc, int fr, int fq) const {
        const int row0 = u.pm * 256 + wr * 64 + fr, col0 = u.pn * 256 + wc * 32 + 8 * fq;
#pragma unroll
        for (int ai = 0; ai < 2; ++ai)
#pragma unroll
            for (int m = 0; m < 4; ++m)
#pragma unroll
                for (int bj = 0; bj < 2; ++bj) { const pg8::f32x4 t0 = acc[ai][bj][m][0], t1 = acc[ai][bj][m][1];
                    float v[8] = {t0[0], t0[1], t0[2], t0[3], t1[0], t1[1], t1[2], t1[3]};
                    store8c(Y + (size_t)(row0 + ai * 128 + m * 16) * 1024 + col0 + bj * 128, v); }
    }
};
__device__ __forceinline__ void ln_out_rows(const Bufs& B, const bf16* Y, int gw, int NGW, int lane) {
    f32x4 gi[4], bi[4];
#pragma unroll
    for (int j = 0; j < 4; ++j) { gi[j] = *((const f32x4*)B.ln_in_g + lane + 64 * j) * ALPHA; bi[j] = *((const f32x4*)B.ln_in_b + lane + 64 * j) * ALPHA; }
    f32x4 v[4], nx[4]; uint2 yv[4], ny[4]; float2 st = {0.f, 0.f}, nst = {0.f, 0.f};
    if (gw < M) { const f32x4* xr = (const f32x4*)(B.x + (size_t)gw * D) + lane; const uint2* yr = (const uint2*)(Y + (size_t)gw * D) + lane;
#pragma unroll
        for (int j = 0; j < 4; ++j) { v[j] = __builtin_nontemporal_load(xr + 64 * j); { typedef unsigned v2u_ __attribute__((ext_vector_type(2))); const v2u_ t_ = __builtin_nontemporal_load((const v2u_*)(yr + 64 * j)); yv[j] = make_uint2(t_.x, t_.y); } }
        st = *(const float2*)(WSP(const float, WS_STATS) + (size_t)gw * 2); }
    for (int row = gw; row < M; row += NGW) {
        const int nr = row + NGW;
        if (nr < M) { const f32x4* xr = (const f32x4*)(B.x + (size_t)nr * D) + lane; const uint2* yr = (const uint2*)(Y + (size_t)nr * D) + lane;
#pragma unroll
            for (int j = 0; j < 4; ++j) { nx[j] = __builtin_nontemporal_load(xr + 64 * j); { typedef unsigned v2u_ __attribute__((ext_vector_type(2))); const v2u_ t_ = __builtin_nontemporal_load((const v2u_*)(yr + 64 * j)); ny[j] = make_uint2(t_.x, t_.y); } }
            nst = *(const float2*)(WSP(const float, WS_STATS) + (size_t)nr * 2); }
        float s = 0.f;
#pragma unroll
        for (int j = 0; j < 4; ++j) { const f32x4 yy = {bf2f(yv[j].x & 0xffffu), bf2f(yv[j].x >> 16), bf2f(yv[j].y & 0xffffu), bf2f(yv[j].y >> 16)};
            v[j] = (v[j] - st.x) * st.y * gi[j] + bi[j] + yy; s += (v[j].x + v[j].y) + (v[j].z + v[j].w); }
        const float mean = wave_sum(s) * (1.f / D); float s2 = 0.f;
#pragma unroll
        for (int j = 0; j < 4; ++j) { v[j] = v[j] - mean; s2 += (v[j].x * v[j].x + v[j].y * v[j].y) + (v[j].z * v[j].z + v[j].w * v[j].w); }
        const float rstd = rsqrtf(wave_sum(s2) * (1.f / D) + LN_EPS);
        f32x4* orow = (f32x4*)(B.out + (size_t)row * D) + lane;
#pragma unroll
        for (int j = 0; j < 4; ++j) { const f32x4 g = *((const f32x4*)B.ln_g + lane + 64 * j), b = *((const f32x4*)B.ln_b + lane + 64 * j); __builtin_nontemporal_store(v[j] * rstd * g + b, orow + 64 * j); }
#pragma unroll
        for (int j = 0; j < 4; ++j) { v[j] = nx[j]; yv[j] = ny[j]; }
        st = nst;
    }
}
__device__ __forceinline__ void ln_out_row(const Bufs& B, int row, int lane) {
    f32x4* xr = (f32x4*)(B.out + (size_t)row * D) + lane;
    f32x4 v[4]; float s = 0.f;
#pragma unroll
    for (int j = 0; j < 4; ++j) { v[j] = xr[64 * j]; s += (v[j].x + v[j].y) + (v[j].z + v[j].w); }
    const float mean = wave_sum(s) * (1.f / D); float s2 = 0.f;
#pragma unroll
    for (int j = 0; j < 4; ++j) { v[j] = v[j] - mean; s2 += (v[j].x * v[j].x + v[j].y * v[j].y) + (v[j].z * v[j].z + v[j].w * v[j].w); }
    const float rstd = rsqrtf(wave_sum(s2) * (1.f / D) + LN_EPS);
#pragma unroll
    for (int j = 0; j < 4; ++j) { const f32x4 g = *((const f32x4*)B.ln_g + lane + 64 * j), b = *((const f32x4*)B.ln_b + lane + 64 * j); xr[64 * j] = v[j] * rstd * g + b; }
}
struct Args { Bufs B; int nprog; int prog[11]; };
__global__ void __launch_bounds__(NWAVES * 64, 2) skel_fwd(Args args) {
    extern __shared__ __attribute__((aligned(16))) unsigned char lds[];
    Frame F;
    F.lds = (LAS unsigned char*)lds; F.MISC = (volatile LAS unsigned*)(F.lds + MISC_OFF);
    F.tid = threadIdx.x; F.lane = F.tid & 63; F.wave = __builtin_amdgcn_readfirstlane(F.tid >> 6);
    F.G = gridDim.x; { const int bx = blockIdx.x; F.vcu = (F.G % 8 == 0) ? (bx % 8) * (F.G / 8) + bx / 8 : bx; }
    F.B = args.B; F.ctl = (unsigned*)(args.B.ws + WS_CTL);
    const Bufs& B = F.B;
    for (int u = F.tid; u < (LDS_BYTES - LDSCTL_OFF) / 4; u += NWAVES * 64) ((LAS unsigned*)(F.lds + LDSCTL_OFF))[u] = 0u;
    __syncthreads();
    XcdBarrier bar = xcd_barrier_post(F.ctl + CW_BAR, F.MISC + 8);
    const int en = args.nprog;
#define P_PRO()  do { if (en & 1) p0_prologue(F); } while (0)
#define P_IN()   do { if (en & 2) { SchedIn S; S.T.init(M / 256, NPOS / 256); S.G = F.G; S.c = (int)blockIdx.x; \
            S.XN = (const char*)(B.ws + WS_XN); S.WIN = (const char*)(B.ws + WS_WIN); S.MEMB = (const char*)(B.ws + WS_MEMB); S.WMEM = (const char*)(B.ws + WS_WMEM); \
            EpiIn E{B, F.lds + att::L_MASK}; pg8::gemm_phase<EpiIn, SchedIn, true, true>(F.lds + RING_OFF, S, E); } } while (0)
#define P_ATT(qi) do { if (en & 4) att::attn_phase(F, F.ctl + CW_QUEUE + 512 * (qi)); } while (0)
#define P_MRG()  do { if (en & 8) { SchedMerge S; S.T.init(M / 256, 4); S.G = F.G; S.c = (int)blockIdx.x; \
            S.QAB = (const char*)(B.ws + WS_QAB); S.QC = (const char*)(B.ws + WS_QC); S.WAB = (const char*)(B.ws + WS_WAB); S.WC = (const char*)(B.ws + WS_WC); \
            EpiMerge E{WSP(bf16, WS_MERGED), (const unsigned char*)B.ws}; \
            pg8::gemm_phase<EpiMerge, SchedMerge, true, true>(F.lds + RING_OFF, S, E); } } while (0)
#define P_OUT()  do { if (en & 16) { SchedOut S; S.T.init(M / 256, 4); S.G = F.G; S.c = (int)blockIdx.x; S.MG = (const char*)(B.ws + WS_MERGED); S.WO = (const char*)(B.ws + WS_WOUT); \
            EpiOutF E{WSP(bf16, WS_XN)}; pg8::gemm_phase<EpiOutF, SchedOut, true, true>(F.lds + RING_OFF, S, E); } } while (0)
#define P_LN()   do { if (en & 32) ln_out_rows(B, WSP(const bf16, WS_XN), F.vcu * NWAVES + F.wave, F.G * NWAVES, (int)(threadIdx.x & 63u)); } while (0)
#define BAR() xcd_barrier(bar)
#ifndef PROBE_REP
#define PROBE_REP 0
#endif
    P_PRO(); BAR();
#if PROBE_REP == 10
    P_PRO(); BAR();
#endif
    P_IN(); BAR();
#if PROBE_REP == 1
    P_IN(); BAR();
#endif
    P_ATT(0); BAR();
#if PROBE_REP == 12
    P_IN(); BAR(); P_ATT(1); BAR();
#endif
    P_MRG(); BAR();
#if PROBE_REP == 3
    P_MRG(); BAR();
#endif
    P_OUT(); BAR();
    P_LN();
#if PROBE_REP == 45
    BAR(); P_OUT(); BAR(); P_LN();
#endif
#if TIMING_SEL >= 0
    BAR(); if (blockIdx.x == 0 && F.tid == 0) { const unsigned v = __hip_atomic_load(F.ctl + CW_TIME + TIMING_SEL, __ATOMIC_RELAXED, __HIP_MEMORY_SCOPE_AGENT); B.out[0] = (float)v / (float)F.G / 100.f; }
#endif
}
#ifndef FAST_UPTO
#define FAST_UPTO 6
#endif
#ifndef PROG_LIST
#define PROG_LIST 0, 1, 2, 3, 4, 5
#endif
static void launch_skel(const Bufs& B, hipStream_t stream, int grid) {
    static const int prog[] = {PROG_LIST};
    Args a{}; a.B = B; a.nprog = 63; (void)prog;
    hipLaunchKernelGGL(skel_fwd, dim3(grid), dim3(NWAVES * 64), LDS_BYTES, stream, a);
}
extern "C" void kernel_launch(void* const* d_in, const int* in_sizes, int n_in, void* d_out, int out_size, void* d_ws, size_t ws_size, hipStream_t stream) {
    (void)in_sizes; (void)n_in; (void)out_size;
    static int grid = 0;
    if (grid == 0) {
        if (ws_size < WS_END) { fprintf(stderr, "workspace too small: %zu < %zu\n", ws_size, (size_t)WS_END); grid = -1; return; }
        int dev = 0, cus = 0;
        if (hipGetDevice(&dev) != hipSuccess || hipDeviceGetAttribute(&cus, hipDeviceAttributeMultiprocessorCount, dev) != hipSuccess) { grid = -1; return; }
        if (hipFuncSetAttribute((const void*)skel_fwd, hipFuncAttributeMaxDynamicSharedMemorySize, LDS_BYTES) != hipSuccess) { fprintf(stderr, "hipFuncSetAttribute failed\n"); grid = -1; return; }
        int per_cu = 0; (void)hipOccupancyMaxActiveBlocksPerMultiprocessor(&per_cu, (const void*)skel_fwd, NWAVES * 64, LDS_BYTES); (void)hipGetLastError();
        if (per_cu < 1) fprintf(stderr, "note: occupancy query reports %d blocks/CU\n", per_cu);
        grid = cus;
    }
    if (grid < 0) return;
    Bufs B{};
    B.x = (const float*)d_in[0]; B.mem = (const float*)d_in[1]; B.ln_in_g = (const float*)d_in[2]; B.ln_in_b = (const float*)d_in[3]; B.w_in = (const float*)d_in[4];
    B.w_mem_kv = (const float*)d_in[5]; B.diff_lambda = (const float*)d_in[6]; B.diff_norm_g = (const float*)d_in[7]; B.w_proj_a = (const float*)d_in[8];
    B.w_proj_b = (const float*)d_in[9]; B.w_proj_c = (const float*)d_in[10]; B.w_out = (const float*)d_in[11]; B.ln_g = (const float*)d_in[12]; B.ln_b = (const float*)d_in[13];
    B.out = (float*)d_out; B.ws = (unsigned char*)d_ws;
    unsigned char* ws = B.ws;
    (void)hipMemsetAsync(ws + WS_CTL, 0, CTL_ZERO_BYTES, stream);
    launch_skel(B, stream, grid);
}
```
